# Optimizing an MI355X kernel written in HIP

```python
import jax, jax.numpy as jnp
from jax import lax
import numpy as np

D_MODEL = 1024
BATCH = 8
SEQ = 2048
DEPTH = 1

D_MIX = D_MODEL
D_LRU = D_MIX // 2
D_CONV = D_MIX - D_LRU
LRU_HEADS = 8
LRU_HEAD_DIM = D_LRU // LRU_HEADS
LRU_CONV_WIDTH = 4
LRU_C = 8.0
LRU_A_MIN = 0.9
LRU_A_MAX = 0.999
CONV_GROUPS = 8
CONV_GROUP_DIM = D_CONV // CONV_GROUPS
CONF_KERNEL = 31
PEER_HEADS = 8
PEER_N_KEYS = 128
PEER_N_EXPERTS = PEER_N_KEYS ** 2
PEER_D_QUERY = 256
PEER_HALF = PEER_D_QUERY // 2
PEER_TOPK = 16
PEER_BLOCK = 128
EPS = 1e-6

kernel_name = "hybrid_rglru_conformer_peer_encoder"


def rms_norm(x, g):
    xf = x.astype(jnp.float32)
    y = xf * lax.rsqrt(jnp.mean(xf * xf, axis=-1, keepdims=True) + EPS)
    return (y * g.astype(jnp.float32)).astype(x.dtype)


def group_layer_norm(x, g, b):
    B_, S_, C = x.shape
    xg = x.astype(jnp.float32).reshape(B_, S_, CONV_GROUPS, CONV_GROUP_DIM)
    mu = jnp.mean(xg, axis=-1, keepdims=True)
    var = jnp.mean(jnp.square(xg - mu), axis=-1, keepdims=True)
    y = ((xg - mu) * lax.rsqrt(var + EPS)).reshape(B_, S_, C)
    return (y * g.astype(jnp.float32) + b.astype(jnp.float32)).astype(x.dtype)


def depthwise_conv(x, w, b, pad):
    C = x.shape[-1]
    y = lax.conv_general_dilated(
        x, w[:, None, :].astype(x.dtype), window_strides=(1,), padding=[pad],
        dimension_numbers=("NWC", "WIO", "NWC"), feature_group_count=C)
    return y + b.astype(x.dtype)


def block_diag_linear(x, w, b):
    B_, S_, _ = x.shape
    xh = x.reshape(B_, S_, LRU_HEADS, LRU_HEAD_DIM)
    y = jnp.einsum("bshi,hij->bshj", xh, w.astype(jnp.float32))
    return y.reshape(B_, S_, D_LRU) + b.astype(jnp.float32)


def _linear_recurrence(left, right):
    a_l, b_l = left
    a_r, b_r = right
    return a_l * a_r, a_r * b_l + b_r


def rg_lru(x, w_r, b_r, w_i, b_i, lam, reverse):
    xf = x.astype(jnp.float32)
    r = jax.nn.sigmoid(block_diag_linear(xf, w_r, b_r))
    i = jax.nn.sigmoid(block_diag_linear(xf, w_i, b_i))
    log_a = LRU_C * r * jax.nn.log_sigmoid(lam.astype(jnp.float32))
    a = jnp.exp(log_a)
    u = jnp.sqrt(-jnp.expm1(2.0 * log_a)) * (i * xf)
    _, h = lax.associative_scan(_linear_recurrence, (a, u), reverse=reverse, axis=1)
    return h


def hybrid_mixer(n, w_in, lru_conv_w, lru_conv_b, lru_w_rg, lru_b_rg, lru_w_ig, lru_b_ig,
                 lru_lambda, conf_conv_w, conf_conv_b, conf_norm_g, conf_norm_b,
                 beta_lru, beta_conv, w_out):
    z = jnp.einsum("bsd,de->bse", n, w_in.astype(n.dtype))
    x_lru, g_lru, a_glu, b_glu = jnp.split(
        z, [D_LRU, 2 * D_LRU, 2 * D_LRU + D_CONV], axis=-1)

    lpad = LRU_CONV_WIDTH // 2
    xc = depthwise_conv(x_lru, lru_conv_w, lru_conv_b, (lpad, LRU_CONV_WIDTH - 1 - lpad))
    h_fwd = rg_lru(xc, lru_w_rg[0], lru_b_rg[0], lru_w_ig[0], lru_b_ig[0], lru_lambda[0], False)
    h_bwd = rg_lru(xc, lru_w_rg[1], lru_b_rg[1], lru_w_ig[1], lru_b_ig[1], lru_lambda[1], True)
    y_lru = ((h_fwd + h_bwd) * jax.nn.gelu(g_lru.astype(jnp.float32))).astype(n.dtype)

    glu = a_glu * jax.nn.sigmoid(b_glu)
    c = depthwise_conv(glu, conf_conv_w, conf_conv_b, (CONF_KERNEL // 2, CONF_KERNEL // 2))
    y_conv = jax.nn.silu(group_layer_norm(c, conf_norm_g, conf_norm_b))

    y = jnp.concatenate([rms_norm(y_lru, beta_lru), rms_norm(y_conv, beta_conv)], axis=-1)
    return jnp.einsum("bse,ed->bsd", y, w_out.astype(y.dtype))


def peer_ffn(n, w_q, sub_keys, expert_u, expert_v):
    B_, S_, D = n.shape
    n_blocks = (B_ * S_) // PEER_BLOCK
    xb = n.reshape(n_blocks, PEER_BLOCK, D)

    def retrieve(xt):
        q = jnp.einsum("td,de->te", xt, w_q.astype(xt.dtype))
        q = q.reshape(PEER_BLOCK, PEER_HEADS, 2, PEER_HALF).astype(jnp.float32)
        s = jnp.einsum("thpc,hpkc->thpk", q, sub_keys.astype(jnp.float32))
        s1, i1 = lax.top_k(s[:, :, 0], PEER_TOPK)
        s2, i2 = lax.top_k(s[:, :, 1], PEER_TOPK)
        cand_s = (s1[..., :, None] + s2[..., None, :]).reshape(PEER_BLOCK, PEER_HEADS, PEER_TOPK * PEER_TOPK)
        cand_i = (i1[..., :, None] * PEER_N_KEYS + i2[..., None, :]).reshape(PEER_BLOCK, PEER_HEADS, PEER_TOPK * PEER_TOPK)
        top_s, pos = lax.top_k(cand_s, PEER_TOPK)
        idx = jnp.take_along_axis(cand_i, pos, axis=-1)
        gate = jax.nn.softmax(top_s, axis=-1)
        u = expert_u[idx]
        v = expert_v[idx]
        act = jax.nn.gelu(jnp.einsum("thkd,td->thk", u, xt))
        return jnp.einsum("thk,thkd->td", (gate * act).astype(v.dtype), v)

    out = lax.map(retrieve, xb)
    return out.reshape(B_, S_, D).astype(n.dtype)


def setup_inputs(seed: int = 0) -> dict:
    key = jax.random.key(seed)
    ks = jax.random.split(key, 24)
    L = DEPTH
    nrm = lambda k, shape, scale: jax.random.normal(k, shape, jnp.float32) * scale
    gain = lambda k, shape: 1.0 + 0.02 * jax.random.normal(k, shape, jnp.float32)
    a0 = jax.random.uniform(ks[9], (L, 2, D_LRU), jnp.float32, LRU_A_MIN, LRU_A_MAX)
    p = a0 ** (1.0 / LRU_C)
    lru_lambda = jnp.log(p) - jnp.log1p(-p)
    return {
        "x": nrm(ks[0], (BATCH, SEQ, D_MODEL), 1.0),
        "mix_norm_g": gain(ks[1], (L, D_MODEL)),
        "w_in": nrm(ks[2], (L, D_MODEL, 2 * D_LRU + 2 * D_CONV), D_MODEL ** -0.5),
        "lru_conv_w": nrm(ks[3], (L, LRU_CONV_WIDTH, D_LRU), LRU_CONV_WIDTH ** -0.5),
        "lru_conv_b": nrm(ks[4], (L, D_LRU), 0.02),
        "lru_w_rg": nrm(ks[5], (L, 2, LRU_HEADS, LRU_HEAD_DIM, LRU_HEAD_DIM), LRU_HEAD_DIM ** -0.5),
        "lru_b_rg": nrm(ks[6], (L, 2, D_LRU), 0.02),
        "lru_w_ig": nrm(ks[7], (L, 2, LRU_HEADS, LRU_HEAD_DIM, LRU_HEAD_DIM), LRU_HEAD_DIM ** -0.5),
        "lru_b_ig": nrm(ks[8], (L, 2, D_LRU), 0.02),
        "lru_lambda": lru_lambda,
        "conf_conv_w": nrm(ks[10], (L, CONF_KERNEL, D_CONV), CONF_KERNEL ** -0.5),
        "conf_conv_b": nrm(ks[11], (L, D_CONV), 0.02),
        "conf_norm_g": gain(ks[12], (L, D_CONV)),
        "conf_norm_b": nrm(ks[13], (L, D_CONV), 0.02),
        "beta_lru": gain(ks[14], (L, D_LRU)),
        "beta_conv": gain(ks[15], (L, D_CONV)),
        "w_out": nrm(ks[16], (L, D_MIX, D_MODEL), D_MIX ** -0.5),
        "ffn_norm_g": gain(ks[17], (L, D_MODEL)),
        "peer_w_q": nrm(ks[18], (L, D_MODEL, PEER_HEADS * PEER_D_QUERY), D_MODEL ** -0.5),
        "peer_sub_keys": nrm(ks[19], (L, PEER_HEADS, 2, PEER_N_KEYS, PEER_HALF), PEER_HALF ** -0.5),
        "peer_u": nrm(ks[20], (L, PEER_N_EXPERTS, D_MODEL), D_MODEL ** -0.5),
        "peer_v": nrm(ks[21], (L, PEER_N_EXPERTS, D_MODEL), PEER_HEADS ** -0.5),
        "final_norm_g": gain(ks[22], (D_MODEL,)),
    }


def reference(x, mix_norm_g, w_in, lru_conv_w, lru_conv_b, lru_w_rg, lru_b_rg, lru_w_ig,
              lru_b_ig, lru_lambda, conf_conv_w, conf_conv_b, conf_norm_g, conf_norm_b,
              beta_lru, beta_conv, w_out, ffn_norm_g, peer_w_q, peer_sub_keys, peer_u,
              peer_v, final_norm_g):
    h = x
    for l in range(DEPTH):
        h = h + hybrid_mixer(
            rms_norm(h, mix_norm_g[l]), w_in[l], lru_conv_w[l], lru_conv_b[l],
            lru_w_rg[l], lru_b_rg[l], lru_w_ig[l], lru_b_ig[l], lru_lambda[l],
            conf_conv_w[l], conf_conv_b[l], conf_norm_g[l], conf_norm_b[l],
            beta_lru[l], beta_conv[l], w_out[l])
        h = h + peer_ffn(rms_norm(h, ffn_norm_g[l]), peer_w_q[l], peer_sub_keys[l],
                         peer_u[l], peer_v[l])
    return rms_norm(h, final_norm_g)
```

```cpp
#include <hip/hip_runtime.h>
#include <hip/hip_bf16.h>
#include <stdint.h>

typedef unsigned short u16;
typedef __attribute__((ext_vector_type(8))) short bf16x8;
typedef __attribute__((ext_vector_type(4))) float f32x4;
typedef __attribute__((ext_vector_type(16))) float f32x16;

#define T_TOK 16384
#define SEQ 2048
#define NB 8
#define DM 1024
#define DL 512
#define EPS 1e-6f

__device__ __forceinline__ float bf2f(u16 v) { return __uint_as_float(((unsigned)v) << 16); }
__device__ __forceinline__ u16 f2bf(float f) {
  unsigned u = __float_as_uint(f);
  u += 0x7fffu + ((u >> 16) & 1u);
  return (u16)(u >> 16);
}
__device__ __forceinline__ float sigmoidf_(float x) { return 1.f / (1.f + __expf(-x)); }
__device__ __forceinline__ float gelu_tanh(float x) {
  float u = 0.7978845608028654f * (x + 0.044715f * x * x * x);
  float e = __expf(2.f * u);
  float th = 1.f - 2.f / (e + 1.f);
  return 0.5f * x * (1.f + th);
}
__device__ __forceinline__ float log_sigmoidf_(float x) {
  return fminf(x, 0.f) - log1pf(__expf(-fabsf(x)));
}
__device__ __forceinline__ float wave_sum(float v) {
#pragma unroll
  for (int o = 32; o > 0; o >>= 1) v += __shfl_xor(v, o, 64);
  return v;
}

struct WS {
  u16* xb;
  float* rs0;
  u16* WinT;
  u16* WoutT;
  u16* WqT;
  u16* keysb;
  u16* Wg;
  u16* Ub;
  u16* Vb;
  u16* xl;
  u16* gg;
  u16* glu;
  u16* y;
  float* ssq_lru;
  float* ssq_h1;
  unsigned* cand;
  u16* h1b;
  float* tmp_a;
  float* tmp_b;
};

static WS make_ws(void* d_ws) {
  char* p = (char*)d_ws;
  WS w;
  size_t off = 0;
  auto take = [&](size_t bytes) { char* r = p + off; off += (bytes + 255) & ~(size_t)255; return r; };
  w.xb = (u16*)take((size_t)T_TOK * 1024 * 2);
  w.rs0 = (float*)take((size_t)T_TOK * 4);
  w.WinT = (u16*)take((size_t)2048 * 1024 * 2);
  w.WoutT = (u16*)take((size_t)1024 * 1024 * 2);
  w.WqT = (u16*)take((size_t)2048 * 1024 * 2);
  w.keysb = (u16*)take((size_t)16 * 128 * 128 * 2);
  w.Wg = (u16*)take((size_t)2 * 8 * 4 * 32 * 64 * 2);
  w.Ub = (u16*)take((size_t)16384 * 1024 * 2);
  w.Vb = (u16*)take((size_t)16384 * 1024 * 2);
  w.xl = (u16*)take((size_t)T_TOK * 512 * 2);
  w.gg = (u16*)take((size_t)T_TOK * 512 * 2);
  w.glu = (u16*)take((size_t)T_TOK * 512 * 2);
  w.y = (u16*)take((size_t)T_TOK * 1024 * 2);
  w.ssq_lru = (float*)take((size_t)T_TOK * 32 * 4);
  w.ssq_h1 = (float*)take((size_t)T_TOK * 8 * 4);
  w.cand = (unsigned*)w.xl;
  w.h1b = w.xb;
  w.tmp_a = (float*)w.Ub;
  w.tmp_b = (float*)w.Vb;
  return w;
}

__global__ void __launch_bounds__(256) k_prep_x(const float* __restrict__ x, u16* __restrict__ xb, float* __restrict__ rs0) {
  int wave = threadIdx.x >> 6, lane = threadIdx.x & 63;
  int t = blockIdx.x * 4 + wave;
  const float4* xr = (const float4*)(x + (size_t)t * 1024);
  float ss = 0.f;
  float4 v[4];
#pragma unroll
  for (int i = 0; i < 4; ++i) {
    v[i] = xr[i * 64 + lane];
    ss += v[i].x * v[i].x + v[i].y * v[i].y + v[i].z * v[i].z + v[i].w * v[i].w;
  }
  ss = wave_sum(ss);
#pragma unroll
  for (int i = 0; i < 4; ++i) {
    ushort4 o;
    o.x = f2bf(v[i].x); o.y = f2bf(v[i].y); o.z = f2bf(v[i].z); o.w = f2bf(v[i].w);
    ((ushort4*)(xb + (size_t)t * 1024))[i * 64 + lane] = o;
  }
  if (lane == 0) rs0[t] = rsqrtf(ss * (1.f / 1024.f) + EPS);
}

__device__ __forceinline__ int win_orig_col(int np) {
  if (np < 1024) return np;
  int r = (np - 1024) >> 6, i = (np - 1024) & 63;
  return (i < 32) ? (1024 + 32 * r + i) : (1536 + 32 * r + (i - 32));
}

template <int MODE>
__global__ void __launch_bounds__(256) k_prep_wT(const float* __restrict__ w, const float* __restrict__ scale_a,
                                                const float* __restrict__ scale_b, u16* __restrict__ out, int N) {
  __shared__ float tile[32][33];
  int n0 = blockIdx.x * 32, k0 = blockIdx.y * 32;
  int tx = threadIdx.x & 31, ty = threadIdx.x >> 5;
  for (int i = ty; i < 32; i += 8) {
    int k = k0 + i;
    int n = n0 + tx;
    int col = (MODE == 1) ? win_orig_col(n) : n;
    float sc;
    if (MODE == 2) sc = (k < 512) ? scale_a[k] : scale_b[k - 512];
    else sc = scale_a[k];
    tile[i][tx] = sc * w[(size_t)k * N + col];
  }
  __syncthreads();
  for (int i = ty; i < 32; i += 8) {
    int n = n0 + i, k = k0 + tx;
    out[(size_t)n * 1024 + k] = f2bf(tile[tx][i]);
  }
}

__global__ void __launch_bounds__(256) k_prep_misc(const float* __restrict__ sub_keys, const float* __restrict__ w_rg,
                                                  const float* __restrict__ w_ig, u16* __restrict__ keysb,
                                                  u16* __restrict__ Wg) {
  int i = blockIdx.x * 256 + threadIdx.x;
  if (i < 16 * 128 * 128) keysb[i] = f2bf(sub_keys[i]);
  if (i < 2 * 8 * 4 * 32 * 64) {
    int k = i & 63, j = (i >> 6) & 31, qq = (i >> 11) & 3, hh = (i >> 13) & 7, dir = (i >> 16) & 1;
    int o = qq * 16 + (j & 15);
    const float* src = (j < 16) ? w_rg : w_ig;
    Wg[i] = f2bf(src[(((size_t)dir * 8 + hh) * 64 + k) * 64 + o]);
  }
}

__global__ void __launch_bounds__(256) k_prep_uv(const float* __restrict__ U, const float* __restrict__ V,
                                                const float* __restrict__ g2, u16* __restrict__ Ub, u16* __restrict__ Vb) {
  size_t i = ((size_t)blockIdx.x * 256 + threadIdx.x);
  if (i >= (size_t)16384 * 256) return;
  int d4 = (int)(i & 255);
  float4 g = ((const float4*)g2)[d4];
  float4 u = ((const float4*)U)[i];
  float4 v = ((const float4*)V)[i];
  ushort4 ou, ov;
  ou.x = f2bf(u.x * g.x); ou.y = f2bf(u.y * g.y); ou.z = f2bf(u.z * g.z); ou.w = f2bf(u.w * g.w);
  ov.x = f2bf(v.x); ov.y = f2bf(v.y); ov.z = f2bf(v.z); ov.w = f2bf(v.w);
  ((ushort4*)Ub)[i] = ou;
  ((ushort4*)Vb)[i] = ov;
}

__device__ __forceinline__ void load_rows8(const u16* __restrict__ A, int t0, float* xs) {
  for (int i = threadIdx.x; i < 8 * 1024; i += 256) xs[i] = bf2f(A[(size_t)t0 * 1024 + i]);
  __syncthreads();
}
__device__ __forceinline__ void dot8(const u16* __restrict__ wrow, const float* xs, int kbeg, int kend, float acc[8]) {
  for (int k = kbeg; k < kend; k += 8) {
    uint4 wv = *(const uint4*)(wrow + k);
    float wf[8];
    wf[0] = __uint_as_float(wv.x << 16); wf[1] = __uint_as_float(wv.x & 0xffff0000u);
    wf[2] = __uint_as_float(wv.y << 16); wf[3] = __uint_as_float(wv.y & 0xffff0000u);
    wf[4] = __uint_as_float(wv.z << 16); wf[5] = __uint_as_float(wv.z & 0xffff0000u);
    wf[6] = __uint_as_float(wv.w << 16); wf[7] = __uint_as_float(wv.w & 0xffff0000u);
#pragma unroll
    for (int r = 0; r < 8; ++r) {
      const float* xr = xs + r * 1024 + k;
      float a = acc[r];
#pragma unroll
      for (int j = 0; j < 8; ++j) a += wf[j] * xr[j];
      acc[r] = a;
    }
  }
}

__global__ void __launch_bounds__(256) k_n_gemm1(WS w) {
  __shared__ float xs[8 * 1024];
  int t0 = blockIdx.x * 8;
  load_rows8(w.xb, t0, xs);
  for (int c = threadIdx.x; c < 512; c += 256) {
    float a0[8] = {0}, a1[8] = {0}, a2[8] = {0}, a3[8] = {0};
    int na = 1024 + 64 * (c >> 5) + (c & 31);
    dot8(w.WinT + (size_t)c * 1024, xs, 0, 1024, a0);
    dot8(w.WinT + (size_t)(512 + c) * 1024, xs, 0, 1024, a1);
    dot8(w.WinT + (size_t)na * 1024, xs, 0, 1024, a2);
    dot8(w.WinT + (size_t)(na + 32) * 1024, xs, 0, 1024, a3);
    for (int r = 0; r < 8; ++r) {
      int t = t0 + r;
      float rs = w.rs0[t];
      w.xl[(size_t)t * 512 + c] = f2bf(rs * a0[r]);
      w.gg[(size_t)t * 512 + c] = f2bf(gelu_tanh(rs * a1[r]));
      w.glu[(size_t)t * 512 + c] = f2bf(rs * a2[r] * sigmoidf_(rs * a3[r]));
    }
  }
}

__global__ void __launch_bounds__(256) k_n_xc(WS w, const float* __restrict__ cw, const float* __restrict__ cb, float* __restrict__ xc) {
  int i = blockIdx.x * 256 + threadIdx.x;
  int c = i & 511, t = i >> 9, s = t & (SEQ - 1);
  float acc = cb[c];
#pragma unroll
  for (int k = 0; k < 4; ++k) {
    int ss = s - 2 + k;
    if (ss >= 0 && ss < SEQ) acc += cw[k * 512 + c] * bf2f(w.xl[(size_t)(t - 2 + k) * 512 + c]);
  }
  xc[i] = acc;
}

template <int DIR>
__global__ void __launch_bounds__(64) k_n_scan(WS w, const float* __restrict__ xc, float* __restrict__ hf,
                                              const float* __restrict__ b_rg, const float* __restrict__ b_ig,
                                              const float* __restrict__ lam) {
  int b = blockIdx.x >> 3, hh = blockIdx.x & 7;
  int cl = threadIdx.x;
  int c = hh * 64 + cl;
  int qq = cl >> 4, j = cl & 15;
  const u16* wr = w.Wg + ((((size_t)DIR * 8 + hh) * 4 + qq) * 32 + j) * 64;
  const u16* wi = wr + 16 * 64;
  float wrf[64], wif[64];
#pragma unroll
  for (int k = 0; k < 64; ++k) { wrf[k] = bf2f(wr[k]); wif[k] = bf2f(wi[k]); }
  float br = b_rg[DIR * 512 + c], bi = b_ig[DIR * 512 + c];
  float Kc = 8.f * log_sigmoidf_(lam[DIR * 512 + c]);
  float h = 0.f;
  for (int st = 0; st < SEQ; ++st) {
    int s = DIR ? (SEQ - 1 - st) : st;
    size_t t = (size_t)b * SEQ + s;
    const float* xr = xc + t * 512 + hh * 64;
    float pr = br, pi = bi;
#pragma unroll
    for (int k = 0; k < 64; ++k) { float xv = xr[k]; pr += xv * wrf[k]; pi += xv * wif[k]; }
    float r = sigmoidf_(pr), ig = sigmoidf_(pi);
    float a = __expf(Kc * r);
    float u = sqrtf(fmaxf(1.f - a * a, 0.f)) * ig * xr[cl];
    h = a * h + u;
    if (DIR == 0) hf[t * 512 + c] = h;
    else {
      float yv = (hf[t * 512 + c] + h) * bf2f(w.gg[t * 512 + c]);
      w.y[t * 1024 + c] = f2bf(yv);
    }
  }
}

__global__ void __launch_bounds__(256) k_n_ssq_lru(WS w) {
  int i = blockIdx.x * 256 + threadIdx.x;
  int t = i >> 5, g = i & 31;
  float s = 0.f;
  for (int k = 0; k < 16; ++k) { float v = bf2f(w.y[(size_t)t * 1024 + g * 16 + k]); s += v * v; }
  w.ssq_lru[i] = s;
}

__global__ void __launch_bounds__(512) k_n_conv(WS w, const float* __restrict__ cw, const float* __restrict__ cb,
                                               const float* __restrict__ ng, const float* __restrict__ nb) {
  __shared__ float red[8];
  int t = blockIdx.x, s = t & (SEQ - 1), c = threadIdx.x;
  float acc = cb[c];
  for (int k = 0; k < 31; ++k) {
    int ss = s - 15 + k;
    if (ss >= 0 && ss < SEQ) acc += cw[k * 512 + c] * bf2f(w.glu[(size_t)(t - 15 + k) * 512 + c]);
  }
  float mu = wave_sum(acc) * (1.f / 64.f);
  float d = acc - mu;
  float var = wave_sum(d * d) * (1.f / 64.f);
  float v = d * rsqrtf(var + EPS) * ng[c] + nb[c];
  float yv = v * sigmoidf_(v);
  float sq = wave_sum(yv * yv);
  if ((c & 63) == 0) red[c >> 6] = sq;
  __syncthreads();
  float tot = 0.f;
  for (int i = 0; i < 8; ++i) tot += red[i];
  float rc = rsqrtf(tot * (1.f / 512.f) + EPS);
  w.y[(size_t)t * 1024 + 512 + c] = f2bf(yv * rc);
}

__global__ void __launch_bounds__(256) k_n_gemm2(WS w, const float* __restrict__ x, float* __restrict__ h1) {
  __shared__ float xs[8 * 1024];
  int t0 = blockIdx.x * 8;
  load_rows8(w.y, t0, xs);
  float rl[8];
  for (int r = 0; r < 8; ++r) {
    float s = 0.f;
    for (int g = 0; g < 32; ++g) s += w.ssq_lru[(size_t)(t0 + r) * 32 + g];
    rl[r] = rsqrtf(s * (1.f / 512.f) + EPS);
  }
  for (int n = threadIdx.x; n < 1024; n += 256) {
    float a0[8] = {0}, a1[8] = {0};
    dot8(w.WoutT + (size_t)n * 1024, xs, 0, 512, a0);
    dot8(w.WoutT + (size_t)n * 1024, xs, 512, 1024, a1);
    for (int r = 0; r < 8; ++r) {
      size_t o = (size_t)(t0 + r) * 1024 + n;
      float hv = x[o] + rl[r] * a0[r] + a1[r];
      h1[o] = hv;
    }
  }
}
__global__ void __launch_bounds__(256) k_n_h1stat(WS w, const float* __restrict__ h1) {
  int wave = threadIdx.x >> 6, lane = threadIdx.x & 63;
  int t = blockIdx.x * 4 + wave;
  float ss = 0.f;
  for (int i = 0; i < 16; ++i) {
    float v = h1[(size_t)t * 1024 + lane * 16 + i];
    ss += v * v;
    w.h1b[(size_t)t * 1024 + lane * 16 + i] = f2bf(v);
  }
  ss += __shfl_xor(ss, 1, 64); ss += __shfl_xor(ss, 2, 64); ss += __shfl_xor(ss, 4, 64);
  if ((lane & 7) == 0) w.ssq_h1[(size_t)t * 8 + (lane >> 3)] = ss;
}

__device__ __forceinline__ float rs2_of(const float* ssq_h1, int t) {
  float s = 0.f;
  for (int j = 0; j < 8; ++j) s += ssq_h1[(size_t)t * 8 + j];
  return rsqrtf(s * (1.f / 1024.f) + EPS);
}

__global__ void __launch_bounds__(256) k_n_gemm3(WS w, u16* __restrict__ qb) {
  __shared__ float xs[8 * 1024];
  int t0 = blockIdx.x * 8;
  load_rows8(w.h1b, t0, xs);
  float rs[8];
  for (int r = 0; r < 8; ++r) rs[r] = rs2_of(w.ssq_h1, t0 + r);
  for (int n = threadIdx.x; n < 2048; n += 256) {
    float a0[8] = {0};
    dot8(w.WqT + (size_t)n * 1024, xs, 0, 1024, a0);
    for (int r = 0; r < 8; ++r) qb[(size_t)(t0 + r) * 2048 + n] = f2bf(rs[r] * a0[r]);
  }
}
__global__ void __launch_bounds__(256) k_n_topk(WS w, const u16* __restrict__ qb) {
  __shared__ float sc[16 * 128];
  __shared__ float qs[2048];
  int t = blockIdx.x;
  for (int i = threadIdx.x; i < 2048; i += 256) qs[i] = bf2f(qb[(size_t)t * 2048 + i]);
  __syncthreads();
  for (int i = threadIdx.x; i < 2048; i += 256) {
    int hp = i >> 7, key = i & 127;
    const u16* kr = w.keysb + ((size_t)hp * 128 + key) * 128;
    float a = 0.f;
    for (int c = 0; c < 128; ++c) a += qs[hp * 128 + c] * bf2f(kr[c]);
    sc[i] = a;
  }
  __syncthreads();
  if (threadIdx.x < 16) {
    int hp = threadIdx.x;
    float* s = sc + hp * 128;
    for (int j = 0; j < 16; ++j) {
      float best = -3.0e38f; int bi = 0;
      for (int k = 0; k < 128; ++k) if (s[k] > best) { best = s[k]; bi = k; }
      s[bi] = -3.0e38f;
      w.cand[((size_t)t * 16 + hp) * 16 + j] = (__float_as_uint(best) & ~127u) | (unsigned)bi;
    }
  }
}

__global__ void __launch_bounds__(256) k_n_peer(WS w, const float* h1, const float* __restrict__ gF, float* out) {
  __shared__ float cs[8][256];
  __shared__ int ce[8][256];
  __shared__ int sel_e[128];
  __shared__ float sel_g[128];
  __shared__ float wj[128];
  __shared__ float hs[1024];
  __shared__ float red[4];
  int t = blockIdx.x, tid = threadIdx.x;
  for (int i = tid; i < 1024; i += 256) hs[i] = bf2f(w.h1b[(size_t)t * 1024 + i]);
  for (int h = 0; h < 8; ++h) {
    int a = tid >> 4, b = tid & 15;
    unsigned pa = w.cand[((size_t)t * 16 + 2 * h) * 16 + a];
    unsigned pb = w.cand[((size_t)t * 16 + 2 * h + 1) * 16 + b];
    cs[h][tid] = __uint_as_float(pa) + __uint_as_float(pb);
    ce[h][tid] = (int)(pa & 127u) * 128 + (int)(pb & 127u);
  }
  __syncthreads();
  if (tid < 8) {
    int h = tid;
    float top[16]; int te[16];
    float mx = -3.0e38f;
    for (int j = 0; j < 16; ++j) {
      float best = -3.0e38f; int bi = 0;
      for (int k = 0; k < 256; ++k) if (cs[h][k] > best) { best = cs[h][k]; bi = k; }
      cs[h][bi] = -3.0e38f;
      top[j] = best; te[j] = ce[h][bi];
      mx = fmaxf(mx, best);
    }
    float sum = 0.f;
    for (int j = 0; j < 16; ++j) { top[j] = __expf(top[j] - mx); sum += top[j]; }
    float inv = 1.f / sum;
    for (int j = 0; j < 16; ++j) { sel_e[h * 16 + j] = te[j]; sel_g[h * 16 + j] = top[j] * inv; }
  }
  __syncthreads();
  float rs2 = rs2_of(w.ssq_h1, t);
  int wave = tid >> 6, lane = tid & 63;
  for (int j = wave; j < 128; j += 4) {
    const u16* ur = w.Ub + (size_t)sel_e[j] * 1024;
    float a = 0.f;
    for (int i = 0; i < 16; ++i) a += bf2f(ur[lane * 16 + i]) * hs[lane * 16 + i];
    a = wave_sum(a);
    if (lane == 0) wj[j] = sel_g[j] * gelu_tanh(rs2 * a);
  }
  __syncthreads();
  float acc[4] = {0, 0, 0, 0};
  for (int j = 0; j < 128; ++j) {
    const u16* vr = w.Vb + (size_t)sel_e[j] * 1024;
    float ww = wj[j];
#pragma unroll
    for (int i = 0; i < 4; ++i) acc[i] += ww * bf2f(vr[tid * 4 + i]);
  }
  float hv[4]; float ss = 0.f;
#pragma unroll
  for (int i = 0; i < 4; ++i) { hv[i] = h1[(size_t)t * 1024 + tid * 4 + i] + acc[i]; ss += hv[i] * hv[i]; }
  ss = wave_sum(ss);
  if (lane == 0) red[wave] = ss;
  __syncthreads();
  float tot = red[0] + red[1] + red[2] + red[3];
  float rn = rsqrtf(tot * (1.f / 1024.f) + EPS);
#pragma unroll
  for (int i = 0; i < 4; ++i) out[(size_t)t * 1024 + tid * 4 + i] = hv[i] * rn * gF[tid * 4 + i];
}

extern "C" void kernel_launch(void* const* d_in, const int* in_sizes, int n_in, void* d_out, int out_size, void* d_ws,
                              size_t ws_size, hipStream_t stream) {
  const float* x = (const float*)d_in[0];
  const float* mix_norm_g = (const float*)d_in[1];
  const float* w_in = (const float*)d_in[2];
  const float* lru_conv_w = (const float*)d_in[3];
  const float* lru_conv_b = (const float*)d_in[4];
  const float* lru_w_rg = (const float*)d_in[5];
  const float* lru_b_rg = (const float*)d_in[6];
  const float* lru_w_ig = (const float*)d_in[7];
  const float* lru_b_ig = (const float*)d_in[8];
  const float* lru_lambda = (const float*)d_in[9];
  const float* conf_conv_w = (const float*)d_in[10];
  const float* conf_conv_b = (const float*)d_in[11];
  const float* conf_norm_g = (const float*)d_in[12];
  const float* conf_norm_b = (const float*)d_in[13];
  const float* beta_lru = (const float*)d_in[14];
  const float* beta_conv = (const float*)d_in[15];
  const float* w_out = (const float*)d_in[16];
  const float* ffn_norm_g = (const float*)d_in[17];
  const float* peer_w_q = (const float*)d_in[18];
  const float* peer_sub_keys = (const float*)d_in[19];
  const float* peer_u = (const float*)d_in[20];
  const float* peer_v = (const float*)d_in[21];
  const float* final_norm_g = (const float*)d_in[22];
  float* out = (float*)d_out;
  WS w = make_ws(d_ws);

  k_prep_x<<<T_TOK / 4, 256, 0, stream>>>(x, w.xb, w.rs0);
  k_prep_wT<1><<<dim3(2048 / 32, 32), 256, 0, stream>>>(w_in, mix_norm_g, nullptr, w.WinT, 2048);
  k_prep_wT<2><<<dim3(1024 / 32, 32), 256, 0, stream>>>(w_out, beta_lru, beta_conv, w.WoutT, 1024);
  k_prep_wT<0><<<dim3(2048 / 32, 32), 256, 0, stream>>>(peer_w_q, ffn_norm_g, nullptr, w.WqT, 2048);
  k_prep_misc<<<(16 * 128 * 128 + 255) / 256, 256, 0, stream>>>(peer_sub_keys, lru_w_rg, lru_w_ig, w.keysb, w.Wg);

  k_n_gemm1<<<T_TOK / 8, 256, 0, stream>>>(w);
  k_n_xc<<<T_TOK * 512 / 256, 256, 0, stream>>>(w, lru_conv_w, lru_conv_b, w.tmp_a);
  k_n_scan<0><<<64, 64, 0, stream>>>(w, w.tmp_a, w.tmp_b, lru_b_rg, lru_b_ig, lru_lambda);
  k_n_scan<1><<<64, 64, 0, stream>>>(w, w.tmp_a, w.tmp_b, lru_b_rg, lru_b_ig, lru_lambda);
  k_n_ssq_lru<<<T_TOK * 32 / 256, 256, 0, stream>>>(w);
  k_n_conv<<<T_TOK, 512, 0, stream>>>(w, conf_conv_w, conf_conv_b, conf_norm_g, conf_norm_b);
  k_n_gemm2<<<T_TOK / 8, 256, 0, stream>>>(w, x, out);
  k_n_h1stat<<<T_TOK / 4, 256, 0, stream>>>(w, out);
  u16* qb = (u16*)w.Ub;
  k_n_gemm3<<<T_TOK / 8, 256, 0, stream>>>(w, qb);
  k_n_topk<<<T_TOK, 256, 0, stream>>>(w, qb);
  k_prep_uv<<<16384 * 256 / 256, 256, 0, stream>>>(peer_u, peer_v, ffn_norm_g, w.Ub, w.Vb);
  k_n_peer<<<T_TOK, 256, 0, stream>>>(w, out, final_norm_g, out);
}
```

```cpp
#include <hip/hip_runtime.h>
#include <hip/hip_bf16.h>
#include <stdint.h>

typedef unsigned short u16;
typedef __attribute__((ext_vector_type(8))) short bf16x8;
typedef __attribute__((ext_vector_type(4))) float f32x4;
typedef __attribute__((ext_vector_type(16))) float f32x16;

#define T_TOK 16384
#define SEQ 2048
#define NB 8
#define DM 1024
#define DL 512
#define EPS 1e-6f

__device__ __forceinline__ float bf2f(u16 v) { return __uint_as_float(((unsigned)v) << 16); }
__device__ __forceinline__ u16 f2bf(float f) {
  unsigned u = __float_as_uint(f);
  u += 0x7fffu + ((u >> 16) & 1u);
  return (u16)(u >> 16);
}
__device__ __forceinline__ float sigmoidf_(float x) { return 1.f / (1.f + __expf(-x)); }
__device__ __forceinline__ float gelu_tanh(float x) {
  float u = 0.7978845608028654f * (x + 0.044715f * x * x * x);
  float e = __expf(2.f * u);
  float th = 1.f - 2.f / (e + 1.f);
  return 0.5f * x * (1.f + th);
}
__device__ __forceinline__ float log_sigmoidf_(float x) {
  return fminf(x, 0.f) - log1pf(__expf(-fabsf(x)));
}
__device__ __forceinline__ float wave_sum(float v) {
#pragma unroll
  for (int o = 32; o > 0; o >>= 1) v += __shfl_xor(v, o, 64);
  return v;
}

struct WS {
  u16* xb;
  float* rs0;
  u16* WinT;
  u16* WoutT;
  u16* WqT;
  u16* keysb;
  u16* Wg;
  u16* Ub;
  u16* Vb;
  u16* xl;
  u16* gg;
  u16* glu;
  u16* y;
  float* ssq_lru;
  float* ssq_h1;
  unsigned* cand;
  u16* h1b;
  float* tmp_a;
  float* tmp_b;
};

static WS make_ws(void* d_ws) {
  char* p = (char*)d_ws;
  WS w;
  size_t off = 0;
  auto take = [&](size_t bytes) { char* r = p + off; off += (bytes + 255) & ~(size_t)255; return r; };
  w.xb = (u16*)take((size_t)T_TOK * 1024 * 2);
  w.rs0 = (float*)take((size_t)T_TOK * 4);
  w.WinT = (u16*)take((size_t)2048 * 1024 * 2);
  w.WoutT = (u16*)take((size_t)1024 * 1024 * 2);
  w.WqT = (u16*)take((size_t)2048 * 1024 * 2);
  w.keysb = (u16*)take((size_t)16 * 128 * 128 * 2);
  w.Wg = (u16*)take((size_t)2 * 8 * 4 * 32 * 64 * 2);
  w.Ub = (u16*)take((size_t)16384 * 1024 * 2);
  w.Vb = (u16*)take((size_t)16384 * 1024 * 2);
  w.xl = (u16*)take((size_t)T_TOK * 512 * 2);
  w.gg = (u16*)take((size_t)T_TOK * 512 * 2);
  w.glu = (u16*)take((size_t)T_TOK * 512 * 2);
  w.y = (u16*)take((size_t)T_TOK * 1024 * 2);
  w.ssq_lru = (float*)take((size_t)T_TOK * 32 * 4);
  w.ssq_h1 = (float*)take((size_t)T_TOK * 16 * 4);
  w.cand = (unsigned*)w.xl;
  w.h1b = w.xb;
  w.tmp_a = (float*)w.Ub;
  w.tmp_b = (float*)w.Vb;
  return w;
}

__global__ void __launch_bounds__(256) k_prep_x(const float* __restrict__ x, u16* __restrict__ xb, float* __restrict__ rs0) {
  int wave = threadIdx.x >> 6, lane = threadIdx.x & 63;
  int t = blockIdx.x * 4 + wave;
  const float4* xr = (const float4*)(x + (size_t)t * 1024);
  float ss = 0.f;
  float4 v[4];
#pragma unroll
  for (int i = 0; i < 4; ++i) {
    v[i] = xr[i * 64 + lane];
    ss += v[i].x * v[i].x + v[i].y * v[i].y + v[i].z * v[i].z + v[i].w * v[i].w;
  }
  ss = wave_sum(ss);
#pragma unroll
  for (int i = 0; i < 4; ++i) {
    ushort4 o;
    o.x = f2bf(v[i].x); o.y = f2bf(v[i].y); o.z = f2bf(v[i].z); o.w = f2bf(v[i].w);
    ((ushort4*)(xb + (size_t)t * 1024))[i * 64 + lane] = o;
  }
  if (lane == 0) rs0[t] = rsqrtf(ss * (1.f / 1024.f) + EPS);
}

__device__ __forceinline__ int win_orig_col(int np) {
  if (np < 1024) return np;
  int r = (np - 1024) >> 6, i = (np - 1024) & 63;
  return (i < 32) ? (1024 + 32 * r + i) : (1536 + 32 * r + (i - 32));
}

template <int MODE>
__global__ void __launch_bounds__(256) k_prep_wT(const float* __restrict__ w, const float* __restrict__ scale_a,
                                                const float* __restrict__ scale_b, u16* __restrict__ out, int N) {
  __shared__ float tile[32][33];
  int n0 = blockIdx.x * 32, k0 = blockIdx.y * 32;
  int tx = threadIdx.x & 31, ty = threadIdx.x >> 5;
  for (int i = ty; i < 32; i += 8) {
    int k = k0 + i;
    int n = n0 + tx;
    int col = (MODE == 1) ? win_orig_col(n) : n;
    float sc;
    if (MODE == 2) sc = (k < 512) ? scale_a[k] : scale_b[k - 512];
    else sc = scale_a[k];
    tile[i][tx] = sc * w[(size_t)k * N + col];
  }
  __syncthreads();
  for (int i = ty; i < 32; i += 8) {
    int n = n0 + i, k = k0 + tx;
    out[(size_t)n * 1024 + k] = f2bf(tile[tx][i]);
  }
}

__global__ void __launch_bounds__(256) k_prep_misc(const float* __restrict__ sub_keys, const float* __restrict__ w_rg,
                                                  const float* __restrict__ w_ig, u16* __restrict__ keysb,
                                                  u16* __restrict__ Wg) {
  int i = blockIdx.x * 256 + threadIdx.x;
  if (i < 16 * 128 * 128) keysb[i] = f2bf(sub_keys[i]);
  if (i < 2 * 8 * 4 * 32 * 64) {
    int k = i & 63, j = (i >> 6) & 31, qq = (i >> 11) & 3, hh = (i >> 13) & 7, dir = (i >> 16) & 1;
    int o = qq * 16 + (j & 15);
    const float* src = (j < 16) ? w_rg : w_ig;
    Wg[i] = f2bf(src[(((size_t)dir * 8 + hh) * 64 + k) * 64 + o]);
  }
}

__global__ void __launch_bounds__(256) k_prep_uv(const float* __restrict__ U, const float* __restrict__ V,
                                                const float* __restrict__ g2, u16* __restrict__ Ub, u16* __restrict__ Vb) {
  size_t i = ((size_t)blockIdx.x * 256 + threadIdx.x);
  if (i >= (size_t)16384 * 256) return;
  int d4 = (int)(i & 255);
  float4 g = ((const float4*)g2)[d4];
  float4 u = ((const float4*)U)[i];
  float4 v = ((const float4*)V)[i];
  ushort4 ou, ov;
  ou.x = f2bf(u.x * g.x); ou.y = f2bf(u.y * g.y); ou.z = f2bf(u.z * g.z); ou.w = f2bf(u.w * g.w);
  ov.x = f2bf(v.x); ov.y = f2bf(v.y); ov.z = f2bf(v.z); ov.w = f2bf(v.w);
  ((ushort4*)Ub)[i] = ou;
  ((ushort4*)Vb)[i] = ov;
}

__device__ __forceinline__ void load_rows8(const u16* __restrict__ A, int t0, float* xs) {
  for (int i = threadIdx.x; i < 8 * 1024; i += 256) xs[i] = bf2f(A[(size_t)t0 * 1024 + i]);
  __syncthreads();
}
__device__ __forceinline__ void dot8(const u16* __restrict__ wrow, const float* xs, int kbeg, int kend, float acc[8]) {
  for (int k = kbeg; k < kend; k += 8) {
    uint4 wv = *(const uint4*)(wrow + k);
    float wf[8];
    wf[0] = __uint_as_float(wv.x << 16); wf[1] = __uint_as_float(wv.x & 0xffff0000u);
    wf[2] = __uint_as_float(wv.y << 16); wf[3] = __uint_as_float(wv.y & 0xffff0000u);
    wf[4] = __uint_as_float(wv.z << 16); wf[5] = __uint_as_float(wv.z & 0xffff0000u);
    wf[6] = __uint_as_float(wv.w << 16); wf[7] = __uint_as_float(wv.w & 0xffff0000u);
#pragma unroll
    for (int r = 0; r < 8; ++r) {
      const float* xr = xs + r * 1024 + k;
      float a = acc[r];
#pragma unroll
      for (int j = 0; j < 8; ++j) a += wf[j] * xr[j];
      acc[r] = a;
    }
  }
}

__global__ void __launch_bounds__(256) k_n_gemm1(WS w) {
  __shared__ float xs[8 * 1024];
  int t0 = blockIdx.x * 8;
  load_rows8(w.xb, t0, xs);
  for (int c = threadIdx.x; c < 512; c += 256) {
    float a0[8] = {0}, a1[8] = {0}, a2[8] = {0}, a3[8] = {0};
    int na = 1024 + 64 * (c >> 5) + (c & 31);
    dot8(w.WinT + (size_t)c * 1024, xs, 0, 1024, a0);
    dot8(w.WinT + (size_t)(512 + c) * 1024, xs, 0, 1024, a1);
    dot8(w.WinT + (size_t)na * 1024, xs, 0, 1024, a2);
    dot8(w.WinT + (size_t)(na + 32) * 1024, xs, 0, 1024, a3);
    for (int r = 0; r < 8; ++r) {
      int t = t0 + r;
      float rs = w.rs0[t];
      w.xl[(size_t)t * 512 + c] = f2bf(rs * a0[r]);
      w.gg[(size_t)t * 512 + c] = f2bf(gelu_tanh(rs * a1[r]));
      w.glu[(size_t)t * 512 + c] = f2bf(rs * a2[r] * sigmoidf_(rs * a3[r]));
    }
  }
}

__global__ void __launch_bounds__(256) k_n_xc(WS w, const float* __restrict__ cw, const float* __restrict__ cb, float* __restrict__ xc) {
  int i = blockIdx.x * 256 + threadIdx.x;
  int c = i & 511, t = i >> 9, s = t & (SEQ - 1);
  float acc = cb[c];
#pragma unroll
  for (int k = 0; k < 4; ++k) {
    int ss = s - 2 + k;
    if (ss >= 0 && ss < SEQ) acc += cw[k * 512 + c] * bf2f(w.xl[(size_t)(t - 2 + k) * 512 + c]);
  }
  xc[i] = acc;
}

template <int DIR>
__global__ void __launch_bounds__(64) k_n_scan(WS w, const float* __restrict__ xc, float* __restrict__ hf,
                                              const float* __restrict__ b_rg, const float* __restrict__ b_ig,
                                              const float* __restrict__ lam) {
  int b = blockIdx.x >> 3, hh = blockIdx.x & 7;
  int cl = threadIdx.x;
  int c = hh * 64 + cl;
  int qq = cl >> 4, j = cl & 15;
  const u16* wr = w.Wg + ((((size_t)DIR * 8 + hh) * 4 + qq) * 32 + j) * 64;
  const u16* wi = wr + 16 * 64;
  float wrf[64], wif[64];
#pragma unroll
  for (int k = 0; k < 64; ++k) { wrf[k] = bf2f(wr[k]); wif[k] = bf2f(wi[k]); }
  float br = b_rg[DIR * 512 + c], bi = b_ig[DIR * 512 + c];
  float Kc = 8.f * log_sigmoidf_(lam[DIR * 512 + c]);
  float h = 0.f;
  for (int st = 0; st < SEQ; ++st) {
    int s = DIR ? (SEQ - 1 - st) : st;
    size_t t = (size_t)b * SEQ + s;
    const float* xr = xc + t * 512 + hh * 64;
    float pr = br, pi = bi;
#pragma unroll
    for (int k = 0; k < 64; ++k) { float xv = xr[k]; pr += xv * wrf[k]; pi += xv * wif[k]; }
    float r = sigmoidf_(pr), ig = sigmoidf_(pi);
    float a = __expf(Kc * r);
    float u = sqrtf(fmaxf(1.f - a * a, 0.f)) * ig * xr[cl];
    h = a * h + u;
    if (DIR == 0) hf[t * 512 + c] = h;
    else {
      float yv = (hf[t * 512 + c] + h) * bf2f(w.gg[t * 512 + c]);
      w.y[t * 1024 + c] = f2bf(yv);
    }
  }
}

__global__ void __launch_bounds__(256) k_n_ssq_lru(WS w) {
  int i = blockIdx.x * 256 + threadIdx.x;
  int t = i >> 5, g = i & 31;
  float s = 0.f;
  for (int k = 0; k < 16; ++k) { float v = bf2f(w.y[(size_t)t * 1024 + g * 16 + k]); s += v * v; }
  w.ssq_lru[i] = s;
}

__global__ void __launch_bounds__(512) k_n_conv(WS w, const float* __restrict__ cw, const float* __restrict__ cb,
                                               const float* __restrict__ ng, const float* __restrict__ nb) {
  __shared__ float red[8];
  int t = blockIdx.x, s = t & (SEQ - 1), c = threadIdx.x;
  float acc = cb[c];
  for (int k = 0; k < 31; ++k) {
    int ss = s - 15 + k;
    if (ss >= 0 && ss < SEQ) acc += cw[k * 512 + c] * bf2f(w.glu[(size_t)(t - 15 + k) * 512 + c]);
  }
  float mu = wave_sum(acc) * (1.f / 64.f);
  float d = acc - mu;
  float var = wave_sum(d * d) * (1.f / 64.f);
  float v = d * rsqrtf(var + EPS) * ng[c] + nb[c];
  float yv = v * sigmoidf_(v);
  float sq = wave_sum(yv * yv);
  if ((c & 63) == 0) red[c >> 6] = sq;
  __syncthreads();
  float tot = 0.f;
  for (int i = 0; i < 8; ++i) tot += red[i];
  float rc = rsqrtf(tot * (1.f / 512.f) + EPS);
  w.y[(size_t)t * 1024 + 512 + c] = f2bf(yv * rc);
}

__global__ void __launch_bounds__(256) k_n_gemm2(WS w, const float* __restrict__ x, float* __restrict__ h1) {
  __shared__ float xs[8 * 1024];
  int t0 = blockIdx.x * 8;
  load_rows8(w.y, t0, xs);
  float rl[8];
  for (int r = 0; r < 8; ++r) {
    float s = 0.f;
    for (int g = 0; g < 32; ++g) s += w.ssq_lru[(size_t)(t0 + r) * 32 + g];
    rl[r] = rsqrtf(s * (1.f / 512.f) + EPS);
  }
  for (int n = threadIdx.x; n < 1024; n += 256) {
    float a0[8] = {0}, a1[8] = {0};
    dot8(w.WoutT + (size_t)n * 1024, xs, 0, 512, a0);
    dot8(w.WoutT + (size_t)n * 1024, xs, 512, 1024, a1);
    for (int r = 0; r < 8; ++r) {
      size_t o = (size_t)(t0 + r) * 1024 + n;
      float hv = x[o] + rl[r] * a0[r] + a1[r];
      h1[o] = hv;
    }
  }
}
__global__ void __launch_bounds__(256) k_n_h1stat(WS w, const float* __restrict__ h1) {
  int wave = threadIdx.x >> 6, lane = threadIdx.x & 63;
  int t = blockIdx.x * 4 + wave;
  float ss = 0.f;
  for (int i = 0; i < 16; ++i) {
    float v = h1[(size_t)t * 1024 + lane * 16 + i];
    ss += v * v;
    w.h1b[(size_t)t * 1024 + lane * 16 + i] = f2bf(v);
  }
  ss += __shfl_xor(ss, 1, 64); ss += __shfl_xor(ss, 2, 64);
  if ((lane & 3) == 0) w.ssq_h1[(size_t)t * 16 + (lane >> 2)] = ss;
}

__device__ __forceinline__ float rs2_of(const float* ssq_h1, int t) {
  float s = 0.f;
  for (int j = 0; j < 16; ++j) s += ssq_h1[(size_t)t * 16 + j];
  return rsqrtf(s * (1.f / 1024.f) + EPS);
}

__global__ void __launch_bounds__(256) k_n_gemm3(WS w, u16* __restrict__ qb) {
  __shared__ float xs[8 * 1024];
  int t0 = blockIdx.x * 8;
  load_rows8(w.h1b, t0, xs);
  float rs[8];
  for (int r = 0; r < 8; ++r) rs[r] = rs2_of(w.ssq_h1, t0 + r);
  for (int n = threadIdx.x; n < 2048; n += 256) {
    float a0[8] = {0};
    dot8(w.WqT + (size_t)n * 1024, xs, 0, 1024, a0);
    for (int r = 0; r < 8; ++r) qb[(size_t)(t0 + r) * 2048 + n] = f2bf(rs[r] * a0[r]);
  }
}
__global__ void __launch_bounds__(256) k_n_topk(WS w, const u16* __restrict__ qb) {
  __shared__ float sc[16 * 128];
  __shared__ float qs[2048];
  int t = blockIdx.x;
  for (int i = threadIdx.x; i < 2048; i += 256) qs[i] = bf2f(qb[(size_t)t * 2048 + i]);
  __syncthreads();
  for (int i = threadIdx.x; i < 2048; i += 256) {
    int hp = i >> 7, key = i & 127;
    const u16* kr = w.keysb + ((size_t)hp * 128 + key) * 128;
    float a = 0.f;
    for (int c = 0; c < 128; ++c) a += qs[hp * 128 + c] * bf2f(kr[c]);
    sc[i] = a;
  }
  __syncthreads();
  if (threadIdx.x < 16) {
    int hp = threadIdx.x;
    float* s = sc + hp * 128;
    for (int j = 0; j < 16; ++j) {
      float best = -3.0e38f; int bi = 0;
      for (int k = 0; k < 128; ++k) if (s[k] > best) { best = s[k]; bi = k; }
      s[bi] = -3.0e38f;
      w.cand[((size_t)t * 16 + hp) * 16 + j] = (__float_as_uint(best) & ~127u) | (unsigned)bi;
    }
  }
}

__global__ void __launch_bounds__(256) k_n_peer(WS w, const float* h1, const float* __restrict__ gF, float* out) {
  __shared__ float cs[8][256];
  __shared__ int ce[8][256];
  __shared__ int sel_e[128];
  __shared__ float sel_g[128];
  __shared__ float wj[128];
  __shared__ float hs[1024];
  __shared__ float red[4];
  int t = blockIdx.x, tid = threadIdx.x;
  for (int i = tid; i < 1024; i += 256) hs[i] = bf2f(w.h1b[(size_t)t * 1024 + i]);
  for (int h = 0; h < 8; ++h) {
    int a = tid >> 4, b = tid & 15;
    unsigned pa = w.cand[((size_t)t * 16 + 2 * h) * 16 + a];
    unsigned pb = w.cand[((size_t)t * 16 + 2 * h + 1) * 16 + b];
    cs[h][tid] = __uint_as_float(pa) + __uint_as_float(pb);
    ce[h][tid] = (int)(pa & 127u) * 128 + (int)(pb & 127u);
  }
  __syncthreads();
  if (tid < 8) {
    int h = tid;
    float top[16]; int te[16];
    float mx = -3.0e38f;
    for (int j = 0; j < 16; ++j) {
      float best = -3.0e38f; int bi = 0;
      for (int k = 0; k < 256; ++k) if (cs[h][k] > best) { best = cs[h][k]; bi = k; }
      cs[h][bi] = -3.0e38f;
      top[j] = best; te[j] = ce[h][bi];
      mx = fmaxf(mx, best);
    }
    float sum = 0.f;
    for (int j = 0; j < 16; ++j) { top[j] = __expf(top[j] - mx); sum += top[j]; }
    float inv = 1.f / sum;
    for (int j = 0; j < 16; ++j) { sel_e[h * 16 + j] = te[j]; sel_g[h * 16 + j] = top[j] * inv; }
  }
  __syncthreads();
  float rs2 = rs2_of(w.ssq_h1, t);
  int wave = tid >> 6, lane = tid & 63;
  for (int j = wave; j < 128; j += 4) {
    const u16* ur = w.Ub + (size_t)sel_e[j] * 1024;
    float a = 0.f;
    for (int i = 0; i < 16; ++i) a += bf2f(ur[lane * 16 + i]) * hs[lane * 16 + i];
    a = wave_sum(a);
    if (lane == 0) wj[j] = sel_g[j] * gelu_tanh(rs2 * a);
  }
  __syncthreads();
  float acc[4] = {0, 0, 0, 0};
  for (int j = 0; j < 128; ++j) {
    const u16* vr = w.Vb + (size_t)sel_e[j] * 1024;
    float ww = wj[j];
#pragma unroll
    for (int i = 0; i < 4; ++i) acc[i] += ww * bf2f(vr[tid * 4 + i]);
  }
  float hv[4]; float ss = 0.f;
#pragma unroll
  for (int i = 0; i < 4; ++i) { hv[i] = h1[(size_t)t * 1024 + tid * 4 + i] + acc[i]; ss += hv[i] * hv[i]; }
  ss = wave_sum(ss);
  if (lane == 0) red[wave] = ss;
  __syncthreads();
  float tot = red[0] + red[1] + red[2] + red[3];
  float rn = rsqrtf(tot * (1.f / 1024.f) + EPS);
#pragma unroll
  for (int i = 0; i < 4; ++i) out[(size_t)t * 1024 + tid * 4 + i] = hv[i] * rn * gF[tid * 4 + i];
}


#define GEMM_BUF_BYTES 49152
#define GEMM_LDS_BYTES (2 * GEMM_BUF_BYTES)

__device__ __forceinline__ int swz_off(int row, int c) { return row * 128 + ((c ^ ((row >> 1) & 7)) << 4); }

__device__ __forceinline__ void gemm_core(const u16* __restrict__ A, const u16* __restrict__ Bt, int m0, int n0,
                                          int kbeg, int kend, char* smem, f32x16 (&acc)[2][2]) {
  const int tid = threadIdx.x, lane = tid & 63, wid = tid >> 6;
  const int wm = wid >> 1, wn = wid & 1;
  uint4 ra[4], rb[2];
  const int srow = tid >> 3, sc = tid & 7;
  const u16* Ap = A + (size_t)(m0 + srow) * 1024 + sc * 8;
  const u16* Bp = Bt + (size_t)(n0 + srow) * 1024 + sc * 8;
  const int nk = (kend - kbeg) >> 6;
#pragma unroll
  for (int i = 0; i < 4; ++i) ra[i] = *(const uint4*)(Ap + (size_t)i * 64 * 1024 + kbeg);
#pragma unroll
  for (int i = 0; i < 2; ++i) rb[i] = *(const uint4*)(Bp + (size_t)i * 64 * 1024 + kbeg);
  {
    char* As = smem; char* Bs = smem + 32768;
#pragma unroll
    for (int i = 0; i < 4; ++i) *(uint4*)(As + swz_off(srow + 64 * i, sc)) = ra[i];
#pragma unroll
    for (int i = 0; i < 2; ++i) *(uint4*)(Bs + swz_off(srow + 64 * i, sc)) = rb[i];
  }
  __syncthreads();
  for (int kt = 0; kt < nk; ++kt) {
    const int buf = kt & 1;
    const bool more = (kt + 1 < nk);
    if (more) {
      const int k0 = kbeg + (kt + 1) * 64;
#pragma unroll
      for (int i = 0; i < 4; ++i) ra[i] = *(const uint4*)(Ap + (size_t)i * 64 * 1024 + k0);
#pragma unroll
      for (int i = 0; i < 2; ++i) rb[i] = *(const uint4*)(Bp + (size_t)i * 64 * 1024 + k0);
    }
    const char* As = smem + buf * GEMM_BUF_BYTES;
    const char* Bs = As + 32768;
#pragma unroll
    for (int ks = 0; ks < 4; ++ks) {
      const int c = ks * 2 + (lane >> 5);
      bf16x8 af[2], bfr[2];
#pragma unroll
      for (int mi = 0; mi < 2; ++mi) af[mi] = *(const bf16x8*)(As + swz_off(wm * 64 + mi * 32 + (lane & 31), c));
#pragma unroll
      for (int ni = 0; ni < 2; ++ni) bfr[ni] = *(const bf16x8*)(Bs + swz_off(wn * 64 + ni * 32 + (lane & 31), c));
#pragma unroll
      for (int mi = 0; mi < 2; ++mi)
#pragma unroll
        for (int ni = 0; ni < 2; ++ni)
          acc[mi][ni] = __builtin_amdgcn_mfma_f32_32x32x16_bf16(af[mi], bfr[ni], acc[mi][ni], 0, 0, 0);
    }
    if (more) {
      char* As2 = smem + (buf ^ 1) * GEMM_BUF_BYTES; char* Bs2 = As2 + 32768;
#pragma unroll
      for (int i = 0; i < 4; ++i) *(uint4*)(As2 + swz_off(srow + 64 * i, sc)) = ra[i];
#pragma unroll
      for (int i = 0; i < 2; ++i) *(uint4*)(Bs2 + swz_off(srow + 64 * i, sc)) = rb[i];
    }
    __syncthreads();
  }
}

__device__ __forceinline__ void zero_acc(f32x16 (&acc)[2][2]) {
#pragma unroll
  for (int mi = 0; mi < 2; ++mi)
#pragma unroll
    for (int ni = 0; ni < 2; ++ni)
#pragma unroll
      for (int r = 0; r < 16; ++r) acc[mi][ni][r] = 0.f;
}

__device__ __forceinline__ void p1_tile(const WS& w, int tile, int nblk_g, char* smem) {
  const int it = tile >> 8, b = tile & 255, g = b & 7, j = b >> 3;
  const int mt = it * 16 + g * 2 + (j >> 4), nt = j & 15;
  const int m0 = mt * 256, n0 = nt * 128;
  f32x16 acc[2][2];
  zero_acc(acc);
  gemm_core(w.xb, w.WinT, m0, n0, 0, 1024, smem, acc);
  const int lane = threadIdx.x & 63, wid = threadIdx.x >> 6, wm = wid >> 1, wn = wid & 1;
  const int nb = n0 + wn * 64;
#pragma unroll
  for (int mi = 0; mi < 2; ++mi) {
#pragma unroll
    for (int r = 0; r < 16; ++r) {
      const int row = m0 + wm * 64 + mi * 32 + (r & 3) + 8 * (r >> 2) + 4 * (lane >> 5);
      const float rs = w.rs0[row];
      if (nb < 512) {
#pragma unroll
        for (int ni = 0; ni < 2; ++ni) w.xl[(size_t)row * 512 + nb + ni * 32 + (lane & 31)] = f2bf(rs * acc[mi][ni][r]);
      } else if (nb < 1024) {
#pragma unroll
        for (int ni = 0; ni < 2; ++ni) w.gg[(size_t)row * 512 + (nb - 512) + ni * 32 + (lane & 31)] = f2bf(gelu_tanh(rs * acc[mi][ni][r]));
      } else {
        const int ch = ((nb - 1024) >> 6) * 32 + (lane & 31);
        const float a = rs * acc[mi][0][r], bb = rs * acc[mi][1][r];
        w.glu[(size_t)row * 512 + ch] = f2bf(a * sigmoidf_(bb));
      }
    }
  }
}
__global__ void __launch_bounds__(512) k_p1(WS w) {
  extern __shared__ __attribute__((aligned(16))) char smem[];
  for (int tile = blockIdx.x; tile < 1024; tile += gridDim.x) p1_tile(w, tile, gridDim.x, smem);
}

__device__ __forceinline__ void p3_tile(const WS& w, const float* __restrict__ x, float* __restrict__ h1, int tile, char* smem) {
  const int it = tile >> 8, b = tile & 255, g = b & 7, j = b >> 3;
  const int mt = it * 32 + g * 4 + (j >> 3), nt = j & 7;
  const int m0 = mt * 256, n0 = nt * 128;
  const int lane = threadIdx.x & 63, wid = threadIdx.x >> 6, wm = wid >> 1, wn = wid & 1;
  float* rls = (float*)(smem + GEMM_LDS_BYTES);
  if (threadIdx.x < 256) {
    const float4* p = (const float4*)(w.ssq_lru + (size_t)(m0 + threadIdx.x) * 32);
    float s = 0.f;
#pragma unroll
    for (int i = 0; i < 8; ++i) { float4 v = p[i]; s += v.x + v.y + v.z + v.w; }
    rls[threadIdx.x] = rsqrtf(s * (1.f / 512.f) + EPS);
  }
  f32x16 acc[2][2];
  zero_acc(acc);
  gemm_core(w.y, w.WoutT, m0, n0, 0, 512, smem, acc);
#pragma unroll
  for (int mi = 0; mi < 2; ++mi)
#pragma unroll
    for (int r = 0; r < 16; ++r) {
      const float s = rls[wm * 64 + mi * 32 + (r & 3) + 8 * (r >> 2) + 4 * (lane >> 5)];
      acc[mi][0][r] *= s; acc[mi][1][r] *= s;
    }
  gemm_core(w.y, w.WoutT, m0, n0, 512, 1024, smem, acc);
#pragma unroll
  for (int mi = 0; mi < 2; ++mi) {
#pragma unroll
    for (int r = 0; r < 16; ++r) {
      const int row = m0 + wm * 64 + mi * 32 + (r & 3) + 8 * (r >> 2) + 4 * (lane >> 5);
      float ss = 0.f;
#pragma unroll
      for (int ni = 0; ni < 2; ++ni) {
        const size_t o = (size_t)row * 1024 + n0 + wn * 64 + ni * 32 + (lane & 31);
        const float hv = x[o] + acc[mi][ni][r];
        h1[o] = hv;
        w.h1b[o] = f2bf(hv);
        ss += hv * hv;
      }
      ss += __shfl_xor(ss, 1, 64); ss += __shfl_xor(ss, 2, 64); ss += __shfl_xor(ss, 4, 64);
      ss += __shfl_xor(ss, 8, 64); ss += __shfl_xor(ss, 16, 64);
      if ((lane & 31) == 0) w.ssq_h1[(size_t)row * 16 + nt * 2 + wn] = ss;
    }
  }
  __syncthreads();
}
__global__ void __launch_bounds__(512) k_p3(WS w, const float* __restrict__ x, float* __restrict__ h1) {
  extern __shared__ __attribute__((aligned(16))) char smem[];
  for (int tile = blockIdx.x; tile < 512; tile += gridDim.x) p3_tile(w, x, h1, tile, smem);
}


__device__ __forceinline__ int swz256(int row, int c) { return row * 256 + ((c ^ (row & 15)) << 4); }

__device__ __forceinline__ void cmpswap_desc(float& a, float& b) { float mx = fmaxf(a, b), mn = fminf(a, b); a = mx; b = mn; }

__device__ __forceinline__ void p4_tile(const WS& w, int tile, char* smem) {
  const int it = tile >> 8, b = tile & 255, g = b & 7, j = b >> 3;
  const int mt = it * 16 + g * 2 + (j >> 4), hp = j & 15;
  const int m0 = mt * 256, n0 = hp * 128;
  const int tid = threadIdx.x, lane = tid & 63, wid = tid >> 6, wm = wid >> 1, wn = wid & 1;
  float* rls = (float*)(smem + GEMM_LDS_BYTES);
  if (tid < 256) {
    const float4* p = (const float4*)(w.ssq_h1 + (size_t)(m0 + tid) * 16);
    float s = 0.f;
#pragma unroll
    for (int i = 0; i < 4; ++i) { float4 v = p[i]; s += v.x + v.y + v.z + v.w; }
    rls[tid] = rsqrtf(s * (1.f / 1024.f) + EPS);
  }
  f32x16 acc[2][2];
  zero_acc(acc);
  gemm_core(w.h1b, w.WqT, m0, n0, 0, 1024, smem, acc);
  char* qs = smem;
  char* ksm = smem + 65536;
#pragma unroll
  for (int mi = 0; mi < 2; ++mi)
#pragma unroll
    for (int r = 0; r < 16; ++r) {
      const int row = wm * 64 + mi * 32 + (r & 3) + 8 * (r >> 2) + 4 * (lane >> 5);
      const float rs = rls[row];
#pragma unroll
      for (int ni = 0; ni < 2; ++ni) {
        const int col = wn * 64 + ni * 32 + (lane & 31);
        *(u16*)(qs + swz256(row, col >> 3) + (col & 7) * 2) = f2bf(rs * acc[mi][ni][r]);
      }
    }
  {
    const u16* kp = w.keysb + (size_t)hp * 128 * 128;
#pragma unroll
    for (int i = 0; i < 4; ++i) {
      const int q = tid + 512 * i, row = q >> 4, c = q & 15;
      *(uint4*)(ksm + swz256(row, c)) = *(const uint4*)(kp + row * 128 + c * 8);
    }
  }
  __syncthreads();
  f32x16 sacc[4];
#pragma unroll
  for (int ni = 0; ni < 4; ++ni)
#pragma unroll
    for (int r = 0; r < 16; ++r) sacc[ni][r] = 0.f;
#pragma unroll
  for (int ks = 0; ks < 8; ++ks) {
    const int c = ks * 2 + (lane >> 5);
    bf16x8 af = *(const bf16x8*)(qs + swz256(wid * 32 + (lane & 31), c));
#pragma unroll
    for (int ni = 0; ni < 4; ++ni) {
      bf16x8 bfr = *(const bf16x8*)(ksm + swz256(ni * 32 + (lane & 31), c));
      sacc[ni] = __builtin_amdgcn_mfma_f32_32x32x16_bf16(af, bfr, sacc[ni], 0, 0, 0);
    }
  }
  const float NEG = -3.0e38f;
#pragma unroll
  for (int r = 0; r < 16; ++r) {
    float v0 = __uint_as_float((__float_as_uint(sacc[0][r]) & ~127u) | (unsigned)(0 * 32 + (lane & 31)));
    float v1 = __uint_as_float((__float_as_uint(sacc[1][r]) & ~127u) | (unsigned)(1 * 32 + (lane & 31)));
    float v2 = __uint_as_float((__float_as_uint(sacc[2][r]) & ~127u) | (unsigned)(2 * 32 + (lane & 31)));
    float v3 = __uint_as_float((__float_as_uint(sacc[3][r]) & ~127u) | (unsigned)(3 * 32 + (lane & 31)));
    cmpswap_desc(v0, v1); cmpswap_desc(v2, v3); cmpswap_desc(v0, v2); cmpswap_desc(v1, v3); cmpswap_desc(v1, v2);
    float res = NEG;
    for (int jj = 0; jj < 16; ++jj) {
      float m = v0;
      m = fmaxf(m, __shfl_xor(m, 1, 64));
      m = fmaxf(m, __shfl_xor(m, 2, 64));
      m = fmaxf(m, __shfl_xor(m, 4, 64));
      m = fmaxf(m, __shfl_xor(m, 8, 64));
      m = fmaxf(m, __shfl_xor(m, 16, 64));
      const bool hit = (v0 == m);
      v0 = hit ? v1 : v0; v1 = hit ? v2 : v1; v2 = hit ? v3 : v2; v3 = hit ? NEG : v3;
      res = ((lane & 31) == jj) ? m : res;
    }
    const int row = m0 + wid * 32 + (r & 3) + 8 * (r >> 2) + 4 * (lane >> 5);
    if ((lane & 31) < 16) w.cand[((size_t)row * 16 + hp) * 16 + (lane & 31)] = __float_as_uint(res);
  }
  __syncthreads();
}
__global__ void __launch_bounds__(512) k_p4(WS w) {
  extern __shared__ __attribute__((aligned(16))) char smem[];
  for (int tile = blockIdx.x; tile < 1024; tile += gridDim.x) p4_tile(w, tile, smem);
}

typedef __attribute__((ext_vector_type(2))) __bf16 bf16x2_t;
__device__ __forceinline__ float dot2bf(unsigned a, unsigned b, float c) {
  return __builtin_amdgcn_fdot2_f32_bf16(__builtin_bit_cast(bf16x2_t, a), __builtin_bit_cast(bf16x2_t, b), c, false);
}
__device__ __forceinline__ float dot8bf(uint4 a, uint4 b, float c) {
  c = dot2bf(a.x, b.x, c); c = dot2bf(a.y, b.y, c); c = dot2bf(a.z, b.z, c); c = dot2bf(a.w, b.w, c);
  return c;
}
__device__ __forceinline__ void axpy8(float (&acc)[8], float wgt, uint4 v) {
  acc[0] += wgt * __uint_as_float(v.x << 16); acc[1] += wgt * __uint_as_float(v.x & 0xffff0000u);
  acc[2] += wgt * __uint_as_float(v.y << 16); acc[3] += wgt * __uint_as_float(v.y & 0xffff0000u);
  acc[4] += wgt * __uint_as_float(v.z << 16); acc[5] += wgt * __uint_as_float(v.z & 0xffff0000u);
  acc[6] += wgt * __uint_as_float(v.w << 16); acc[7] += wgt * __uint_as_float(v.w & 0xffff0000u);
}

__device__ __forceinline__ void p5_token(const WS& w, int t, const float* h1, const float* __restrict__ gF, float* out,
                                         unsigned* wsm, int ca, int cb) {
  const int lane = threadIdx.x & 63;
  for (int h = 0; h < 8; ++h) {
    float s = -3.0e38f; int e = 0;
    if (lane < 50) {
      const unsigned pa = w.cand[((size_t)t * 16 + 2 * h) * 16 + ca];
      const unsigned pb = w.cand[((size_t)t * 16 + 2 * h + 1) * 16 + cb];
      s = __uint_as_float(pa) + __uint_as_float(pb);
      e = (int)(pa & 127u) * 128 + (int)(pb & 127u);
    }
    int rank = 0;
#pragma unroll
    for (int jj = 0; jj < 50; ++jj) {
      const float sj = __int_as_float(__builtin_amdgcn_readlane(__float_as_int(s), jj));
      rank += (sj > s || (sj == s && jj < lane)) ? 1 : 0;
    }
    const bool sel = (lane < 50) && (rank < 16);
    float mx = sel ? s : -3.0e38f;
#pragma unroll
    for (int o = 32; o > 0; o >>= 1) mx = fmaxf(mx, __shfl_xor(mx, o, 64));
    const float ex = sel ? __expf(s - mx) : 0.f;
    const float sum = wave_sum(ex);
    if (sel) { wsm[h * 16 + rank] = (unsigned)e; wsm[128 + h * 16 + rank] = __float_as_uint(ex / sum); }
  }
  __builtin_amdgcn_fence(__ATOMIC_RELEASE, "wavefront");
  __builtin_amdgcn_wave_barrier();
  __builtin_amdgcn_fence(__ATOMIC_ACQUIRE, "wavefront");
  const int eA = (int)wsm[lane], eB = (int)wsm[64 + lane];
  const float gA = __uint_as_float(wsm[128 + lane]), gB = __uint_as_float(wsm[192 + lane]);
  const u16* xrow = w.h1b + (size_t)t * 1024;
  const uint4 x0 = *(const uint4*)(xrow + lane * 8), x1 = *(const uint4*)(xrow + 512 + lane * 8);
  float rs2;
  {
    float s = (lane < 16) ? w.ssq_h1[(size_t)t * 16 + lane] : 0.f;
    s = wave_sum(s);
    rs2 = rsqrtf(s * (1.f / 1024.f) + EPS);
  }
  float wA, wB;
#pragma unroll
  for (int half = 0; half < 2; ++half) {
    const int ev = half ? eB : eA;
    float* red = (float*)(wsm + 256);
#pragma unroll 1
    for (int g8 = 0; g8 < 8; ++g8) {
      const int j0 = g8 * 8;
      uint4 u0[8], u1[8];
#pragma unroll
      for (int jj = 0; jj < 8; ++jj) {
        const int e = __builtin_amdgcn_readlane(ev, j0 + jj);
        const u16* ur = w.Ub + (size_t)e * 1024;
        u0[jj] = *(const uint4*)(ur + lane * 8);
        u1[jj] = *(const uint4*)(ur + 512 + lane * 8);
      }
      float p[8];
#pragma unroll
      for (int jj = 0; jj < 8; ++jj) p[jj] = dot8bf(u1[jj], x1, dot8bf(u0[jj], x0, 0.f));
#pragma unroll
      for (int i = 0; i < 4; ++i) {
        const bool up = (lane & 4) != 0;
        const float send = up ? p[i] : p[i + 4];
        const float keep = up ? p[i + 4] : p[i];
        p[i] = keep + __shfl_xor(send, 4, 64);
      }
#pragma unroll
      for (int i = 0; i < 2; ++i) {
        const bool up = (lane & 2) != 0;
        const float send = up ? p[i] : p[i + 2];
        const float keep = up ? p[i + 2] : p[i];
        p[i] = keep + __shfl_xor(send, 2, 64);
      }
      {
        const bool up = (lane & 1) != 0;
        const float send = up ? p[0] : p[1];
        const float keep = up ? p[1] : p[0];
        red[g8 * 64 + lane] = keep + __shfl_xor(send, 1, 64);
      }
    }
    __builtin_amdgcn_fence(__ATOMIC_RELEASE, "wavefront");
    __builtin_amdgcn_wave_barrier();
    __builtin_amdgcn_fence(__ATOMIC_ACQUIRE, "wavefront");
    float ptot = 0.f;
#pragma unroll
    for (int m = 0; m < 8; ++m) ptot += red[(lane >> 3) * 64 + (lane & 7) + 8 * m];
    __builtin_amdgcn_fence(__ATOMIC_RELEASE, "wavefront");
    __builtin_amdgcn_wave_barrier();
    __builtin_amdgcn_fence(__ATOMIC_ACQUIRE, "wavefront");
    const float wv = (half ? gB : gA) * gelu_tanh(rs2 * ptot);
    if (half) wB = wv; else wA = wv;
  }
  float a0[8], a1[8];
#pragma unroll
  for (int i = 0; i < 8; ++i) { a0[i] = 0.f; a1[i] = 0.f; }
#pragma unroll
  for (int half = 0; half < 2; ++half) {
    const int ev = half ? eB : eA;
    const float wv = half ? wB : wA;
#pragma unroll 1
    for (int j0 = 0; j0 < 64; j0 += 8) {
      uint4 v0[8], v1[8];
#pragma unroll
      for (int jj = 0; jj < 8; ++jj) {
        const int e = __builtin_amdgcn_readlane(ev, j0 + jj);
        const u16* vr = w.Vb + (size_t)e * 1024;
        v0[jj] = *(const uint4*)(vr + lane * 8);
        v1[jj] = *(const uint4*)(vr + 512 + lane * 8);
      }
#pragma unroll
      for (int jj = 0; jj < 8; ++jj) {
        const float wj = __int_as_float(__builtin_amdgcn_readlane(__float_as_int(wv), j0 + jj));
        axpy8(a0, wj, v0[jj]);
        axpy8(a1, wj, v1[jj]);
      }
    }
  }
  const float* hr = h1 + (size_t)t * 1024;
  float4 ha = *(const float4*)(hr + lane * 8), hb = *(const float4*)(hr + lane * 8 + 4);
  float4 hc = *(const float4*)(hr + 512 + lane * 8), hd = *(const float4*)(hr + 512 + lane * 8 + 4);
  a0[0] += ha.x; a0[1] += ha.y; a0[2] += ha.z; a0[3] += ha.w; a0[4] += hb.x; a0[5] += hb.y; a0[6] += hb.z; a0[7] += hb.w;
  a1[0] += hc.x; a1[1] += hc.y; a1[2] += hc.z; a1[3] += hc.w; a1[4] += hd.x; a1[5] += hd.y; a1[6] += hd.z; a1[7] += hd.w;
  float ss = 0.f;
#pragma unroll
  for (int i = 0; i < 8; ++i) ss += a0[i] * a0[i] + a1[i] * a1[i];
  ss = wave_sum(ss);
  const float rn = rsqrtf(ss * (1.f / 1024.f) + EPS);
  const float4 g0 = *(const float4*)(gF + lane * 8), g1 = *(const float4*)(gF + lane * 8 + 4);
  const float4 g2 = *(const float4*)(gF + 512 + lane * 8), g3 = *(const float4*)(gF + 512 + lane * 8 + 4);
  float* orow = out + (size_t)t * 1024;
  *(float4*)(orow + lane * 8) = make_float4(a0[0] * rn * g0.x, a0[1] * rn * g0.y, a0[2] * rn * g0.z, a0[3] * rn * g0.w);
  *(float4*)(orow + lane * 8 + 4) = make_float4(a0[4] * rn * g1.x, a0[5] * rn * g1.y, a0[6] * rn * g1.z, a0[7] * rn * g1.w);
  *(float4*)(orow + 512 + lane * 8) = make_float4(a1[0] * rn * g2.x, a1[1] * rn * g2.y, a1[2] * rn * g2.z, a1[3] * rn * g2.w);
  *(float4*)(orow + 512 + lane * 8 + 4) = make_float4(a1[4] * rn * g3.x, a1[5] * rn * g3.y, a1[6] * rn * g3.z, a1[7] * rn * g3.w);
}

__device__ __forceinline__ void staircase_ab(int lane, int& ca, int& cb) {
  ca = 0; cb = 0;
  int cnt = 0;
  for (int a = 0; a < 16; ++a) {
    const int nb = 16 / (a + 1);
    if (lane >= cnt && lane < cnt + nb) { ca = a; cb = lane - cnt; }
    cnt += nb;
  }
}

__global__ void __launch_bounds__(512) k_p5(WS w, const float* h1, const float* __restrict__ gF, float* out) {
  __shared__ unsigned wsm_all[8 * 768];
  const int wid = threadIdx.x >> 6, lane = threadIdx.x & 63;
  int ca, cb;
  staircase_ab(lane, ca, cb);
  const int gw = blockIdx.x * 8 + wid, nw = gridDim.x * 8;
  for (int t = gw; t < T_TOK; t += nw) p5_token(w, t, h1, gF, out, wsm_all + wid * 768, ca, cb);
}


#define LRU_XCT 0
#define LRU_GX 32768
#define LRU_HF (32768 + 33792)
#define LRU_SUM (LRU_HF + 65536)
#define LRU_CARRY (LRU_SUM + 4096)
#define LRU_LDS_BYTES (LRU_CARRY + 128)

struct LruParams {
  const float* cw; const float* cb; const float* b_rg; const float* b_ig; const float* lam;
};

template <int DIR>
__device__ __forceinline__ void lru_pass(const WS& w, const LruParams& P, int b, int hh, int qq, char* smem) {
  const int tid = threadIdx.x, lane = tid & 63, wid = tid >> 6;
  char* xct = smem + LRU_XCT;
  char* gx = smem + LRU_GX;
  float* Gt = (float*)(smem + LRU_GX);
  u16* hf = (u16*)(smem + LRU_HF);
  float* sumA = (float*)(smem + LRU_SUM);
  float* sumB = sumA + 512;
  float* carry = (float*)(smem + LRU_CARRY);
  bf16x8 bw[4];
  {
    const u16* wg = w.Wg + (((size_t)DIR * 8 + hh) * 4 + qq) * 32 * 64;
#pragma unroll
    for (int ks = 0; ks < 4; ++ks) bw[ks] = *(const bf16x8*)(wg + (lane & 31) * 64 + ks * 16 + 8 * (lane >> 5));
  }
  const int s_sub = tid >> 4, ch = tid & 15;
  const int cglob = hh * 64 + qq * 16 + ch;
  const float br = P.b_rg[DIR * 512 + cglob], bi = P.b_ig[DIR * 512 + cglob];
  const float Kc = 8.f * log_sigmoidf_(P.lam[DIR * 512 + cglob]);
  const int cp = tid & 31, rr = tid >> 5;
  float cw0[4], cw1[4];
#pragma unroll
  for (int k = 0; k < 4; ++k) { cw0[k] = P.cw[k * 512 + hh * 64 + 2 * cp]; cw1[k] = P.cw[k * 512 + hh * 64 + 2 * cp + 1]; }
  const float cb0 = P.cb[hh * 64 + 2 * cp], cb1 = P.cb[hh * 64 + 2 * cp + 1];
  if (tid < 16) carry[tid] = 0.f;

  for (int cs = 0; cs < 8; ++cs) {
    const int chunk = DIR ? (7 - cs) : cs;
    const int s0 = chunk * 256;
#pragma unroll
    for (int i = 0; i < 5; ++i) {
      const int q = tid + 512 * i, row = q >> 3, c = q & 7;
      if (row < 259) {
        const int sp = s0 - 2 + row;
        uint4 v = make_uint4(0, 0, 0, 0);
        if (sp >= 0 && sp < SEQ) v = *(const uint4*)(w.xl + ((size_t)b * SEQ + sp) * 512 + hh * 64 + c * 8);
        *(uint4*)(gx + row * 128 + c * 16) = v;
      }
    }
    __syncthreads();
    {
      const unsigned* gxi = (const unsigned*)gx;
      unsigned win[19];
#pragma unroll
      for (int i = 0; i < 19; ++i) win[i] = gxi[(rr * 16 + i) * 32 + cp];
#pragma unroll
      for (int i = 0; i < 16; ++i) {
        float o0 = cb0, o1 = cb1;
#pragma unroll
        for (int k = 0; k < 4; ++k) {
          o0 += cw0[k] * __uint_as_float(win[i + k] << 16);
          o1 += cw1[k] * __uint_as_float(win[i + k] & 0xffff0000u);
        }
        const int row = rr * 16 + i;
        const unsigned pk = (unsigned)f2bf(o0) | ((unsigned)f2bf(o1) << 16);
        *(unsigned*)(xct + swz_off(row, cp >> 2) + (cp & 3) * 4) = pk;
      }
    }
    __syncthreads();
    {
      f32x16 acc;
#pragma unroll
      for (int r = 0; r < 16; ++r) acc[r] = 0.f;
#pragma unroll
      for (int ks = 0; ks < 4; ++ks) {
        bf16x8 af = *(const bf16x8*)(xct + swz_off(wid * 32 + (lane & 31), ks * 2 + (lane >> 5)));
        acc = __builtin_amdgcn_mfma_f32_32x32x16_bf16(af, bw[ks], acc, 0, 0, 0);
      }
#pragma unroll
      for (int r = 0; r < 16; ++r) {
        const int row = wid * 32 + (r & 3) + 8 * (r >> 2) + 4 * (lane >> 5);
        Gt[row * 33 + (lane & 31)] = acc[r];
      }
    }
    __syncthreads();
    float av[8], uv[8];
    {
      float A = 1.f, B = 0.f;
#pragma unroll
      for (int i = 0; i < 8; ++i) {
        const int p = s_sub * 8 + i;
        const int tok = DIR ? (255 - p) : p;
        const float r = sigmoidf_(Gt[tok * 33 + ch] + br);
        const float ig = sigmoidf_(Gt[tok * 33 + 16 + ch] + bi);
        const int col = qq * 16 + ch;
        const float xcv = bf2f(*(const u16*)(xct + swz_off(tok, col >> 3) + (col & 7) * 2));
        const float a = __expf(Kc * r);
        const float u = sqrtf(fmaxf(1.f - a * a, 0.f)) * ig * xcv;
        av[i] = a; uv[i] = u;
        B = a * B + u; A *= a;
      }
      sumA[s_sub * 16 + ch] = A; sumB[s_sub * 16 + ch] = B;
    }
    __syncthreads();
    {
      float h = carry[(cs & 1) * 16 + ch];
      for (int sp = 0; sp < s_sub; ++sp) h = sumA[sp * 16 + ch] * h + sumB[sp * 16 + ch];
#pragma unroll
      for (int i = 0; i < 8; ++i) {
        const int p = s_sub * 8 + i;
        const int tok = DIR ? (255 - p) : p;
        h = av[i] * h + uv[i];
        const int sq = s0 + tok;
        if (DIR == 0) {
          hf[sq * 16 + ch] = f2bf(h);
        } else {
          const size_t t = (size_t)b * SEQ + sq;
          const float yv = (bf2f(hf[sq * 16 + ch]) + h) * bf2f(w.gg[t * 512 + cglob]);
          w.y[t * 1024 + cglob] = f2bf(yv);
          float ss = yv * yv;
          ss += __shfl_xor(ss, 1, 64); ss += __shfl_xor(ss, 2, 64); ss += __shfl_xor(ss, 4, 64); ss += __shfl_xor(ss, 8, 64);
          if (ch == 0) w.ssq_lru[t * 32 + hh * 4 + qq] = ss;
        }
      }
      if (s_sub == 31) carry[((cs + 1) & 1) * 16 + ch] = h;
    }
    __syncthreads();
  }
}

__device__ __forceinline__ void p2_lru_task(const WS& w, const LruParams& P, int task, char* smem) {
  const int b = task >> 5, hh = (task >> 2) & 7, qq = task & 3;
  lru_pass<0>(w, P, b, hh, qq, smem);
  lru_pass<1>(w, P, b, hh, qq, smem);
}
__global__ void __launch_bounds__(512) k_p2_lru(WS w, LruParams P) {
  extern __shared__ __attribute__((aligned(16))) char smem[];
  for (int task = blockIdx.x; task < 256; task += gridDim.x) p2_lru_task(w, P, task, smem);
}

#define CONV_LDS_BYTES (62 * 1024 + 32 * 4 * 4)
struct ConvParams { const float* cw; const float* cb; const float* ng; const float* nb; };

__device__ __forceinline__ void p2_conv_tile(const WS& w, const ConvParams& P, int tile, char* smem) {
  int tid = threadIdx.x;
  asm volatile("" : "+v"(tid));
  const int lane = tid & 63, wid = tid >> 6;
  const int b = tile >> 6, s0 = (tile & 63) * 32;
  float* red = (float*)(smem + 62 * 1024);
  for (int q = tid; q < 62 * 64; q += 512) {
    const int row = q >> 6, c = q & 63;
    const int sp = s0 - 15 + row;
    uint4 v = make_uint4(0, 0, 0, 0);
    if (sp >= 0 && sp < SEQ) v = *(const uint4*)(w.glu + ((size_t)b * SEQ + sp) * 512 + c * 8);
    *(uint4*)(smem + row * 1024 + c * 16) = v;
  }
  const int cp = tid & 255, th = tid >> 8;
  float w0[31], w1[31];
#pragma unroll
  for (int k = 0; k < 31; ++k) {
    const float2 wv = *(const float2*)(P.cw + k * 512 + 2 * cp);
    w0[k] = wv.x; w1[k] = wv.y;
  }
  const float2 cbv = *(const float2*)(P.cb + 2 * cp);
  const float2 ngv = *(const float2*)(P.ng + 2 * cp);
  const float2 nbv = *(const float2*)(P.nb + 2 * cp);
  __syncthreads();
  const unsigned* gl = (const unsigned*)smem;
  float y0[16], y1[16];
#pragma unroll
  for (int tb = 0; tb < 2; ++tb) {
    float a0[8], a1[8];
#pragma unroll
    for (int i = 0; i < 8; ++i) { a0[i] = cbv.x; a1[i] = cbv.y; }
    const int rbase = th * 16 + tb * 8;
#pragma unroll
    for (int j = 0; j < 38; ++j) {
      const unsigned pk = gl[(rbase + j) * 256 + cp];
      const float xlo = __uint_as_float(pk << 16), xhi = __uint_as_float(pk & 0xffff0000u);
#pragma unroll
      for (int i = 0; i < 8; ++i) {
        const int k = j - i;
        if (k >= 0 && k < 31) { a0[i] += w0[k] * xlo; a1[i] += w1[k] * xhi; }
      }
      if ((j & 3) == 3) __builtin_amdgcn_sched_barrier(0);
    }
#pragma unroll
    for (int i = 0; i < 8; ++i) {
      float s = a0[i] + a1[i];
      s += __shfl_xor(s, 1, 64); s += __shfl_xor(s, 2, 64); s += __shfl_xor(s, 4, 64); s += __shfl_xor(s, 8, 64); s += __shfl_xor(s, 16, 64);
      const float mu = s * (1.f / 64.f);
      const float d0 = a0[i] - mu, d1 = a1[i] - mu;
      float q = d0 * d0 + d1 * d1;
      q += __shfl_xor(q, 1, 64); q += __shfl_xor(q, 2, 64); q += __shfl_xor(q, 4, 64); q += __shfl_xor(q, 8, 64); q += __shfl_xor(q, 16, 64);
      const float rstd = rsqrtf(q * (1.f / 64.f) + EPS);
      const float v0 = d0 * rstd * ngv.x + nbv.x, v1 = d1 * rstd * ngv.y + nbv.y;
      const float yy0 = v0 * sigmoidf_(v0), yy1 = v1 * sigmoidf_(v1);
      y0[tb * 8 + i] = yy0; y1[tb * 8 + i] = yy1;
      float sq = yy0 * yy0 + yy1 * yy1;
      sq = wave_sum(sq);
      if (lane == 0) red[(th * 16 + tb * 8 + i) * 4 + (wid & 3)] = sq;
    }
    __builtin_amdgcn_sched_barrier(0);
  }
  __syncthreads();
#pragma unroll
  for (int i = 0; i < 16; ++i) {
    const int tok = th * 16 + i;
    const float4 r4 = *(const float4*)(red + tok * 4);
    const float rc = rsqrtf((r4.x + r4.y + r4.z + r4.w) * (1.f / 512.f) + EPS);
    const size_t t = (size_t)b * SEQ + s0 + tok;
    const unsigned pk = (unsigned)f2bf(y0[i] * rc) | ((unsigned)f2bf(y1[i] * rc) << 16);
    *(unsigned*)(w.y + t * 1024 + 512 + 2 * cp) = pk;
  }
  __syncthreads();
}
__global__ void __launch_bounds__(512) k_p2_conv(WS w, ConvParams P) {
  extern __shared__ __attribute__((aligned(16))) char smem[];
  for (int tile = blockIdx.x; tile < 512; tile += gridDim.x) p2_conv_tile(w, P, tile, smem);
}

extern "C" void kernel_launch(void* const* d_in, const int* in_sizes, int n_in, void* d_out, int out_size, void* d_ws,
                              size_t ws_size, hipStream_t stream) {
  const float* x = (const float*)d_in[0];
  const float* mix_norm_g = (const float*)d_in[1];
  const float* w_in = (const float*)d_in[2];
  const float* lru_conv_w = (const float*)d_in[3];
  const float* lru_conv_b = (const float*)d_in[4];
  const float* lru_w_rg = (const float*)d_in[5];
  const float* lru_b_rg = (const float*)d_in[6];
  const float* lru_w_ig = (const float*)d_in[7];
  const float* lru_b_ig = (const float*)d_in[8];
  const float* lru_lambda = (const float*)d_in[9];
  const float* conf_conv_w = (const float*)d_in[10];
  const float* conf_conv_b = (const float*)d_in[11];
  const float* conf_norm_g = (const float*)d_in[12];
  const float* conf_norm_b = (const float*)d_in[13];
  const float* beta_lru = (const float*)d_in[14];
  const float* beta_conv = (const float*)d_in[15];
  const float* w_out = (const float*)d_in[16];
  const float* ffn_norm_g = (const float*)d_in[17];
  const float* peer_w_q = (const float*)d_in[18];
  const float* peer_sub_keys = (const float*)d_in[19];
  const float* peer_u = (const float*)d_in[20];
  const float* peer_v = (const float*)d_in[21];
  const float* final_norm_g = (const float*)d_in[22];
  float* out = (float*)d_out;
  WS w = make_ws(d_ws);
  static bool attr_done = false;
  if (!attr_done) {
    hipFuncSetAttribute((const void*)k_p1, hipFuncAttributeMaxDynamicSharedMemorySize, GEMM_LDS_BYTES);
    hipFuncSetAttribute((const void*)k_p3, hipFuncAttributeMaxDynamicSharedMemorySize, GEMM_LDS_BYTES + 1024);
    hipFuncSetAttribute((const void*)k_p4, hipFuncAttributeMaxDynamicSharedMemorySize, GEMM_LDS_BYTES + 1024);
    hipFuncSetAttribute((const void*)k_p2_lru, hipFuncAttributeMaxDynamicSharedMemorySize, LRU_LDS_BYTES);
    hipFuncSetAttribute((const void*)k_p2_conv, hipFuncAttributeMaxDynamicSharedMemorySize, CONV_LDS_BYTES);
    attr_done = true;
  }

  k_prep_x<<<T_TOK / 4, 256, 0, stream>>>(x, w.xb, w.rs0);
  k_prep_wT<1><<<dim3(2048 / 32, 32), 256, 0, stream>>>(w_in, mix_norm_g, nullptr, w.WinT, 2048);
  k_prep_wT<2><<<dim3(1024 / 32, 32), 256, 0, stream>>>(w_out, beta_lru, beta_conv, w.WoutT, 1024);
  k_prep_wT<0><<<dim3(2048 / 32, 32), 256, 0, stream>>>(peer_w_q, ffn_norm_g, nullptr, w.WqT, 2048);
  k_prep_misc<<<(16 * 128 * 128 + 255) / 256, 256, 0, stream>>>(peer_sub_keys, lru_w_rg, lru_w_ig, w.keysb, w.Wg);

  k_p1<<<256, 512, GEMM_LDS_BYTES, stream>>>(w);
  {
    LruParams LP{lru_conv_w, lru_conv_b, lru_b_rg, lru_b_ig, lru_lambda};
    k_p2_lru<<<256, 512, LRU_LDS_BYTES, stream>>>(w, LP);
    ConvParams CP{conf_conv_w, conf_conv_b, conf_norm_g, conf_norm_b};
    k_p2_conv<<<512, 512, CONV_LDS_BYTES, stream>>>(w, CP);
  }
  k_p3<<<256, 512, GEMM_LDS_BYTES + 1024, stream>>>(w, x, out);
  k_p4<<<256, 512, GEMM_LDS_BYTES + 1024, stream>>>(w);
  k_prep_uv<<<16384 * 256 / 256, 256, 0, stream>>>(peer_u, peer_v, ffn_norm_g, w.Ub, w.Vb);
  k_p5<<<512, 512, 0, stream>>>(w, out, final_norm_g, out);
}
```

```cpp
#include <hip/hip_runtime.h>
#include <hip/hip_bf16.h>
#include <hip/hip_cooperative_groups.h>
#include <cstdio>
namespace cg = cooperative_groups;
#include <stdint.h>

typedef unsigned short u16;
typedef __attribute__((ext_vector_type(8))) short bf16x8;
typedef __attribute__((ext_vector_type(4))) float f32x4;
typedef __attribute__((ext_vector_type(16))) float f32x16;

#define T_TOK 16384
#define SEQ 2048
#define NB 8
#define DM 1024
#define DL 512
#define EPS 1e-6f

__device__ __forceinline__ float bf2f(u16 v) { return __uint_as_float(((unsigned)v) << 16); }
__device__ __forceinline__ u16 f2bf(float f) {
  unsigned u = __float_as_uint(f);
  u += 0x7fffu + ((u >> 16) & 1u);
  return (u16)(u >> 16);
}
__device__ __forceinline__ float sigmoidf_(float x) { return 1.f / (1.f + __expf(-x)); }
__device__ __forceinline__ float gelu_tanh(float x) {
  float u = 0.7978845608028654f * (x + 0.044715f * x * x * x);
  float e = __expf(2.f * u);
  float th = 1.f - 2.f / (e + 1.f);
  return 0.5f * x * (1.f + th);
}
__device__ __forceinline__ float log_sigmoidf_(float x) {
  return fminf(x, 0.f) - log1pf(__expf(-fabsf(x)));
}
__device__ __forceinline__ float wave_sum(float v) {
#pragma unroll
  for (int o = 32; o > 0; o >>= 1) v += __shfl_xor(v, o, 64);
  return v;
}

struct WS {
  u16* xb;
  float* rs0;
  u16* WinT;
  u16* WoutT;
  u16* WqT;
  u16* keysb;
  u16* Wg;
  u16* Ub;
  u16* Vb;
  u16* xl;
  u16* gg;
  u16* glu;
  u16* y;
  float* ssq_lru;
  float* ssq_h1;
  unsigned* cand;
  u16* h1b;
  float* tmp_a;
  float* tmp_b;
};

static WS make_ws(void* d_ws) {
  char* p = (char*)d_ws;
  WS w;
  size_t off = 0;
  auto take = [&](size_t bytes) { char* r = p + off; off += (bytes + 255) & ~(size_t)255; return r; };
  w.xb = (u16*)take((size_t)T_TOK * 1024 * 2);
  w.rs0 = (float*)take((size_t)T_TOK * 4);
  w.WinT = (u16*)take((size_t)2048 * 1024 * 2);
  w.WoutT = (u16*)take((size_t)1024 * 1024 * 2);
  w.WqT = (u16*)take((size_t)2048 * 1024 * 2);
  w.keysb = (u16*)take((size_t)16 * 128 * 128 * 2);
  w.Wg = (u16*)take((size_t)2 * 8 * 4 * 32 * 64 * 2);
  w.Ub = (u16*)take((size_t)16384 * 1024 * 2);
  w.Vb = (u16*)take((size_t)16384 * 1024 * 2);
  w.xl = (u16*)take((size_t)T_TOK * 512 * 2);
  w.gg = (u16*)take((size_t)T_TOK * 512 * 2);
  w.glu = (u16*)take((size_t)T_TOK * 512 * 2);
  w.y = (u16*)take((size_t)T_TOK * 1024 * 2);
  w.ssq_lru = (float*)take((size_t)T_TOK * 32 * 4);
  w.ssq_h1 = (float*)take((size_t)T_TOK * 16 * 4);
  w.cand = (unsigned*)w.xl;
  w.h1b = w.xb;
  w.tmp_a = (float*)w.Ub;
  w.tmp_b = (float*)w.Vb;
  return w;
}

__global__ void __launch_bounds__(256) k_prep_x(const float* __restrict__ x, u16* __restrict__ xb, float* __restrict__ rs0) {
  int wave = threadIdx.x >> 6, lane = threadIdx.x & 63;
  int t = blockIdx.x * 4 + wave;
  const float4* xr = (const float4*)(x + (size_t)t * 1024);
  float ss = 0.f;
  float4 v[4];
#pragma unroll
  for (int i = 0; i < 4; ++i) {
    v[i] = xr[i * 64 + lane];
    ss += v[i].x * v[i].x + v[i].y * v[i].y + v[i].z * v[i].z + v[i].w * v[i].w;
  }
  ss = wave_sum(ss);
#pragma unroll
  for (int i = 0; i < 4; ++i) {
    ushort4 o;
    o.x = f2bf(v[i].x); o.y = f2bf(v[i].y); o.z = f2bf(v[i].z); o.w = f2bf(v[i].w);
    ((ushort4*)(xb + (size_t)t * 1024))[i * 64 + lane] = o;
  }
  if (lane == 0) rs0[t] = rsqrtf(ss * (1.f / 1024.f) + EPS);
}

__device__ __forceinline__ int win_orig_col(int np) {
  if (np < 1024) return np;
  int r = (np - 1024) >> 6, i = (np - 1024) & 63;
  return (i < 32) ? (1024 + 32 * r + i) : (1536 + 32 * r + (i - 32));
}

template <int MODE>
__global__ void __launch_bounds__(256) k_prep_wT(const float* __restrict__ w, const float* __restrict__ scale_a,
                                                const float* __restrict__ scale_b, u16* __restrict__ out, int N) {
  __shared__ float tile[32][33];
  int n0 = blockIdx.x * 32, k0 = blockIdx.y * 32;
  int tx = threadIdx.x & 31, ty = threadIdx.x >> 5;
  for (int i = ty; i < 32; i += 8) {
    int k = k0 + i;
    int n = n0 + tx;
    int col = (MODE == 1) ? win_orig_col(n) : n;
    float sc;
    if (MODE == 2) sc = (k < 512) ? scale_a[k] : scale_b[k - 512];
    else sc = scale_a[k];
    tile[i][tx] = sc * w[(size_t)k * N + col];
  }
  __syncthreads();
  for (int i = ty; i < 32; i += 8) {
    int n = n0 + i, k = k0 + tx;
    out[(size_t)n * 1024 + k] = f2bf(tile[tx][i]);
  }
}

__global__ void __launch_bounds__(256) k_prep_misc(const float* __restrict__ sub_keys, const float* __restrict__ w_rg,
                                                  const float* __restrict__ w_ig, u16* __restrict__ keysb,
                                                  u16* __restrict__ Wg) {
  int i = blockIdx.x * 256 + threadIdx.x;
  if (i < 16 * 128 * 128) keysb[i] = f2bf(sub_keys[i]);
  if (i < 2 * 8 * 4 * 32 * 64) {
    int k = i & 63, j = (i >> 6) & 31, qq = (i >> 11) & 3, hh = (i >> 13) & 7, dir = (i >> 16) & 1;
    int o = qq * 16 + (j & 15);
    const float* src = (j < 16) ? w_rg : w_ig;
    Wg[i] = f2bf(src[(((size_t)dir * 8 + hh) * 64 + k) * 64 + o]);
  }
}

__global__ void __launch_bounds__(256) k_prep_uv(const float* __restrict__ U, const float* __restrict__ V,
                                                const float* __restrict__ g2, u16* __restrict__ Ub, u16* __restrict__ Vb) {
  size_t i = ((size_t)blockIdx.x * 256 + threadIdx.x);
  if (i >= (size_t)16384 * 256) return;
  int d4 = (int)(i & 255);
  float4 g = ((const float4*)g2)[d4];
  float4 u = ((const float4*)U)[i];
  float4 v = ((const float4*)V)[i];
  ushort4 ou, ov;
  ou.x = f2bf(u.x * g.x); ou.y = f2bf(u.y * g.y); ou.z = f2bf(u.z * g.z); ou.w = f2bf(u.w * g.w);
  ov.x = f2bf(v.x); ov.y = f2bf(v.y); ov.z = f2bf(v.z); ov.w = f2bf(v.w);
  ((ushort4*)Ub)[i] = ou;
  ((ushort4*)Vb)[i] = ov;
}

__device__ __forceinline__ void load_rows8(const u16* __restrict__ A, int t0, float* xs) {
  for (int i = threadIdx.x; i < 8 * 1024; i += 256) xs[i] = bf2f(A[(size_t)t0 * 1024 + i]);
  __syncthreads();
}
__device__ __forceinline__ void dot8(const u16* __restrict__ wrow, const float* xs, int kbeg, int kend, float acc[8]) {
  for (int k = kbeg; k < kend; k += 8) {
    uint4 wv = *(const uint4*)(wrow + k);
    float wf[8];
    wf[0] = __uint_as_float(wv.x << 16); wf[1] = __uint_as_float(wv.x & 0xffff0000u);
    wf[2] = __uint_as_float(wv.y << 16); wf[3] = __uint_as_float(wv.y & 0xffff0000u);
    wf[4] = __uint_as_float(wv.z << 16); wf[5] = __uint_as_float(wv.z & 0xffff0000u);
    wf[6] = __uint_as_float(wv.w << 16); wf[7] = __uint_as_float(wv.w & 0xffff0000u);
#pragma unroll
    for (int r = 0; r < 8; ++r) {
      const float* xr = xs + r * 1024 + k;
      float a = acc[r];
#pragma unroll
      for (int j = 0; j < 8; ++j) a += wf[j] * xr[j];
      acc[r] = a;
    }
  }
}

__global__ void __launch_bounds__(256) k_n_gemm1(WS w) {
  __shared__ float xs[8 * 1024];
  int t0 = blockIdx.x * 8;
  load_rows8(w.xb, t0, xs);
  for (int c = threadIdx.x; c < 512; c += 256) {
    float a0[8] = {0}, a1[8] = {0}, a2[8] = {0}, a3[8] = {0};
    int na = 1024 + 64 * (c >> 5) + (c & 31);
    dot8(w.WinT + (size_t)c * 1024, xs, 0, 1024, a0);
    dot8(w.WinT + (size_t)(512 + c) * 1024, xs, 0, 1024, a1);
    dot8(w.WinT + (size_t)na * 1024, xs, 0, 1024, a2);
    dot8(w.WinT + (size_t)(na + 32) * 1024, xs, 0, 1024, a3);
    for (int r = 0; r < 8; ++r) {
      int t = t0 + r;
      float rs = w.rs0[t];
      w.xl[(size_t)t * 512 + c] = f2bf(rs * a0[r]);
      w.gg[(size_t)t * 512 + c] = f2bf(gelu_tanh(rs * a1[r]));
      w.glu[(size_t)t * 512 + c] = f2bf(rs * a2[r] * sigmoidf_(rs * a3[r]));
    }
  }
}

__global__ void __launch_bounds__(256) k_n_xc(WS w, const float* __restrict__ cw, const float* __restrict__ cb, float* __restrict__ xc) {
  int i = blockIdx.x * 256 + threadIdx.x;
  int c = i & 511, t = i >> 9, s = t & (SEQ - 1);
  float acc = cb[c];
#pragma unroll
  for (int k = 0; k < 4; ++k) {
    int ss = s - 2 + k;
    if (ss >= 0 && ss < SEQ) acc += cw[k * 512 + c] * bf2f(w.xl[(size_t)(t - 2 + k) * 512 + c]);
  }
  xc[i] = acc;
}

template <int DIR>
__global__ void __launch_bounds__(64) k_n_scan(WS w, const float* __restrict__ xc, float* __restrict__ hf,
                                              const float* __restrict__ b_rg, const float* __restrict__ b_ig,
                                              const float* __restrict__ lam) {
  int b = blockIdx.x >> 3, hh = blockIdx.x & 7;
  int cl = threadIdx.x;
  int c = hh * 64 + cl;
  int qq = cl >> 4, j = cl & 15;
  const u16* wr = w.Wg + ((((size_t)DIR * 8 + hh) * 4 + qq) * 32 + j) * 64;
  const u16* wi = wr + 16 * 64;
  float wrf[64], wif[64];
#pragma unroll
  for (int k = 0; k < 64; ++k) { wrf[k] = bf2f(wr[k]); wif[k] = bf2f(wi[k]); }
  float br = b_rg[DIR * 512 + c], bi = b_ig[DIR * 512 + c];
  float Kc = 8.f * log_sigmoidf_(lam[DIR * 512 + c]);
  float h = 0.f;
  for (int st = 0; st < SEQ; ++st) {
    int s = DIR ? (SEQ - 1 - st) : st;
    size_t t = (size_t)b * SEQ + s;
    const float* xr = xc + t * 512 + hh * 64;
    float pr = br, pi = bi;
#pragma unroll
    for (int k = 0; k < 64; ++k) { float xv = xr[k]; pr += xv * wrf[k]; pi += xv * wif[k]; }
    float r = sigmoidf_(pr), ig = sigmoidf_(pi);
    float a = __expf(Kc * r);
    float u = sqrtf(fmaxf(1.f - a * a, 0.f)) * ig * xr[cl];
    h = a * h + u;
    if (DIR == 0) hf[t * 512 + c] = h;
    else {
      float yv = (hf[t * 512 + c] + h) * bf2f(w.gg[t * 512 + c]);
      w.y[t * 1024 + c] = f2bf(yv);
    }
  }
}

__global__ void __launch_bounds__(256) k_n_ssq_lru(WS w) {
  int i = blockIdx.x * 256 + threadIdx.x;
  int t = i >> 5, g = i & 31;
  float s = 0.f;
  for (int k = 0; k < 16; ++k) { float v = bf2f(w.y[(size_t)t * 1024 + g * 16 + k]); s += v * v; }
  w.ssq_lru[i] = s;
}

__global__ void __launch_bounds__(512) k_n_conv(WS w, const float* __restrict__ cw, const float* __restrict__ cb,
                                               const float* __restrict__ ng, const float* __restrict__ nb) {
  __shared__ float red[8];
  int t = blockIdx.x, s = t & (SEQ - 1), c = threadIdx.x;
  float acc = cb[c];
  for (int k = 0; k < 31; ++k) {
    int ss = s - 15 + k;
    if (ss >= 0 && ss < SEQ) acc += cw[k * 512 + c] * bf2f(w.glu[(size_t)(t - 15 + k) * 512 + c]);
  }
  float mu = wave_sum(acc) * (1.f / 64.f);
  float d = acc - mu;
  float var = wave_sum(d * d) * (1.f / 64.f);
  float v = d * rsqrtf(var + EPS) * ng[c] + nb[c];
  float yv = v * sigmoidf_(v);
  float sq = wave_sum(yv * yv);
  if ((c & 63) == 0) red[c >> 6] = sq;
  __syncthreads();
  float tot = 0.f;
  for (int i = 0; i < 8; ++i) tot += red[i];
  float rc = rsqrtf(tot * (1.f / 512.f) + EPS);
  w.y[(size_t)t * 1024 + 512 + c] = f2bf(yv * rc);
}

__global__ void __launch_bounds__(256) k_n_gemm2(WS w, const float* __restrict__ x, float* __restrict__ h1) {
  __shared__ float xs[8 * 1024];
  int t0 = blockIdx.x * 8;
  load_rows8(w.y, t0, xs);
  float rl[8];
  for (int r = 0; r < 8; ++r) {
    float s = 0.f;
    for (int g = 0; g < 32; ++g) s += w.ssq_lru[(size_t)(t0 + r) * 32 + g];
    rl[r] = rsqrtf(s * (1.f / 512.f) + EPS);
  }
  for (int n = threadIdx.x; n < 1024; n += 256) {
    float a0[8] = {0}, a1[8] = {0};
    dot8(w.WoutT + (size_t)n * 1024, xs, 0, 512, a0);
    dot8(w.WoutT + (size_t)n * 1024, xs, 512, 1024, a1);
    for (int r = 0; r < 8; ++r) {
      size_t o = (size_t)(t0 + r) * 1024 + n;
      float hv = x[o] + rl[r] * a0[r] + a1[r];
      h1[o] = hv;
    }
  }
}
__global__ void __launch_bounds__(256) k_n_h1stat(WS w, const float* __restrict__ h1) {
  int wave = threadIdx.x >> 6, lane = threadIdx.x & 63;
  int t = blockIdx.x * 4 + wave;
  float ss = 0.f;
  for (int i = 0; i < 16; ++i) {
    float v = h1[(size_t)t * 1024 + lane * 16 + i];
    ss += v * v;
    w.h1b[(size_t)t * 1024 + lane * 16 + i] = f2bf(v);
  }
  ss += __shfl_xor(ss, 1, 64); ss += __shfl_xor(ss, 2, 64);
  if ((lane & 3) == 0) w.ssq_h1[(size_t)t * 16 + (lane >> 2)] = ss;
}

__device__ __forceinline__ float rs2_of(const float* ssq_h1, int t) {
  float s = 0.f;
  for (int j = 0; j < 16; ++j) s += ssq_h1[(size_t)t * 16 + j];
  return rsqrtf(s * (1.f / 1024.f) + EPS);
}

__global__ void __launch_bounds__(256) k_n_gemm3(WS w, u16* __restrict__ qb) {
  __shared__ float xs[8 * 1024];
  int t0 = blockIdx.x * 8;
  load_rows8(w.h1b, t0, xs);
  float rs[8];
  for (int r = 0; r < 8; ++r) rs[r] = rs2_of(w.ssq_h1, t0 + r);
  for (int n = threadIdx.x; n < 2048; n += 256) {
    float a0[8] = {0};
    dot8(w.WqT + (size_t)n * 1024, xs, 0, 1024, a0);
    for (int r = 0; r < 8; ++r) qb[(size_t)(t0 + r) * 2048 + n] = f2bf(rs[r] * a0[r]);
  }
}
__global__ void __launch_bounds__(256) k_n_topk(WS w, const u16* __restrict__ qb) {
  __shared__ float sc[16 * 128];
  __shared__ float qs[2048];
  int t = blockIdx.x;
  for (int i = threadIdx.x; i < 2048; i += 256) qs[i] = bf2f(qb[(size_t)t * 2048 + i]);
  __syncthreads();
  for (int i = threadIdx.x; i < 2048; i += 256) {
    int hp = i >> 7, key = i & 127;
    const u16* kr = w.keysb + ((size_t)hp * 128 + key) * 128;
    float a = 0.f;
    for (int c = 0; c < 128; ++c) a += qs[hp * 128 + c] * bf2f(kr[c]);
    sc[i] = a;
  }
  __syncthreads();
  if (threadIdx.x < 16) {
    int hp = threadIdx.x;
    float* s = sc + hp * 128;
    for (int j = 0; j < 16; ++j) {
      float best = -3.0e38f; int bi = 0;
      for (int k = 0; k < 128; ++k) if (s[k] > best) { best = s[k]; bi = k; }
      s[bi] = -3.0e38f;
      w.cand[((size_t)t * 16 + hp) * 16 + j] = (__float_as_uint(best) & ~127u) | (unsigned)bi;
    }
  }
}

__global__ void __launch_bounds__(256) k_n_peer(WS w, const float* h1, const float* __restrict__ gF, float* out) {
  __shared__ float cs[8][256];
  __shared__ int ce[8][256];
  __shared__ int sel_e[128];
  __shared__ float sel_g[128];
  __shared__ float wj[128];
  __shared__ float hs[1024];
  __shared__ float red[4];
  int t = blockIdx.x, tid = threadIdx.x;
  for (int i = tid; i < 1024; i += 256) hs[i] = bf2f(w.h1b[(size_t)t * 1024 + i]);
  for (int h = 0; h < 8; ++h) {
    int a = tid >> 4, b = tid & 15;
    unsigned pa = w.cand[((size_t)t * 16 + 2 * h) * 16 + a];
    unsigned pb = w.cand[((size_t)t * 16 + 2 * h + 1) * 16 + b];
    cs[h][tid] = __uint_as_float(pa) + __uint_as_float(pb);
    ce[h][tid] = (int)(pa & 127u) * 128 + (int)(pb & 127u);
  }
  __syncthreads();
  if (tid < 8) {
    int h = tid;
    float top[16]; int te[16];
    float mx = -3.0e38f;
    for (int j = 0; j < 16; ++j) {
      float best = -3.0e38f; int bi = 0;
      for (int k = 0; k < 256; ++k) if (cs[h][k] > best) { best = cs[h][k]; bi = k; }
      cs[h][bi] = -3.0e38f;
      top[j] = best; te[j] = ce[h][bi];
      mx = fmaxf(mx, best);
    }
    float sum = 0.f;
    for (int j = 0; j < 16; ++j) { top[j] = __expf(top[j] - mx); sum += top[j]; }
    float inv = 1.f / sum;
    for (int j = 0; j < 16; ++j) { sel_e[h * 16 + j] = te[j]; sel_g[h * 16 + j] = top[j] * inv; }
  }
  __syncthreads();
  float rs2 = rs2_of(w.ssq_h1, t);
  int wave = tid >> 6, lane = tid & 63;
  for (int j = wave; j < 128; j += 4) {
    const u16* ur = w.Ub + (size_t)sel_e[j] * 1024;
    float a = 0.f;
    for (int i = 0; i < 16; ++i) a += bf2f(ur[lane * 16 + i]) * hs[lane * 16 + i];
    a = wave_sum(a);
    if (lane == 0) wj[j] = sel_g[j] * gelu_tanh(rs2 * a);
  }
  __syncthreads();
  float acc[4] = {0, 0, 0, 0};
  for (int j = 0; j < 128; ++j) {
    const u16* vr = w.Vb + (size_t)sel_e[j] * 1024;
    float ww = wj[j];
#pragma unroll
    for (int i = 0; i < 4; ++i) acc[i] += ww * bf2f(vr[tid * 4 + i]);
  }
  float hv[4]; float ss = 0.f;
#pragma unroll
  for (int i = 0; i < 4; ++i) { hv[i] = h1[(size_t)t * 1024 + tid * 4 + i] + acc[i]; ss += hv[i] * hv[i]; }
  ss = wave_sum(ss);
  if (lane == 0) red[wave] = ss;
  __syncthreads();
  float tot = red[0] + red[1] + red[2] + red[3];
  float rn = rsqrtf(tot * (1.f / 1024.f) + EPS);
#pragma unroll
  for (int i = 0; i < 4; ++i) out[(size_t)t * 1024 + tid * 4 + i] = hv[i] * rn * gF[tid * 4 + i];
}


#define GEMM_BUF_BYTES 49152
#define GEMM_LDS_BYTES (2 * GEMM_BUF_BYTES)

__device__ __forceinline__ int swz_off(int row, int c) { return row * 128 + ((c ^ ((row >> 1) & 7)) << 4); }

__device__ __forceinline__ void gemm_core(const u16* __restrict__ A, const u16* __restrict__ Bt, int m0, int n0,
                                          int kbeg, int kend, char* smem, f32x16 (&acc)[2][2]) {
  const int tid = threadIdx.x, lane = tid & 63, wid = tid >> 6;
  const int wm = wid >> 1, wn = wid & 1;
  uint4 ra[4], rb[2];
  const int srow = tid >> 3, sc = tid & 7;
  const u16* Ap = A + (size_t)(m0 + srow) * 1024 + sc * 8;
  const u16* Bp = Bt + (size_t)(n0 + srow) * 1024 + sc * 8;
  const int nk = (kend - kbeg) >> 6;
#pragma unroll
  for (int i = 0; i < 4; ++i) ra[i] = *(const uint4*)(Ap + (size_t)i * 64 * 1024 + kbeg);
#pragma unroll
  for (int i = 0; i < 2; ++i) rb[i] = *(const uint4*)(Bp + (size_t)i * 64 * 1024 + kbeg);
  {
    char* As = smem; char* Bs = smem + 32768;
#pragma unroll
    for (int i = 0; i < 4; ++i) *(uint4*)(As + swz_off(srow + 64 * i, sc)) = ra[i];
#pragma unroll
    for (int i = 0; i < 2; ++i) *(uint4*)(Bs + swz_off(srow + 64 * i, sc)) = rb[i];
  }
  __syncthreads();
  for (int kt = 0; kt < nk; ++kt) {
    const int buf = kt & 1;
    const bool more = (kt + 1 < nk);
    if (more) {
      const int k0 = kbeg + (kt + 1) * 64;
#pragma unroll
      for (int i = 0; i < 4; ++i) ra[i] = *(const uint4*)(Ap + (size_t)i * 64 * 1024 + k0);
#pragma unroll
      for (int i = 0; i < 2; ++i) rb[i] = *(const uint4*)(Bp + (size_t)i * 64 * 1024 + k0);
    }
    const char* As = smem + buf * GEMM_BUF_BYTES;
    const char* Bs = As + 32768;
#pragma unroll
    for (int ks = 0; ks < 4; ++ks) {
      const int c = ks * 2 + (lane >> 5);
      bf16x8 af[2], bfr[2];
#pragma unroll
      for (int mi = 0; mi < 2; ++mi) af[mi] = *(const bf16x8*)(As + swz_off(wm * 64 + mi * 32 + (lane & 31), c));
#pragma unroll
      for (int ni = 0; ni < 2; ++ni) bfr[ni] = *(const bf16x8*)(Bs + swz_off(wn * 64 + ni * 32 + (lane & 31), c));
#pragma unroll
      for (int mi = 0; mi < 2; ++mi)
#pragma unroll
        for (int ni = 0; ni < 2; ++ni)
          acc[mi][ni] = __builtin_amdgcn_mfma_f32_32x32x16_bf16(af[mi], bfr[ni], acc[mi][ni], 0, 0, 0);
    }
    if (more) {
      char* As2 = smem + (buf ^ 1) * GEMM_BUF_BYTES; char* Bs2 = As2 + 32768;
#pragma unroll
      for (int i = 0; i < 4; ++i) *(uint4*)(As2 + swz_off(srow + 64 * i, sc)) = ra[i];
#pragma unroll
      for (int i = 0; i < 2; ++i) *(uint4*)(Bs2 + swz_off(srow + 64 * i, sc)) = rb[i];
    }
    __syncthreads();
  }
}

__device__ __forceinline__ void zero_acc(f32x16 (&acc)[2][2]) {
#pragma unroll
  for (int mi = 0; mi < 2; ++mi)
#pragma unroll
    for (int ni = 0; ni < 2; ++ni)
#pragma unroll
      for (int r = 0; r < 16; ++r) acc[mi][ni][r] = 0.f;
}

__device__ __forceinline__ void p1_tile(const WS& w, int tile, int nblk_g, char* smem) {
  const int it = tile >> 8, b = tile & 255, g = b & 7, j = b >> 3;
  const int mt = it * 16 + g * 2 + (j >> 4), nt = j & 15;
  const int m0 = mt * 256, n0 = nt * 128;
  f32x16 acc[2][2];
  zero_acc(acc);
  gemm_core(w.xb, w.WinT, m0, n0, 0, 1024, smem, acc);
  const int lane = threadIdx.x & 63, wid = threadIdx.x >> 6, wm = wid >> 1, wn = wid & 1;
  const int nb = n0 + wn * 64;
#pragma unroll
  for (int mi = 0; mi < 2; ++mi) {
#pragma unroll
    for (int r = 0; r < 16; ++r) {
      const int row = m0 + wm * 64 + mi * 32 + (r & 3) + 8 * (r >> 2) + 4 * (lane >> 5);
      const float rs = w.rs0[row];
      if (nb < 512) {
#pragma unroll
        for (int ni = 0; ni < 2; ++ni) w.xl[(size_t)row * 512 + nb + ni * 32 + (lane & 31)] = f2bf(rs * acc[mi][ni][r]);
      } else if (nb < 1024) {
#pragma unroll
        for (int ni = 0; ni < 2; ++ni) w.gg[(size_t)row * 512 + (nb - 512) + ni * 32 + (lane & 31)] = f2bf(gelu_tanh(rs * acc[mi][ni][r]));
      } else {
        const int ch = ((nb - 1024) >> 6) * 32 + (lane & 31);
        const float a = rs * acc[mi][0][r], bb = rs * acc[mi][1][r];
        w.glu[(size_t)row * 512 + ch] = f2bf(a * sigmoidf_(bb));
      }
    }
  }
}
__global__ void __launch_bounds__(512) k_p1(WS w) {
  extern __shared__ __attribute__((aligned(16))) char smem[];
  for (int tile = blockIdx.x; tile < 1024; tile += gridDim.x) p1_tile(w, tile, gridDim.x, smem);
}

__device__ __forceinline__ void p3_tile(const WS& w, const float* __restrict__ x, float* __restrict__ h1, int tile, char* smem) {
  const int it = tile >> 8, b = tile & 255, g = b & 7, j = b >> 3;
  const int mt = it * 32 + g * 4 + (j >> 3), nt = j & 7;
  const int m0 = mt * 256, n0 = nt * 128;
  const int lane = threadIdx.x & 63, wid = threadIdx.x >> 6, wm = wid >> 1, wn = wid & 1;
  float* rls = (float*)(smem + GEMM_LDS_BYTES);
  if (threadIdx.x < 256) {
    const float4* p = (const float4*)(w.ssq_lru + (size_t)(m0 + threadIdx.x) * 32);
    float s = 0.f;
#pragma unroll
    for (int i = 0; i < 8; ++i) { float4 v = p[i]; s += v.x + v.y + v.z + v.w; }
    rls[threadIdx.x] = rsqrtf(s * (1.f / 512.f) + EPS);
  }
  f32x16 acc[2][2];
  zero_acc(acc);
  gemm_core(w.y, w.WoutT, m0, n0, 0, 512, smem, acc);
#pragma unroll
  for (int mi = 0; mi < 2; ++mi)
#pragma unroll
    for (int r = 0; r < 16; ++r) {
      const float s = rls[wm * 64 + mi * 32 + (r & 3) + 8 * (r >> 2) + 4 * (lane >> 5)];
      acc[mi][0][r] *= s; acc[mi][1][r] *= s;
    }
  gemm_core(w.y, w.WoutT, m0, n0, 512, 1024, smem, acc);
#pragma unroll
  for (int mi = 0; mi < 2; ++mi) {
#pragma unroll
    for (int r = 0; r < 16; ++r) {
      const int row = m0 + wm * 64 + mi * 32 + (r & 3) + 8 * (r >> 2) + 4 * (lane >> 5);
      float ss = 0.f;
#pragma unroll
      for (int ni = 0; ni < 2; ++ni) {
        const size_t o = (size_t)row * 1024 + n0 + wn * 64 + ni * 32 + (lane & 31);
        const float hv = x[o] + acc[mi][ni][r];
        h1[o] = hv;
        w.h1b[o] = f2bf(hv);
        ss += hv * hv;
      }
      ss += __shfl_xor(ss, 1, 64); ss += __shfl_xor(ss, 2, 64); ss += __shfl_xor(ss, 4, 64);
      ss += __shfl_xor(ss, 8, 64); ss += __shfl_xor(ss, 16, 64);
      if ((lane & 31) == 0) w.ssq_h1[(size_t)row * 16 + nt * 2 + wn] = ss;
    }
  }
  __syncthreads();
}
__global__ void __launch_bounds__(512) k_p3(WS w, const float* __restrict__ x, float* __restrict__ h1) {
  extern __shared__ __attribute__((aligned(16))) char smem[];
  for (int tile = blockIdx.x; tile < 512; tile += gridDim.x) p3_tile(w, x, h1, tile, smem);
}


__device__ __forceinline__ int swz256(int row, int c) { return row * 256 + ((c ^ (row & 15)) << 4); }

__device__ __forceinline__ void cmpswap_desc(float& a, float& b) { float mx = fmaxf(a, b), mn = fminf(a, b); a = mx; b = mn; }

__device__ __forceinline__ void p4_tile(const WS& w, int tile, char* smem) {
  const int it = tile >> 8, b = tile & 255, g = b & 7, j = b >> 3;
  const int mt = it * 16 + g * 2 + (j >> 4), hp = j & 15;
  const int m0 = mt * 256, n0 = hp * 128;
  const int tid = threadIdx.x, lane = tid & 63, wid = tid >> 6, wm = wid >> 1, wn = wid & 1;
  float* rls = (float*)(smem + GEMM_LDS_BYTES);
  if (tid < 256) {
    const float4* p = (const float4*)(w.ssq_h1 + (size_t)(m0 + tid) * 16);
    float s = 0.f;
#pragma unroll
    for (int i = 0; i < 4; ++i) { float4 v = p[i]; s += v.x + v.y + v.z + v.w; }
    rls[tid] = rsqrtf(s * (1.f / 1024.f) + EPS);
  }
  f32x16 acc[2][2];
  zero_acc(acc);
  gemm_core(w.h1b, w.WqT, m0, n0, 0, 1024, smem, acc);
  char* qs = smem;
  char* ksm = smem + 65536;
#pragma unroll
  for (int mi = 0; mi < 2; ++mi)
#pragma unroll
    for (int r = 0; r < 16; ++r) {
      const int row = wm * 64 + mi * 32 + (r & 3) + 8 * (r >> 2) + 4 * (lane >> 5);
      const float rs = rls[row];
#pragma unroll
      for (int ni = 0; ni < 2; ++ni) {
        const int col = wn * 64 + ni * 32 + (lane & 31);
        *(u16*)(qs + swz256(row, col >> 3) + (col & 7) * 2) = f2bf(rs * acc[mi][ni][r]);
      }
    }
  {
    const u16* kp = w.keysb + (size_t)hp * 128 * 128;
#pragma unroll
    for (int i = 0; i < 4; ++i) {
      const int q = tid + 512 * i, row = q >> 4, c = q & 15;
      *(uint4*)(ksm + swz256(row, c)) = *(const uint4*)(kp + row * 128 + c * 8);
    }
  }
  __syncthreads();
  f32x16 sacc[4];
#pragma unroll
  for (int ni = 0; ni < 4; ++ni)
#pragma unroll
    for (int r = 0; r < 16; ++r) sacc[ni][r] = 0.f;
#pragma unroll
  for (int ks = 0; ks < 8; ++ks) {
    const int c = ks * 2 + (lane >> 5);
    bf16x8 af = *(const bf16x8*)(qs + swz256(wid * 32 + (lane & 31), c));
#pragma unroll
    for (int ni = 0; ni < 4; ++ni) {
      bf16x8 bfr = *(const bf16x8*)(ksm + swz256(ni * 32 + (lane & 31), c));
      sacc[ni] = __builtin_amdgcn_mfma_f32_32x32x16_bf16(af, bfr, sacc[ni], 0, 0, 0);
    }
  }
  const float NEG = -3.0e38f;
#pragma unroll
  for (int r = 0; r < 16; ++r) {
    float v0 = __uint_as_float((__float_as_uint(sacc[0][r]) & ~127u) | (unsigned)(0 * 32 + (lane & 31)));
    float v1 = __uint_as_float((__float_as_uint(sacc[1][r]) & ~127u) | (unsigned)(1 * 32 + (lane & 31)));
    float v2 = __uint_as_float((__float_as_uint(sacc[2][r]) & ~127u) | (unsigned)(2 * 32 + (lane & 31)));
    float v3 = __uint_as_float((__float_as_uint(sacc[3][r]) & ~127u) | (unsigned)(3 * 32 + (lane & 31)));
    cmpswap_desc(v0, v1); cmpswap_desc(v2, v3); cmpswap_desc(v0, v2); cmpswap_desc(v1, v3); cmpswap_desc(v1, v2);
    float res = NEG;
    for (int jj = 0; jj < 16; ++jj) {
      float m = v0;
      m = fmaxf(m, __shfl_xor(m, 1, 64));
      m = fmaxf(m, __shfl_xor(m, 2, 64));
      m = fmaxf(m, __shfl_xor(m, 4, 64));
      m = fmaxf(m, __shfl_xor(m, 8, 64));
      m = fmaxf(m, __shfl_xor(m, 16, 64));
      const bool hit = (v0 == m);
      v0 = hit ? v1 : v0; v1 = hit ? v2 : v1; v2 = hit ? v3 : v2; v3 = hit ? NEG : v3;
      res = ((lane & 31) == jj) ? m : res;
    }
    const int row = m0 + wid * 32 + (r & 3) + 8 * (r >> 2) + 4 * (lane >> 5);
    if ((lane & 31) < 16) w.cand[((size_t)row * 16 + hp) * 16 + (lane & 31)] = __float_as_uint(res);
  }
  __syncthreads();
}
__global__ void __launch_bounds__(512) k_p4(WS w) {
  extern __shared__ __attribute__((aligned(16))) char smem[];
  for (int tile = blockIdx.x; tile < 1024; tile += gridDim.x) p4_tile(w, tile, smem);
}

typedef __attribute__((ext_vector_type(2))) __bf16 bf16x2_t;
__device__ __forceinline__ float dot2bf(unsigned a, unsigned b, float c) {
  return __builtin_amdgcn_fdot2_f32_bf16(__builtin_bit_cast(bf16x2_t, a), __builtin_bit_cast(bf16x2_t, b), c, false);
}
__device__ __forceinline__ float dot8bf(uint4 a, uint4 b, float c) {
  c = dot2bf(a.x, b.x, c); c = dot2bf(a.y, b.y, c); c = dot2bf(a.z, b.z, c); c = dot2bf(a.w, b.w, c);
  return c;
}
__device__ __forceinline__ void axpy8(float (&acc)[8], float wgt, uint4 v) {
  acc[0] += wgt * __uint_as_float(v.x << 16); acc[1] += wgt * __uint_as_float(v.x & 0xffff0000u);
  acc[2] += wgt * __uint_as_float(v.y << 16); acc[3] += wgt * __uint_as_float(v.y & 0xffff0000u);
  acc[4] += wgt * __uint_as_float(v.z << 16); acc[5] += wgt * __uint_as_float(v.z & 0xffff0000u);
  acc[6] += wgt * __uint_as_float(v.w << 16); acc[7] += wgt * __uint_as_float(v.w & 0xffff0000u);
}

__device__ __forceinline__ void p5_token(const WS& w, int t, const float* h1, const float* __restrict__ gF, float* out,
                                         unsigned* wsm, int ca, int cb) {
  const int lane = threadIdx.x & 63;
  for (int h = 0; h < 8; ++h) {
    float s = -3.0e38f; int e = 0;
    if (lane < 50) {
      const unsigned pa = w.cand[((size_t)t * 16 + 2 * h) * 16 + ca];
      const unsigned pb = w.cand[((size_t)t * 16 + 2 * h + 1) * 16 + cb];
      s = __uint_as_float(pa) + __uint_as_float(pb);
      e = (int)(pa & 127u) * 128 + (int)(pb & 127u);
    }
    int rank = 0;
#pragma unroll
    for (int jj = 0; jj < 50; ++jj) {
      const float sj = __int_as_float(__builtin_amdgcn_readlane(__float_as_int(s), jj));
      rank += (sj > s || (sj == s && jj < lane)) ? 1 : 0;
    }
    const bool sel = (lane < 50) && (rank < 16);
    float mx = sel ? s : -3.0e38f;
#pragma unroll
    for (int o = 32; o > 0; o >>= 1) mx = fmaxf(mx, __shfl_xor(mx, o, 64));
    const float ex = sel ? __expf(s - mx) : 0.f;
    const float sum = wave_sum(ex);
    if (sel) { wsm[h * 16 + rank] = (unsigned)e; wsm[128 + h * 16 + rank] = __float_as_uint(ex / sum); }
  }
  __builtin_amdgcn_fence(__ATOMIC_RELEASE, "wavefront");
  __builtin_amdgcn_wave_barrier();
  __builtin_amdgcn_fence(__ATOMIC_ACQUIRE, "wavefront");
  const int eA = (int)wsm[lane], eB = (int)wsm[64 + lane];
  const float gA = __uint_as_float(wsm[128 + lane]), gB = __uint_as_float(wsm[192 + lane]);
  const u16* xrow = w.h1b + (size_t)t * 1024;
  const uint4 x0 = *(const uint4*)(xrow + lane * 8), x1 = *(const uint4*)(xrow + 512 + lane * 8);
  float rs2;
  {
    float s = (lane < 16) ? w.ssq_h1[(size_t)t * 16 + lane] : 0.f;
    s = wave_sum(s);
    rs2 = rsqrtf(s * (1.f / 1024.f) + EPS);
  }
  float wA, wB;
#pragma unroll
  for (int half = 0; half < 2; ++half) {
    const int ev = half ? eB : eA;
    float* red = (float*)(wsm + 256);
#pragma unroll 1
    for (int g8 = 0; g8 < 8; ++g8) {
      const int j0 = g8 * 8;
      uint4 u0[8], u1[8];
#pragma unroll
      for (int jj = 0; jj < 8; ++jj) {
        const int e = __builtin_amdgcn_readlane(ev, j0 + jj);
        const u16* ur = w.Ub + (size_t)e * 1024;
        u0[jj] = *(const uint4*)(ur + lane * 8);
        u1[jj] = *(const uint4*)(ur + 512 + lane * 8);
      }
      float p[8];
#pragma unroll
      for (int jj = 0; jj < 8; ++jj) p[jj] = dot8bf(u1[jj], x1, dot8bf(u0[jj], x0, 0.f));
#pragma unroll
      for (int i = 0; i < 4; ++i) {
        const bool up = (lane & 4) != 0;
        const float send = up ? p[i] : p[i + 4];
        const float keep = up ? p[i + 4] : p[i];
        p[i] = keep + __shfl_xor(send, 4, 64);
      }
#pragma unroll
      for (int i = 0; i < 2; ++i) {
        const bool up = (lane & 2) != 0;
        const float send = up ? p[i] : p[i + 2];
        const float keep = up ? p[i + 2] : p[i];
        p[i] = keep + __shfl_xor(send, 2, 64);
      }
      {
        const bool up = (lane & 1) != 0;
        const float send = up ? p[0] : p[1];
        const float keep = up ? p[1] : p[0];
        red[g8 * 64 + lane] = keep + __shfl_xor(send, 1, 64);
      }
    }
    __builtin_amdgcn_fence(__ATOMIC_RELEASE, "wavefront");
    __builtin_amdgcn_wave_barrier();
    __builtin_amdgcn_fence(__ATOMIC_ACQUIRE, "wavefront");
    float ptot = 0.f;
#pragma unroll
    for (int m = 0; m < 8; ++m) ptot += red[(lane >> 3) * 64 + (lane & 7) + 8 * m];
    __builtin_amdgcn_fence(__ATOMIC_RELEASE, "wavefront");
    __builtin_amdgcn_wave_barrier();
    __builtin_amdgcn_fence(__ATOMIC_ACQUIRE, "wavefront");
    const float wv = (half ? gB : gA) * gelu_tanh(rs2 * ptot);
    if (half) wB = wv; else wA = wv;
  }
  float a0[8], a1[8];
#pragma unroll
  for (int i = 0; i < 8; ++i) { a0[i] = 0.f; a1[i] = 0.f; }
#pragma unroll
  for (int half = 0; half < 2; ++half) {
    const int ev = half ? eB : eA;
    const float wv = half ? wB : wA;
#pragma unroll 1
    for (int j0 = 0; j0 < 64; j0 += 8) {
      uint4 v0[8], v1[8];
#pragma unroll
      for (int jj = 0; jj < 8; ++jj) {
        const int e = __builtin_amdgcn_readlane(ev, j0 + jj);
        const u16* vr = w.Vb + (size_t)e * 1024;
        v0[jj] = *(const uint4*)(vr + lane * 8);
        v1[jj] = *(const uint4*)(vr + 512 + lane * 8);
      }
#pragma unroll
      for (int jj = 0; jj < 8; ++jj) {
        const float wj = __int_as_float(__builtin_amdgcn_readlane(__float_as_int(wv), j0 + jj));
        axpy8(a0, wj, v0[jj]);
        axpy8(a1, wj, v1[jj]);
      }
    }
  }
  const float* hr = h1 + (size_t)t * 1024;
  float4 ha = *(const float4*)(hr + lane * 8), hb = *(const float4*)(hr + lane * 8 + 4);
  float4 hc = *(const float4*)(hr + 512 + lane * 8), hd = *(const float4*)(hr + 512 + lane * 8 + 4);
  a0[0] += ha.x; a0[1] += ha.y; a0[2] += ha.z; a0[3] += ha.w; a0[4] += hb.x; a0[5] += hb.y; a0[6] += hb.z; a0[7] += hb.w;
  a1[0] += hc.x; a1[1] += hc.y; a1[2] += hc.z; a1[3] += hc.w; a1[4] += hd.x; a1[5] += hd.y; a1[6] += hd.z; a1[7] += hd.w;
  float ss = 0.f;
#pragma unroll
  for (int i = 0; i < 8; ++i) ss += a0[i] * a0[i] + a1[i] * a1[i];
  ss = wave_sum(ss);
  const float rn = rsqrtf(ss * (1.f / 1024.f) + EPS);
  const float4 g0 = *(const float4*)(gF + lane * 8), g1 = *(const float4*)(gF + lane * 8 + 4);
  const float4 g2 = *(const float4*)(gF + 512 + lane * 8), g3 = *(const float4*)(gF + 512 + lane * 8 + 4);
  float* orow = out + (size_t)t * 1024;
  *(float4*)(orow + lane * 8) = make_float4(a0[0] * rn * g0.x, a0[1] * rn * g0.y, a0[2] * rn * g0.z, a0[3] * rn * g0.w);
  *(float4*)(orow + lane * 8 + 4) = make_float4(a0[4] * rn * g1.x, a0[5] * rn * g1.y, a0[6] * rn * g1.z, a0[7] * rn * g1.w);
  *(float4*)(orow + 512 + lane * 8) = make_float4(a1[0] * rn * g2.x, a1[1] * rn * g2.y, a1[2] * rn * g2.z, a1[3] * rn * g2.w);
  *(float4*)(orow + 512 + lane * 8 + 4) = make_float4(a1[4] * rn * g3.x, a1[5] * rn * g3.y, a1[6] * rn * g3.z, a1[7] * rn * g3.w);
}

__device__ __forceinline__ void staircase_ab(int lane, int& ca, int& cb) {
  ca = 0; cb = 0;
  int cnt = 0;
  for (int a = 0; a < 16; ++a) {
    const int nb = 16 / (a + 1);
    if (lane >= cnt && lane < cnt + nb) { ca = a; cb = lane - cnt; }
    cnt += nb;
  }
}

__global__ void __launch_bounds__(512) k_p5(WS w, const float* h1, const float* __restrict__ gF, float* out) {
  __shared__ unsigned wsm_all[8 * 768];
  const int wid = threadIdx.x >> 6, lane = threadIdx.x & 63;
  int ca, cb;
  staircase_ab(lane, ca, cb);
  const int gw = blockIdx.x * 8 + wid, nw = gridDim.x * 8;
  for (int t = gw; t < T_TOK; t += nw) p5_token(w, t, h1, gF, out, wsm_all + wid * 768, ca, cb);
}


#define LRU_XCT 0
#define LRU_GX 32768
#define LRU_HF (32768 + 33792)
#define LRU_SUM (LRU_HF + 65536)
#define LRU_CARRY (LRU_SUM + 4096)
#define LRU_LDS_BYTES (LRU_CARRY + 128)

struct LruParams {
  const float* cw; const float* cb; const float* b_rg; const float* b_ig; const float* lam;
};

template <int DIR>
__device__ __forceinline__ void lru_pass(const WS& w, const LruParams& P, int b, int hh, int qq, char* smem) {
  const int tid = threadIdx.x, lane = tid & 63, wid = tid >> 6;
  char* xct = smem + LRU_XCT;
  char* gx = smem + LRU_GX;
  float* Gt = (float*)(smem + LRU_GX);
  u16* hf = (u16*)(smem + LRU_HF);
  float* sumA = (float*)(smem + LRU_SUM);
  float* sumB = sumA + 512;
  float* carry = (float*)(smem + LRU_CARRY);
  bf16x8 bw[4];
  {
    const u16* wg = w.Wg + (((size_t)DIR * 8 + hh) * 4 + qq) * 32 * 64;
#pragma unroll
    for (int ks = 0; ks < 4; ++ks) bw[ks] = *(const bf16x8*)(wg + (lane & 31) * 64 + ks * 16 + 8 * (lane >> 5));
  }
  const int s_sub = tid >> 4, ch = tid & 15;
  const int cglob = hh * 64 + qq * 16 + ch;
  const float br = P.b_rg[DIR * 512 + cglob], bi = P.b_ig[DIR * 512 + cglob];
  const float Kc = 8.f * log_sigmoidf_(P.lam[DIR * 512 + cglob]);
  const int cp = tid & 31, rr = tid >> 5;
  float cw0[4], cw1[4];
#pragma unroll
  for (int k = 0; k < 4; ++k) { cw0[k] = P.cw[k * 512 + hh * 64 + 2 * cp]; cw1[k] = P.cw[k * 512 + hh * 64 + 2 * cp + 1]; }
  const float cb0 = P.cb[hh * 64 + 2 * cp], cb1 = P.cb[hh * 64 + 2 * cp + 1];
  if (tid < 16) carry[tid] = 0.f;

  for (int cs = 0; cs < 8; ++cs) {
    const int chunk = DIR ? (7 - cs) : cs;
    const int s0 = chunk * 256;
#pragma unroll
    for (int i = 0; i < 5; ++i) {
      const int q = tid + 512 * i, row = q >> 3, c = q & 7;
      if (row < 259) {
        const int sp = s0 - 2 + row;
        uint4 v = make_uint4(0, 0, 0, 0);
        if (sp >= 0 && sp < SEQ) v = *(const uint4*)(w.xl + ((size_t)b * SEQ + sp) * 512 + hh * 64 + c * 8);
        *(uint4*)(gx + row * 128 + c * 16) = v;
      }
    }
    __syncthreads();
    {
      const unsigned* gxi = (const unsigned*)gx;
      unsigned win[19];
#pragma unroll
      for (int i = 0; i < 19; ++i) win[i] = gxi[(rr * 16 + i) * 32 + cp];
#pragma unroll
      for (int i = 0; i < 16; ++i) {
        float o0 = cb0, o1 = cb1;
#pragma unroll
        for (int k = 0; k < 4; ++k) {
          o0 += cw0[k] * __uint_as_float(win[i + k] << 16);
          o1 += cw1[k] * __uint_as_float(win[i + k] & 0xffff0000u);
        }
        const int row = rr * 16 + i;
        const unsigned pk = (unsigned)f2bf(o0) | ((unsigned)f2bf(o1) << 16);
        *(unsigned*)(xct + swz_off(row, cp >> 2) + (cp & 3) * 4) = pk;
      }
    }
    __syncthreads();
    {
      f32x16 acc;
#pragma unroll
      for (int r = 0; r < 16; ++r) acc[r] = 0.f;
#pragma unroll
      for (int ks = 0; ks < 4; ++ks) {
        bf16x8 af = *(const bf16x8*)(xct + swz_off(wid * 32 + (lane & 31), ks * 2 + (lane >> 5)));
        acc = __builtin_amdgcn_mfma_f32_32x32x16_bf16(af, bw[ks], acc, 0, 0, 0);
      }
#pragma unroll
      for (int r = 0; r < 16; ++r) {
        const int row = wid * 32 + (r & 3) + 8 * (r >> 2) + 4 * (lane >> 5);
        Gt[row * 33 + (lane & 31)] = acc[r];
      }
    }
    __syncthreads();
    float av[8], uv[8];
    {
      float A = 1.f, B = 0.f;
#pragma unroll
      for (int i = 0; i < 8; ++i) {
        const int p = s_sub * 8 + i;
        const int tok = DIR ? (255 - p) : p;
        const float r = sigmoidf_(Gt[tok * 33 + ch] + br);
        const float ig = sigmoidf_(Gt[tok * 33 + 16 + ch] + bi);
        const int col = qq * 16 + ch;
        const float xcv = bf2f(*(const u16*)(xct + swz_off(tok, col >> 3) + (col & 7) * 2));
        const float a = __expf(Kc * r);
        const float u = sqrtf(fmaxf(1.f - a * a, 0.f)) * ig * xcv;
        av[i] = a; uv[i] = u;
        B = a * B + u; A *= a;
      }
      sumA[s_sub * 16 + ch] = A; sumB[s_sub * 16 + ch] = B;
    }
    __syncthreads();
    {
      float h = carry[(cs & 1) * 16 + ch];
      for (int sp = 0; sp < s_sub; ++sp) h = sumA[sp * 16 + ch] * h + sumB[sp * 16 + ch];
#pragma unroll
      for (int i = 0; i < 8; ++i) {
        const int p = s_sub * 8 + i;
        const int tok = DIR ? (255 - p) : p;
        h = av[i] * h + uv[i];
        const int sq = s0 + tok;
        if (DIR == 0) {
          hf[sq * 16 + ch] = f2bf(h);
        } else {
          const size_t t = (size_t)b * SEQ + sq;
          const float yv = (bf2f(hf[sq * 16 + ch]) + h) * bf2f(w.gg[t * 512 + cglob]);
          w.y[t * 1024 + cglob] = f2bf(yv);
          float ss = yv * yv;
          ss += __shfl_xor(ss, 1, 64); ss += __shfl_xor(ss, 2, 64); ss += __shfl_xor(ss, 4, 64); ss += __shfl_xor(ss, 8, 64);
          if (ch == 0) w.ssq_lru[t * 32 + hh * 4 + qq] = ss;
        }
      }
      if (s_sub == 31) carry[((cs + 1) & 1) * 16 + ch] = h;
    }
    __syncthreads();
  }
}

__device__ __forceinline__ void p2_lru_task(const WS& w, const LruParams& P, int task, char* smem) {
  const int b = task >> 5, hh = (task >> 2) & 7, qq = task & 3;
  lru_pass<0>(w, P, b, hh, qq, smem);
  lru_pass<1>(w, P, b, hh, qq, smem);
}
__global__ void __launch_bounds__(512) k_p2_lru(WS w, LruParams P) {
  extern __shared__ __attribute__((aligned(16))) char smem[];
  for (int task = blockIdx.x; task < 256; task += gridDim.x) p2_lru_task(w, P, task, smem);
}

#define CONV_LDS_BYTES (62 * 1024 + 32 * 4 * 4)
struct ConvParams { const float* cw; const float* cb; const float* ng; const float* nb; };

__device__ __forceinline__ void p2_conv_tile(const WS& w, const ConvParams& P, int tile, char* smem) {
  int tid = threadIdx.x;
  asm volatile("" : "+v"(tid));
  const int lane = tid & 63, wid = tid >> 6;
  const int b = tile >> 6, s0 = (tile & 63) * 32;
  float* red = (float*)(smem + 62 * 1024);
  for (int q = tid; q < 62 * 64; q += 512) {
    const int row = q >> 6, c = q & 63;
    const int sp = s0 - 15 + row;
    uint4 v = make_uint4(0, 0, 0, 0);
    if (sp >= 0 && sp < SEQ) v = *(const uint4*)(w.glu + ((size_t)b * SEQ + sp) * 512 + c * 8);
    *(uint4*)(smem + row * 1024 + c * 16) = v;
  }
  const int cp = tid & 255, th = tid >> 8;
  float w0[31], w1[31];
#pragma unroll
  for (int k = 0; k < 31; ++k) {
    const float2 wv = *(const float2*)(P.cw + k * 512 + 2 * cp);
    w0[k] = wv.x; w1[k] = wv.y;
  }
  const float2 cbv = *(const float2*)(P.cb + 2 * cp);
  const float2 ngv = *(const float2*)(P.ng + 2 * cp);
  const float2 nbv = *(const float2*)(P.nb + 2 * cp);
  __syncthreads();
  const unsigned* gl = (const unsigned*)smem;
  float y0[16], y1[16];
#pragma unroll
  for (int tb = 0; tb < 2; ++tb) {
    float a0[8], a1[8];
#pragma unroll
    for (int i = 0; i < 8; ++i) { a0[i] = cbv.x; a1[i] = cbv.y; }
    const int rbase = th * 16 + tb * 8;
#pragma unroll
    for (int j = 0; j < 38; ++j) {
      const unsigned pk = gl[(rbase + j) * 256 + cp];
      const float xlo = __uint_as_float(pk << 16), xhi = __uint_as_float(pk & 0xffff0000u);
#pragma unroll
      for (int i = 0; i < 8; ++i) {
        const int k = j - i;
        if (k >= 0 && k < 31) { a0[i] += w0[k] * xlo; a1[i] += w1[k] * xhi; }
      }
      if ((j & 3) == 3) __builtin_amdgcn_sched_barrier(0);
    }
#pragma unroll
    for (int i = 0; i < 8; ++i) {
      float s = a0[i] + a1[i];
      s += __shfl_xor(s, 1, 64); s += __shfl_xor(s, 2, 64); s += __shfl_xor(s, 4, 64); s += __shfl_xor(s, 8, 64); s += __shfl_xor(s, 16, 64);
      const float mu = s * (1.f / 64.f);
      const float d0 = a0[i] - mu, d1 = a1[i] - mu;
      float q = d0 * d0 + d1 * d1;
      q += __shfl_xor(q, 1, 64); q += __shfl_xor(q, 2, 64); q += __shfl_xor(q, 4, 64); q += __shfl_xor(q, 8, 64); q += __shfl_xor(q, 16, 64);
      const float rstd = rsqrtf(q * (1.f / 64.f) + EPS);
      const float v0 = d0 * rstd * ngv.x + nbv.x, v1 = d1 * rstd * ngv.y + nbv.y;
      const float yy0 = v0 * sigmoidf_(v0), yy1 = v1 * sigmoidf_(v1);
      y0[tb * 8 + i] = yy0; y1[tb * 8 + i] = yy1;
      float sq = yy0 * yy0 + yy1 * yy1;
      sq = wave_sum(sq);
      if (lane == 0) red[(th * 16 + tb * 8 + i) * 4 + (wid & 3)] = sq;
    }
    __builtin_amdgcn_sched_barrier(0);
  }
  __syncthreads();
#pragma unroll
  for (int i = 0; i < 16; ++i) {
    const int tok = th * 16 + i;
    const float4 r4 = *(const float4*)(red + tok * 4);
    const float rc = rsqrtf((r4.x + r4.y + r4.z + r4.w) * (1.f / 512.f) + EPS);
    const size_t t = (size_t)b * SEQ + s0 + tok;
    const unsigned pk = (unsigned)f2bf(y0[i] * rc) | ((unsigned)f2bf(y1[i] * rc) << 16);
    *(unsigned*)(w.y + t * 1024 + 512 + 2 * cp) = pk;
  }
  __syncthreads();
}
__global__ void __launch_bounds__(512) k_p2_conv(WS w, ConvParams P) {
  extern __shared__ __attribute__((aligned(16))) char smem[];
  for (int tile = blockIdx.x; tile < 512; tile += gridDim.x) p2_conv_tile(w, P, tile, smem);
}


struct MK {
  WS w;
  const float* x; const float* mix_norm_g; const float* w_in; const float* lru_conv_w; const float* lru_conv_b;
  const float* lru_w_rg; const float* lru_b_rg; const float* lru_w_ig; const float* lru_b_ig; const float* lru_lambda;
  const float* conf_conv_w; const float* conf_conv_b; const float* conf_norm_g; const float* conf_norm_b;
  const float* beta_lru; const float* beta_conv; const float* w_out; const float* ffn_norm_g; const float* peer_w_q;
  const float* peer_sub_keys; const float* peer_u; const float* peer_v; const float* final_norm_g;
  float* out;
  unsigned* bar;
};

#define MK_LDS_BYTES LRU_LDS_BYTES

template <int MODE>
__device__ __forceinline__ void prep_wT_tile(const float* __restrict__ wsrc, const float* __restrict__ scale_a,
                                             const float* __restrict__ scale_b, u16* __restrict__ dst, int N, int tile,
                                             int htid, float* tl) {
  const int ntn = N >> 5;
  const int n0 = (tile % ntn) * 32, k0 = (tile / ntn) * 32;
  const int tx = htid & 31, ty = htid >> 5;
#pragma unroll
  for (int i = 0; i < 4; ++i) {
    const int kk = ty + 8 * i, k = k0 + kk, n = n0 + tx;
    const int col = (MODE == 1) ? win_orig_col(n) : n;
    float sc;
    if (MODE == 2) sc = (k < 512) ? scale_a[k] : scale_b[k - 512];
    else sc = scale_a[k];
    tl[kk * 33 + tx] = sc * wsrc[(size_t)k * N + col];
  }
  __syncthreads();
#pragma unroll
  for (int i = 0; i < 4; ++i) {
    const int nn = ty + 8 * i;
    dst[(size_t)(n0 + nn) * 1024 + k0 + tx] = f2bf(tl[tx * 33 + nn]);
  }
  __syncthreads();
}

__device__ __forceinline__ void phase0(const MK& p, char* smem) {
  int tid = threadIdx.x;
  asm volatile("" : "+v"(tid));
  const int lane = tid & 63, wid = tid >> 6;
  const int nb = gridDim.x, bid = blockIdx.x;
  for (int t = bid * 8 + wid; t < T_TOK; t += nb * 8) {
    const float4* xr = (const float4*)(p.x + (size_t)t * 1024);
    float ss = 0.f;
    float4 v[4];
#pragma unroll
    for (int i = 0; i < 4; ++i) {
      v[i] = xr[i * 64 + lane];
      ss += v[i].x * v[i].x + v[i].y * v[i].y + v[i].z * v[i].z + v[i].w * v[i].w;
    }
    ss = wave_sum(ss);
#pragma unroll
    for (int i = 0; i < 4; ++i) {
      ushort4 o;
      o.x = f2bf(v[i].x); o.y = f2bf(v[i].y); o.z = f2bf(v[i].z); o.w = f2bf(v[i].w);
      ((ushort4*)(p.w.xb + (size_t)t * 1024))[i * 64 + lane] = o;
    }
    if (lane == 0) p.w.rs0[t] = rsqrtf(ss * (1.f / 1024.f) + EPS);
  }
  {
    float* tl = (float*)smem + (tid >> 8) * (32 * 33);
    const int htid = tid & 255, hb = bid * 2 + (tid >> 8), nhb = nb * 2;
    for (int tile = hb; tile < 2048; tile += nhb) prep_wT_tile<1>(p.w_in, p.mix_norm_g, nullptr, p.w.WinT, 2048, tile, htid, tl);
    for (int tile = hb; tile < 1024; tile += nhb) prep_wT_tile<2>(p.w_out, p.beta_lru, p.beta_conv, p.w.WoutT, 1024, tile, htid, tl);
    for (int tile = hb; tile < 2048; tile += nhb) prep_wT_tile<0>(p.peer_w_q, p.ffn_norm_g, nullptr, p.w.WqT, 2048, tile, htid, tl);
  }
  for (int i = bid * 512 + tid; i < 16 * 128 * 128; i += nb * 512) {
    p.w.keysb[i] = f2bf(p.peer_sub_keys[i]);
    if (i < 2 * 8 * 4 * 32 * 64) {
      const int k = i & 63, j = (i >> 6) & 31, qq = (i >> 11) & 3, hh = (i >> 13) & 7, dir = (i >> 16) & 1;
      const int o = qq * 16 + (j & 15);
      const float* srcp = (j < 16) ? p.lru_w_rg : p.lru_w_ig;
      p.w.Wg[i] = f2bf(srcp[(((size_t)dir * 8 + hh) * 64 + k) * 64 + o]);
    }
  }
  {
    const size_t n4 = (size_t)16384 * 256;
    for (size_t i = (size_t)bid * 512 + tid; i < n4; i += (size_t)nb * 512) {
      const int d4 = (int)(i & 255);
      const float4 g = ((const float4*)p.ffn_norm_g)[d4];
      const float4 u = ((const float4*)p.peer_u)[i];
      const float4 v = ((const float4*)p.peer_v)[i];
      ushort4 ou, ov;
      ou.x = f2bf(u.x * g.x); ou.y = f2bf(u.y * g.y); ou.z = f2bf(u.z * g.z); ou.w = f2bf(u.w * g.w);
      ov.x = f2bf(v.x); ov.y = f2bf(v.y); ov.z = f2bf(v.z); ov.w = f2bf(v.w);
      ((ushort4*)p.w.Ub)[i] = ou;
      ((ushort4*)p.w.Vb)[i] = ov;
    }
  }
}

__global__ void __launch_bounds__(512) k_mega(MK p) {
  extern __shared__ __attribute__((aligned(16))) char smem[];
  cg::grid_group grid = cg::this_grid();
  const int nb = gridDim.x, bid = blockIdx.x;
  phase0(p, smem);
  grid.sync();
  for (int tile = bid; tile < 1024; tile += nb) p1_tile(p.w, tile, nb, smem);
  grid.sync();
  {
    LruParams LP{p.lru_conv_w, p.lru_conv_b, p.lru_b_rg, p.lru_b_ig, p.lru_lambda};
    for (int task = bid; task < 256; task += nb) p2_lru_task(p.w, LP, task, smem);
    ConvParams CP{p.conf_conv_w, p.conf_conv_b, p.conf_norm_g, p.conf_norm_b};
    for (int tile = bid; tile < 512; tile += nb) p2_conv_tile(p.w, CP, tile, smem);
  }
  grid.sync();
  for (int tile = bid; tile < 512; tile += nb) p3_tile(p.w, p.x, p.out, tile, smem);
  grid.sync();
  for (int tile = bid; tile < 1024; tile += nb) p4_tile(p.w, tile, smem);
  grid.sync();
  {
    const int wid = threadIdx.x >> 6, lane = threadIdx.x & 63;
    int ca, cb;
    staircase_ab(lane, ca, cb);
    unsigned* wsm = (unsigned*)smem + wid * 768;
    for (int t = bid * 8 + wid; t < T_TOK; t += nb * 8) p5_token(p.w, t, p.out, p.final_norm_g, p.out, wsm, ca, cb);
  }
}

extern "C" void kernel_launch(void* const* d_in, const int* in_sizes, int n_in, void* d_out, int out_size, void* d_ws,
                              size_t ws_size, hipStream_t stream) {
  const float* x = (const float*)d_in[0];
  const float* mix_norm_g = (const float*)d_in[1];
  const float* w_in = (const float*)d_in[2];
  const float* lru_conv_w = (const float*)d_in[3];
  const float* lru_conv_b = (const float*)d_in[4];
  const float* lru_w_rg = (const float*)d_in[5];
  const float* lru_b_rg = (const float*)d_in[6];
  const float* lru_w_ig = (const float*)d_in[7];
  const float* lru_b_ig = (const float*)d_in[8];
  const float* lru_lambda = (const float*)d_in[9];
  const float* conf_conv_w = (const float*)d_in[10];
  const float* conf_conv_b = (const float*)d_in[11];
  const float* conf_norm_g = (const float*)d_in[12];
  const float* conf_norm_b = (const float*)d_in[13];
  const float* beta_lru = (const float*)d_in[14];
  const float* beta_conv = (const float*)d_in[15];
  const float* w_out = (const float*)d_in[16];
  const float* ffn_norm_g = (const float*)d_in[17];
  const float* peer_w_q = (const float*)d_in[18];
  const float* peer_sub_keys = (const float*)d_in[19];
  const float* peer_u = (const float*)d_in[20];
  const float* peer_v = (const float*)d_in[21];
  const float* final_norm_g = (const float*)d_in[22];
  float* out = (float*)d_out;
  WS w = make_ws(d_ws);
  static int grid_blocks = 0;
  if (!grid_blocks) {
    (void)hipFuncSetAttribute((const void*)k_mega, hipFuncAttributeMaxDynamicSharedMemorySize, MK_LDS_BYTES);
    int dev = 0, cus = 0, per_cu = 0;
    (void)hipGetDevice(&dev);
    (void)hipDeviceGetAttribute(&cus, hipDeviceAttributeMultiprocessorCount, dev);
    (void)hipOccupancyMaxActiveBlocksPerMultiprocessor(&per_cu, k_mega, 512, MK_LDS_BYTES);
    if (per_cu > 1) per_cu = 1;
    grid_blocks = cus * per_cu;
    if (grid_blocks <= 0) grid_blocks = 1;
  }
  MK p{};
  p.w = w;
  p.x = x; p.mix_norm_g = mix_norm_g; p.w_in = w_in; p.lru_conv_w = lru_conv_w; p.lru_conv_b = lru_conv_b;
  p.lru_w_rg = lru_w_rg; p.lru_b_rg = lru_b_rg; p.lru_w_ig = lru_w_ig; p.lru_b_ig = lru_b_ig; p.lru_lambda = lru_lambda;
  p.conf_conv_w = conf_conv_w; p.conf_conv_b = conf_conv_b; p.conf_norm_g = conf_norm_g; p.conf_norm_b = conf_norm_b;
  p.beta_lru = beta_lru; p.beta_conv = beta_conv; p.w_out = w_out; p.ffn_norm_g = ffn_norm_g; p.peer_w_q = peer_w_q;
  p.peer_sub_keys = peer_sub_keys; p.peer_u = peer_u; p.peer_v = peer_v; p.final_norm_g = final_norm_g;
  p.out = out;
  p.bar = nullptr;
  void* args[] = {&p};
  hipError_t e = hipLaunchCooperativeKernel((const void*)k_mega, dim3(grid_blocks), dim3(512), args, MK_LDS_BYTES, stream);
  if (e != hipSuccess) fprintf(stderr, "cooperative launch failed: %s (grid %d)\n", hipGetErrorString(e), grid_blocks);
}
```

```cpp
#include <hip/hip_runtime.h>
#include <hip/hip_bf16.h>
#include <hip/hip_cooperative_groups.h>
#include <cstdio>
namespace cg = cooperative_groups;
#include <stdint.h>

typedef unsigned short u16;
typedef __attribute__((ext_vector_type(8))) short bf16x8;
typedef __attribute__((ext_vector_type(4))) float f32x4;
typedef __attribute__((ext_vector_type(16))) float f32x16;

#ifndef DUP
#define DUP 0
#endif
#define T_TOK 16384
#define SEQ 2048
#define NB 8
#define DM 1024
#define DL 512
#define EPS 1e-6f
#define PEER_SU 256.f
#define PEER_SV 16.f
typedef __attribute__((ext_vector_type(2))) float f32x2;

__device__ __forceinline__ float bf2f(u16 v) { return __uint_as_float(((unsigned)v) << 16); }
__device__ __forceinline__ u16 f2bf(float f) {
  unsigned u = __float_as_uint(f);
  u += 0x7fffu + ((u >> 16) & 1u);
  return (u16)(u >> 16);
}
__device__ __forceinline__ float sigmoidf_(float x) { return 1.f / (1.f + __expf(-x)); }
__device__ __forceinline__ float gelu_tanh(float x) {
  float u = 0.7978845608028654f * (x + 0.044715f * x * x * x);
  float e = __expf(2.f * u);
  float th = 1.f - 2.f / (e + 1.f);
  return 0.5f * x * (1.f + th);
}
__device__ __forceinline__ float log_sigmoidf_(float x) {
  return fminf(x, 0.f) - log1pf(__expf(-fabsf(x)));
}
__device__ __forceinline__ float wave_sum(float v) {
#pragma unroll
  for (int o = 32; o > 0; o >>= 1) v += __shfl_xor(v, o, 64);
  return v;
}

struct WS {
  u16* xb;
  float* rs0;
  u16* WinT;
  u16* WoutT;
  u16* WqT;
  u16* keysb;
  u16* Wg;
  u16* Ub;
  u16* Vb;
  u16* xl;
  u16* gg;
  u16* glu;
  u16* y;
  float* ssq_lru;
  float* ssq_h1;
  unsigned* cand;
  u16* h1b;
  float* tmp_a;
  float* tmp_b;
  u16* sel_e;
  float* wgt;
  float* ssq_out;
  unsigned* bar;
  float* gate;
  float* rs2v;
  unsigned* part;
};

static WS make_ws(void* d_ws) {
  char* p = (char*)d_ws;
  WS w;
  size_t off = 0;
  auto take = [&](size_t bytes) { char* r = p + off; off += (bytes + 255) & ~(size_t)255; return r; };
  w.xb = (u16*)take((size_t)T_TOK * 1024 * 2);
  w.rs0 = (float*)take((size_t)T_TOK * 4);
  w.WinT = (u16*)take((size_t)2048 * 1024 * 2);
  w.WoutT = (u16*)take((size_t)1024 * 1024 * 2);
  w.WqT = (u16*)take((size_t)2048 * 1024 * 2);
  w.keysb = (u16*)take((size_t)16 * 128 * 128 * 2);
  w.Wg = (u16*)take((size_t)2 * 8 * 4 * 32 * 64 * 2);
  w.Ub = (u16*)take((size_t)16384 * 1024 * 2);
  w.Vb = (u16*)take((size_t)16384 * 1024 * 2);
  w.xl = (u16*)take((size_t)T_TOK * 512 * 2);
  w.gg = (u16*)take((size_t)T_TOK * 512 * 2);
  w.glu = (u16*)take((size_t)T_TOK * 512 * 2);
  w.y = (u16*)take((size_t)T_TOK * 1024 * 2);
  w.ssq_lru = (float*)take((size_t)T_TOK * 32 * 4);
  w.ssq_h1 = (float*)take((size_t)T_TOK * 16 * 4);
  w.sel_e = (u16*)take((size_t)T_TOK * 128 * 2);
  w.wgt = (float*)take((size_t)T_TOK * 128 * 4);
  w.ssq_out = (float*)take((size_t)T_TOK * 16 * 4);
  w.bar = (unsigned*)take(4096 * 4);
  w.gate = (float*)take((size_t)T_TOK * 128 * 4);
  w.rs2v = (float*)take((size_t)T_TOK * 4);
  w.part = (unsigned*)w.xl;
  w.cand = (unsigned*)w.xl;
  w.h1b = w.xb;
  w.tmp_a = (float*)w.Ub;
  w.tmp_b = (float*)w.Vb;
  return w;
}

__global__ void __launch_bounds__(256) k_prep_x(const float* __restrict__ x, u16* __restrict__ xb, float* __restrict__ rs0) {
  int wave = threadIdx.x >> 6, lane = threadIdx.x & 63;
  int t = blockIdx.x * 4 + wave;
  const float4* xr = (const float4*)(x + (size_t)t * 1024);
  float ss = 0.f;
  float4 v[4];
#pragma unroll
  for (int i = 0; i < 4; ++i) {
    v[i] = xr[i * 64 + lane];
    ss += v[i].x * v[i].x + v[i].y * v[i].y + v[i].z * v[i].z + v[i].w * v[i].w;
  }
  ss = wave_sum(ss);
#pragma unroll
  for (int i = 0; i < 4; ++i) {
    ushort4 o;
    o.x = f2bf(v[i].x); o.y = f2bf(v[i].y); o.z = f2bf(v[i].z); o.w = f2bf(v[i].w);
    ((ushort4*)(xb + (size_t)t * 1024))[i * 64 + lane] = o;
  }
  if (lane == 0) rs0[t] = rsqrtf(ss * (1.f / 1024.f) + EPS);
}

__device__ __forceinline__ int win_orig_col(int np) {
  if (np < 1024) return np;
  int r = (np - 1024) >> 6, i = (np - 1024) & 63;
  return (i < 32) ? (1024 + 32 * r + i) : (1536 + 32 * r + (i - 32));
}

template <int MODE>
__global__ void __launch_bounds__(256) k_prep_wT(const float* __restrict__ w, const float* __restrict__ scale_a,
                                                const float* __restrict__ scale_b, u16* __restrict__ out, int N) {
  __shared__ float tile[32][33];
  int n0 = blockIdx.x * 32, k0 = blockIdx.y * 32;
  int tx = threadIdx.x & 31, ty = threadIdx.x >> 5;
  for (int i = ty; i < 32; i += 8) {
    int k = k0 + i;
    int n = n0 + tx;
    int col = (MODE == 1) ? win_orig_col(n) : n;
    float sc;
    if (MODE == 2) sc = (k < 512) ? scale_a[k] : scale_b[k - 512];
    else sc = scale_a[k];
    tile[i][tx] = sc * w[(size_t)k * N + col];
  }
  __syncthreads();
  for (int i = ty; i < 32; i += 8) {
    int n = n0 + i, k = k0 + tx;
    out[(size_t)n * 1024 + k] = f2bf(tile[tx][i]);
  }
}

__global__ void __launch_bounds__(256) k_prep_misc(const float* __restrict__ sub_keys, const float* __restrict__ w_rg,
                                                  const float* __restrict__ w_ig, u16* __restrict__ keysb,
                                                  u16* __restrict__ Wg) {
  int i = blockIdx.x * 256 + threadIdx.x;
  if (i < 16 * 128 * 128) keysb[i] = f2bf(sub_keys[i]);
  if (i < 2 * 8 * 4 * 32 * 64) {
    int k = i & 63, j = (i >> 6) & 31, qq = (i >> 11) & 3, hh = (i >> 13) & 7, dir = (i >> 16) & 1;
    int o = qq * 16 + (j & 15);
    const float* src = (j < 16) ? w_rg : w_ig;
    Wg[i] = f2bf(src[(((size_t)dir * 8 + hh) * 64 + k) * 64 + o]);
  }
}

__global__ void __launch_bounds__(256) k_prep_uv(const float* __restrict__ U, const float* __restrict__ V,
                                                const float* __restrict__ g2, u16* __restrict__ Ub, u16* __restrict__ Vb) {
  size_t i = ((size_t)blockIdx.x * 256 + threadIdx.x);
  if (i >= (size_t)16384 * 256) return;
  int d4 = (int)(i & 255);
  float4 g = ((const float4*)g2)[d4];
  float4 u = ((const float4*)U)[i];
  float4 v = ((const float4*)V)[i];
  ushort4 ou, ov;
  ou.x = f2bf(u.x * g.x); ou.y = f2bf(u.y * g.y); ou.z = f2bf(u.z * g.z); ou.w = f2bf(u.w * g.w);
  ov.x = f2bf(v.x); ov.y = f2bf(v.y); ov.z = f2bf(v.z); ov.w = f2bf(v.w);
  ((ushort4*)Ub)[i] = ou;
  ((ushort4*)Vb)[i] = ov;
}

__device__ __forceinline__ void load_rows8(const u16* __restrict__ A, int t0, float* xs) {
  for (int i = threadIdx.x; i < 8 * 1024; i += 256) xs[i] = bf2f(A[(size_t)t0 * 1024 + i]);
  __syncthreads();
}
__device__ __forceinline__ void dot8(const u16* __restrict__ wrow, const float* xs, int kbeg, int kend, float acc[8]) {
  for (int k = kbeg; k < kend; k += 8) {
    uint4 wv = *(const uint4*)(wrow + k);
    float wf[8];
    wf[0] = __uint_as_float(wv.x << 16); wf[1] = __uint_as_float(wv.x & 0xffff0000u);
    wf[2] = __uint_as_float(wv.y << 16); wf[3] = __uint_as_float(wv.y & 0xffff0000u);
    wf[4] = __uint_as_float(wv.z << 16); wf[5] = __uint_as_float(wv.z & 0xffff0000u);
    wf[6] = __uint_as_float(wv.w << 16); wf[7] = __uint_as_float(wv.w & 0xffff0000u);
#pragma unroll
    for (int r = 0; r < 8; ++r) {
      const float* xr = xs + r * 1024 + k;
      float a = acc[r];
#pragma unroll
      for (int j = 0; j < 8; ++j) a += wf[j] * xr[j];
      acc[r] = a;
    }
  }
}

__global__ void __launch_bounds__(256) k_n_gemm1(WS w) {
  __shared__ float xs[8 * 1024];
  int t0 = blockIdx.x * 8;
  load_rows8(w.xb, t0, xs);
  for (int c = threadIdx.x; c < 512; c += 256) {
    float a0[8] = {0}, a1[8] = {0}, a2[8] = {0}, a3[8] = {0};
    int na = 1024 + 64 * (c >> 5) + (c & 31);
    dot8(w.WinT + (size_t)c * 1024, xs, 0, 1024, a0);
    dot8(w.WinT + (size_t)(512 + c) * 1024, xs, 0, 1024, a1);
    dot8(w.WinT + (size_t)na * 1024, xs, 0, 1024, a2);
    dot8(w.WinT + (size_t)(na + 32) * 1024, xs, 0, 1024, a3);
    for (int r = 0; r < 8; ++r) {
      int t = t0 + r;
      float rs = w.rs0[t];
      w.xl[(size_t)t * 512 + c] = f2bf(rs * a0[r]);
      w.gg[(size_t)t * 512 + c] = f2bf(gelu_tanh(rs * a1[r]));
      w.glu[(size_t)t * 512 + c] = f2bf(rs * a2[r] * sigmoidf_(rs * a3[r]));
    }
  }
}

__global__ void __launch_bounds__(256) k_n_xc(WS w, const float* __restrict__ cw, const float* __restrict__ cb, float* __restrict__ xc) {
  int i = blockIdx.x * 256 + threadIdx.x;
  int c = i & 511, t = i >> 9, s = t & (SEQ - 1);
  float acc = cb[c];
#pragma unroll
  for (int k = 0; k < 4; ++k) {
    int ss = s - 2 + k;
    if (ss >= 0 && ss < SEQ) acc += cw[k * 512 + c] * bf2f(w.xl[(size_t)(t - 2 + k) * 512 + c]);
  }
  xc[i] = acc;
}

template <int DIR>
__global__ void __launch_bounds__(64) k_n_scan(WS w, const float* __restrict__ xc, float* __restrict__ hf,
                                              const float* __restrict__ b_rg, const float* __restrict__ b_ig,
                                              const float* __restrict__ lam) {
  int b = blockIdx.x >> 3, hh = blockIdx.x & 7;
  int cl = threadIdx.x;
  int c = hh * 64 + cl;
  int qq = cl >> 4, j = cl & 15;
  const u16* wr = w.Wg + ((((size_t)DIR * 8 + hh) * 4 + qq) * 32 + j) * 64;
  const u16* wi = wr + 16 * 64;
  float wrf[64], wif[64];
#pragma unroll
  for (int k = 0; k < 64; ++k) { wrf[k] = bf2f(wr[k]); wif[k] = bf2f(wi[k]); }
  float br = b_rg[DIR * 512 + c], bi = b_ig[DIR * 512 + c];
  float Kc = 8.f * log_sigmoidf_(lam[DIR * 512 + c]);
  float h = 0.f;
  for (int st = 0; st < SEQ; ++st) {
    int s = DIR ? (SEQ - 1 - st) : st;
    size_t t = (size_t)b * SEQ + s;
    const float* xr = xc + t * 512 + hh * 64;
    float pr = br, pi = bi;
#pragma unroll
    for (int k = 0; k < 64; ++k) { float xv = xr[k]; pr += xv * wrf[k]; pi += xv * wif[k]; }
    float r = sigmoidf_(pr), ig = sigmoidf_(pi);
    float a = __expf(Kc * r);
    float u = sqrtf(fmaxf(1.f - a * a, 0.f)) * ig * xr[cl];
    h = a * h + u;
    if (DIR == 0) hf[t * 512 + c] = h;
    else {
      float yv = (hf[t * 512 + c] + h) * bf2f(w.gg[t * 512 + c]);
      w.y[t * 1024 + c] = f2bf(yv);
    }
  }
}

__global__ void __launch_bounds__(256) k_n_ssq_lru(WS w) {
  int i = blockIdx.x * 256 + threadIdx.x;
  int t = i >> 5, g = i & 31;
  float s = 0.f;
  for (int k = 0; k < 16; ++k) { float v = bf2f(w.y[(size_t)t * 1024 + g * 16 + k]); s += v * v; }
  w.ssq_lru[i] = s;
}

__global__ void __launch_bounds__(512) k_n_conv(WS w, const float* __restrict__ cw, const float* __restrict__ cb,
                                               const float* __restrict__ ng, const float* __restrict__ nb) {
  __shared__ float red[8];
  int t = blockIdx.x, s = t & (SEQ - 1), c = threadIdx.x;
  float acc = cb[c];
  for (int k = 0; k < 31; ++k) {
    int ss = s - 15 + k;
    if (ss >= 0 && ss < SEQ) acc += cw[k * 512 + c] * bf2f(w.glu[(size_t)(t - 15 + k) * 512 + c]);
  }
  float mu = wave_sum(acc) * (1.f / 64.f);
  float d = acc - mu;
  float var = wave_sum(d * d) * (1.f / 64.f);
  float v = d * rsqrtf(var + EPS) * ng[c] + nb[c];
  float yv = v * sigmoidf_(v);
  float sq = wave_sum(yv * yv);
  if ((c & 63) == 0) red[c >> 6] = sq;
  __syncthreads();
  float tot = 0.f;
  for (int i = 0; i < 8; ++i) tot += red[i];
  float rc = rsqrtf(tot * (1.f / 512.f) + EPS);
  w.y[(size_t)t * 1024 + 512 + c] = f2bf(yv * rc);
}

__global__ void __launch_bounds__(256) k_n_gemm2(WS w, const float* __restrict__ x, float* __restrict__ h1) {
  __shared__ float xs[8 * 1024];
  int t0 = blockIdx.x * 8;
  load_rows8(w.y, t0, xs);
  float rl[8];
  for (int r = 0; r < 8; ++r) {
    float s = 0.f;
    for (int g = 0; g < 32; ++g) s += w.ssq_lru[(size_t)(t0 + r) * 32 + g];
    rl[r] = rsqrtf(s * (1.f / 512.f) + EPS);
  }
  for (int n = threadIdx.x; n < 1024; n += 256) {
    float a0[8] = {0}, a1[8] = {0};
    dot8(w.WoutT + (size_t)n * 1024, xs, 0, 512, a0);
    dot8(w.WoutT + (size_t)n * 1024, xs, 512, 1024, a1);
    for (int r = 0; r < 8; ++r) {
      size_t o = (size_t)(t0 + r) * 1024 + n;
      float hv = x[o] + rl[r] * a0[r] + a1[r];
      h1[o] = hv;
    }
  }
}
__global__ void __launch_bounds__(256) k_n_h1stat(WS w, const float* __restrict__ h1) {
  int wave = threadIdx.x >> 6, lane = threadIdx.x & 63;
  int t = blockIdx.x * 4 + wave;
  float ss = 0.f;
  for (int i = 0; i < 16; ++i) {
    float v = h1[(size_t)t * 1024 + lane * 16 + i];
    ss += v * v;
    w.h1b[(size_t)t * 1024 + lane * 16 + i] = f2bf(v);
  }
  ss += __shfl_xor(ss, 1, 64); ss += __shfl_xor(ss, 2, 64);
  if ((lane & 3) == 0) w.ssq_h1[(size_t)t * 16 + (lane >> 2)] = ss;
}

__device__ __forceinline__ float rs2_of(const float* ssq_h1, int t) {
  float s = 0.f;
  for (int j = 0; j < 16; ++j) s += ssq_h1[(size_t)t * 16 + j];
  return rsqrtf(s * (1.f / 1024.f) + EPS);
}

__global__ void __launch_bounds__(256) k_n_gemm3(WS w, u16* __restrict__ qb) {
  __shared__ float xs[8 * 1024];
  int t0 = blockIdx.x * 8;
  load_rows8(w.h1b, t0, xs);
  float rs[8];
  for (int r = 0; r < 8; ++r) rs[r] = rs2_of(w.ssq_h1, t0 + r);
  for (int n = threadIdx.x; n < 2048; n += 256) {
    float a0[8] = {0};
    dot8(w.WqT + (size_t)n * 1024, xs, 0, 1024, a0);
    for (int r = 0; r < 8; ++r) qb[(size_t)(t0 + r) * 2048 + n] = f2bf(rs[r] * a0[r]);
  }
}
__global__ void __launch_bounds__(256) k_n_topk(WS w, const u16* __restrict__ qb) {
  __shared__ float sc[16 * 128];
  __shared__ float qs[2048];
  int t = blockIdx.x;
  for (int i = threadIdx.x; i < 2048; i += 256) qs[i] = bf2f(qb[(size_t)t * 2048 + i]);
  __syncthreads();
  for (int i = threadIdx.x; i < 2048; i += 256) {
    int hp = i >> 7, key = i & 127;
    const u16* kr = w.keysb + ((size_t)hp * 128 + key) * 128;
    float a = 0.f;
    for (int c = 0; c < 128; ++c) a += qs[hp * 128 + c] * bf2f(kr[c]);
    sc[i] = a;
  }
  __syncthreads();
  if (threadIdx.x < 16) {
    int hp = threadIdx.x;
    float* s = sc + hp * 128;
    for (int j = 0; j < 16; ++j) {
      float best = -3.0e38f; int bi = 0;
      for (int k = 0; k < 128; ++k) if (s[k] > best) { best = s[k]; bi = k; }
      s[bi] = -3.0e38f;
      w.cand[((size_t)t * 16 + hp) * 16 + j] = (__float_as_uint(best) & ~127u) | (unsigned)bi;
    }
  }
}

__global__ void __launch_bounds__(256) k_n_peer(WS w, const float* h1, const float* __restrict__ gF, float* out) {
  __shared__ float cs[8][256];
  __shared__ int ce[8][256];
  __shared__ int sel_e[128];
  __shared__ float sel_g[128];
  __shared__ float wj[128];
  __shared__ float hs[1024];
  __shared__ float red[4];
  int t = blockIdx.x, tid = threadIdx.x;
  for (int i = tid; i < 1024; i += 256) hs[i] = bf2f(w.h1b[(size_t)t * 1024 + i]);
  for (int h = 0; h < 8; ++h) {
    int a = tid >> 4, b = tid & 15;
    unsigned pa = w.cand[((size_t)t * 16 + 2 * h) * 16 + a];
    unsigned pb = w.cand[((size_t)t * 16 + 2 * h + 1) * 16 + b];
    cs[h][tid] = __uint_as_float(pa) + __uint_as_float(pb);
    ce[h][tid] = (int)(pa & 127u) * 128 + (int)(pb & 127u);
  }
  __syncthreads();
  if (tid < 8) {
    int h = tid;
    float top[16]; int te[16];
    float mx = -3.0e38f;
    for (int j = 0; j < 16; ++j) {
      float best = -3.0e38f; int bi = 0;
      for (int k = 0; k < 256; ++k) if (cs[h][k] > best) { best = cs[h][k]; bi = k; }
      cs[h][bi] = -3.0e38f;
      top[j] = best; te[j] = ce[h][bi];
      mx = fmaxf(mx, best);
    }
    float sum = 0.f;
    for (int j = 0; j < 16; ++j) { top[j] = __expf(top[j] - mx); sum += top[j]; }
    float inv = 1.f / sum;
    for (int j = 0; j < 16; ++j) { sel_e[h * 16 + j] = te[j]; sel_g[h * 16 + j] = top[j] * inv; }
  }
  __syncthreads();
  float rs2 = rs2_of(w.ssq_h1, t);
  int wave = tid >> 6, lane = tid & 63;
  for (int j = wave; j < 128; j += 4) {
    const u16* ur = w.Ub + (size_t)sel_e[j] * 1024;
    float a = 0.f;
    for (int i = 0; i < 16; ++i) a += bf2f(ur[lane * 16 + i]) * hs[lane * 16 + i];
    a = wave_sum(a);
    if (lane == 0) wj[j] = sel_g[j] * gelu_tanh(rs2 * a);
  }
  __syncthreads();
  float acc[4] = {0, 0, 0, 0};
  for (int j = 0; j < 128; ++j) {
    const u16* vr = w.Vb + (size_t)sel_e[j] * 1024;
    float ww = wj[j];
#pragma unroll
    for (int i = 0; i < 4; ++i) acc[i] += ww * bf2f(vr[tid * 4 + i]);
  }
  float hv[4]; float ss = 0.f;
#pragma unroll
  for (int i = 0; i < 4; ++i) { hv[i] = h1[(size_t)t * 1024 + tid * 4 + i] + acc[i]; ss += hv[i] * hv[i]; }
  ss = wave_sum(ss);
  if (lane == 0) red[wave] = ss;
  __syncthreads();
  float tot = red[0] + red[1] + red[2] + red[3];
  float rn = rsqrtf(tot * (1.f / 1024.f) + EPS);
#pragma unroll
  for (int i = 0; i < 4; ++i) out[(size_t)t * 1024 + tid * 4 + i] = hv[i] * rn * gF[tid * 4 + i];
}


#define GEMM_BUF_BYTES 49152
#define GEMM_LDS_BYTES (2 * GEMM_BUF_BYTES)

__device__ __forceinline__ int swz_off(int row, int c) { return row * 128 + ((c ^ ((row >> 1) & 7)) << 4); }

__device__ __forceinline__ void gemm_core(const u16* __restrict__ A, const u16* __restrict__ Bt, int m0, int n0,
                                          int kbeg, int kend, char* smem, f32x16 (&acc)[2][2]) {
  const int tid = threadIdx.x, lane = tid & 63, wid = tid >> 6;
  const int wm = wid >> 1, wn = wid & 1;
  uint4 ra[4], rb[2];
  const int srow = tid >> 3, sc = tid & 7;
  const u16* Ap = A + (size_t)(m0 + srow) * 1024 + sc * 8;
  const u16* Bp = Bt + (size_t)(n0 + srow) * 1024 + sc * 8;
  const int nk = (kend - kbeg) >> 6;
#pragma unroll
  for (int i = 0; i < 4; ++i) ra[i] = *(const uint4*)(Ap + (size_t)i * 64 * 1024 + kbeg);
#pragma unroll
  for (int i = 0; i < 2; ++i) rb[i] = *(const uint4*)(Bp + (size_t)i * 64 * 1024 + kbeg);
  {
    char* As = smem; char* Bs = smem + 32768;
#pragma unroll
    for (int i = 0; i < 4; ++i) *(uint4*)(As + swz_off(srow + 64 * i, sc)) = ra[i];
#pragma unroll
    for (int i = 0; i < 2; ++i) *(uint4*)(Bs + swz_off(srow + 64 * i, sc)) = rb[i];
  }
  __syncthreads();
  for (int kt = 0; kt < nk; ++kt) {
    const int buf = kt & 1;
    const bool more = (kt + 1 < nk);
    if (more) {
      const int k0 = kbeg + (kt + 1) * 64;
#pragma unroll
      for (int i = 0; i < 4; ++i) ra[i] = *(const uint4*)(Ap + (size_t)i * 64 * 1024 + k0);
#pragma unroll
      for (int i = 0; i < 2; ++i) rb[i] = *(const uint4*)(Bp + (size_t)i * 64 * 1024 + k0);
    }
    const char* As = smem + buf * GEMM_BUF_BYTES;
    const char* Bs = As + 32768;
#pragma unroll
    for (int ks = 0; ks < 4; ++ks) {
      const int c = ks * 2 + (lane >> 5);
      bf16x8 af[2], bfr[2];
#pragma unroll
      for (int mi = 0; mi < 2; ++mi) af[mi] = *(const bf16x8*)(As + swz_off(wm * 64 + mi * 32 + (lane & 31), c));
#pragma unroll
      for (int ni = 0; ni < 2; ++ni) bfr[ni] = *(const bf16x8*)(Bs + swz_off(wn * 64 + ni * 32 + (lane & 31), c));
#pragma unroll
      for (int mi = 0; mi < 2; ++mi)
#pragma unroll
        for (int ni = 0; ni < 2; ++ni)
          acc[mi][ni] = __builtin_amdgcn_mfma_f32_32x32x16_bf16(af[mi], bfr[ni], acc[mi][ni], 0, 0, 0);
    }
    if (more) {
      char* As2 = smem + (buf ^ 1) * GEMM_BUF_BYTES; char* Bs2 = As2 + 32768;
#pragma unroll
      for (int i = 0; i < 4; ++i) *(uint4*)(As2 + swz_off(srow + 64 * i, sc)) = ra[i];
#pragma unroll
      for (int i = 0; i < 2; ++i) *(uint4*)(Bs2 + swz_off(srow + 64 * i, sc)) = rb[i];
    }
    __syncthreads();
  }
}

__device__ __forceinline__ void zero_acc(f32x16 (&acc)[2][2]) {
#pragma unroll
  for (int mi = 0; mi < 2; ++mi)
#pragma unroll
    for (int ni = 0; ni < 2; ++ni)
#pragma unroll
      for (int r = 0; r < 16; ++r) acc[mi][ni][r] = 0.f;
}

__device__ __forceinline__ void p1_tile(const WS& w, int tile, int nblk_g, char* smem) {
  const int it = tile >> 8, b = tile & 255, g = b & 7, j = b >> 3;
  const int mt = it * 16 + g * 2 + (j >> 4), nt = j & 15;
  const int m0 = mt * 256, n0 = nt * 128;
  f32x16 acc[2][2];
  zero_acc(acc);
  gemm_core(w.xb, w.WinT, m0, n0, 0, 1024, smem, acc);
  const int lane = threadIdx.x & 63, wid = threadIdx.x >> 6, wm = wid >> 1, wn = wid & 1;
  const int nb = n0 + wn * 64;
#pragma unroll
  for (int mi = 0; mi < 2; ++mi) {
#pragma unroll
    for (int r = 0; r < 16; ++r) {
      const int row = m0 + wm * 64 + mi * 32 + (r & 3) + 8 * (r >> 2) + 4 * (lane >> 5);
      const float rs = w.rs0[row];
      if (nb < 512) {
#pragma unroll
        for (int ni = 0; ni < 2; ++ni) w.xl[(size_t)row * 512 + nb + ni * 32 + (lane & 31)] = f2bf(rs * acc[mi][ni][r]);
      } else if (nb < 1024) {
#pragma unroll
        for (int ni = 0; ni < 2; ++ni) w.gg[(size_t)row * 512 + (nb - 512) + ni * 32 + (lane & 31)] = f2bf(gelu_tanh(rs * acc[mi][ni][r]));
      } else {
        const int ch = ((nb - 1024) >> 6) * 32 + (lane & 31);
        const float a = rs * acc[mi][0][r], bb = rs * acc[mi][1][r];
        w.glu[(size_t)row * 512 + ch] = f2bf(a * sigmoidf_(bb));
      }
    }
  }
}
__global__ void __launch_bounds__(512) k_p1(WS w) {
  extern __shared__ __attribute__((aligned(16))) char smem[];
  for (int tile = blockIdx.x; tile < 1024; tile += gridDim.x) p1_tile(w, tile, gridDim.x, smem);
}

__device__ __forceinline__ void p3_tile(const WS& w, const float* __restrict__ x, float* __restrict__ h1, int tile, char* smem) {
  const int it = tile >> 8, b = tile & 255, g = b & 7, j = b >> 3;
  const int mt = it * 32 + g * 4 + (j >> 3), nt = j & 7;
  const int m0 = mt * 256, n0 = nt * 128;
  const int lane = threadIdx.x & 63, wid = threadIdx.x >> 6, wm = wid >> 1, wn = wid & 1;
  float* rls = (float*)(smem + GEMM_LDS_BYTES);
  if (threadIdx.x < 256) {
    const float4* p = (const float4*)(w.ssq_lru + (size_t)(m0 + threadIdx.x) * 32);
    float s = 0.f;
#pragma unroll
    for (int i = 0; i < 8; ++i) { float4 v = p[i]; s += v.x + v.y + v.z + v.w; }
    rls[threadIdx.x] = rsqrtf(s * (1.f / 512.f) + EPS);
  }
  f32x16 acc[2][2];
  zero_acc(acc);
  gemm_core(w.y, w.WoutT, m0, n0, 0, 512, smem, acc);
#pragma unroll
  for (int mi = 0; mi < 2; ++mi)
#pragma unroll
    for (int r = 0; r < 16; ++r) {
      const float s = rls[wm * 64 + mi * 32 + (r & 3) + 8 * (r >> 2) + 4 * (lane >> 5)];
      acc[mi][0][r] *= s; acc[mi][1][r] *= s;
    }
  gemm_core(w.y, w.WoutT, m0, n0, 512, 1024, smem, acc);
#pragma unroll
  for (int mi = 0; mi < 2; ++mi) {
#pragma unroll
    for (int r = 0; r < 16; ++r) {
      const int row = m0 + wm * 64 + mi * 32 + (r & 3) + 8 * (r >> 2) + 4 * (lane >> 5);
      float ss = 0.f;
#pragma unroll
      for (int ni = 0; ni < 2; ++ni) {
        const size_t o = (size_t)row * 1024 + n0 + wn * 64 + ni * 32 + (lane & 31);
        const float hv = x[o] + acc[mi][ni][r];
        h1[o] = hv;
        w.h1b[o] = f2bf(hv);
        ss += hv * hv;
      }
      ss += __shfl_xor(ss, 1, 64); ss += __shfl_xor(ss, 2, 64); ss += __shfl_xor(ss, 4, 64);
      ss += __shfl_xor(ss, 8, 64); ss += __shfl_xor(ss, 16, 64);
      if ((lane & 31) == 0) w.ssq_h1[(size_t)row * 16 + nt * 2 + wn] = ss;
    }
  }
  __syncthreads();
}
__global__ void __launch_bounds__(512) k_p3(WS w, const float* __restrict__ x, float* __restrict__ h1) {
  extern __shared__ __attribute__((aligned(16))) char smem[];
  for (int tile = blockIdx.x; tile < 512; tile += gridDim.x) p3_tile(w, x, h1, tile, smem);
}


__device__ __forceinline__ int swz256(int row, int c) { return row * 256 + ((c ^ (row & 15)) << 4); }

__device__ __forceinline__ void cmpswap_desc(float& a, float& b) { float mx = fmaxf(a, b), mn = fminf(a, b); a = mx; b = mn; }

__device__ __forceinline__ void p4_tile(const WS& w, int tile, char* smem) {
  const int it = tile >> 8, b = tile & 255, g = b & 7, j = b >> 3;
  const int mt = it * 16 + g * 2 + (j >> 4), hp = j & 15;
  const int m0 = mt * 256, n0 = hp * 128;
  const int tid = threadIdx.x, lane = tid & 63, wid = tid >> 6, wm = wid >> 1, wn = wid & 1;
  float* rls = (float*)(smem + GEMM_LDS_BYTES);
  if (tid < 256) {
    const float4* p = (const float4*)(w.ssq_h1 + (size_t)(m0 + tid) * 16);
    float s = 0.f;
#pragma unroll
    for (int i = 0; i < 4; ++i) { float4 v = p[i]; s += v.x + v.y + v.z + v.w; }
    rls[tid] = rsqrtf(s * (1.f / 1024.f) + EPS);
  }
  f32x16 acc[2][2];
  zero_acc(acc);
  gemm_core(w.h1b, w.WqT, m0, n0, 0, 1024, smem, acc);
  char* qs = smem;
  char* ksm = smem + 65536;
#pragma unroll
  for (int mi = 0; mi < 2; ++mi)
#pragma unroll
    for (int r = 0; r < 16; ++r) {
      const int row = wm * 64 + mi * 32 + (r & 3) + 8 * (r >> 2) + 4 * (lane >> 5);
      const float rs = rls[row];
#pragma unroll
      for (int ni = 0; ni < 2; ++ni) {
        const int col = wn * 64 + ni * 32 + (lane & 31);
        *(u16*)(qs + swz256(row, col >> 3) + (col & 7) * 2) = f2bf(rs * acc[mi][ni][r]);
      }
    }
  {
    const u16* kp = w.keysb + (size_t)hp * 128 * 128;
#pragma unroll
    for (int i = 0; i < 4; ++i) {
      const int q = tid + 512 * i, row = q >> 4, c = q & 15;
      *(uint4*)(ksm + swz256(row, c)) = *(const uint4*)(kp + row * 128 + c * 8);
    }
  }
  __syncthreads();
  f32x16 sacc[4];
#pragma unroll
  for (int ni = 0; ni < 4; ++ni)
#pragma unroll
    for (int r = 0; r < 16; ++r) sacc[ni][r] = 0.f;
#pragma unroll
  for (int ks = 0; ks < 8; ++ks) {
    const int c = ks * 2 + (lane >> 5);
    bf16x8 af = *(const bf16x8*)(qs + swz256(wid * 32 + (lane & 31), c));
#pragma unroll
    for (int ni = 0; ni < 4; ++ni) {
      bf16x8 bfr = *(const bf16x8*)(ksm + swz256(ni * 32 + (lane & 31), c));
      sacc[ni] = __builtin_amdgcn_mfma_f32_32x32x16_bf16(af, bfr, sacc[ni], 0, 0, 0);
    }
  }
  {
    const int l31 = lane & 31;
    int v0[16], v1[16], v2[16], v3[16], res[16];
#pragma unroll
    for (int r = 0; r < 16; ++r) {
      int k0 = (int)((__float_as_uint(sacc[0][r]) & ~127u) | (unsigned)(l31));
      int k1 = (int)((__float_as_uint(sacc[1][r]) & ~127u) | (unsigned)(32 + l31));
      int k2 = (int)((__float_as_uint(sacc[2][r]) & ~127u) | (unsigned)(64 + l31));
      int k3 = (int)((__float_as_uint(sacc[3][r]) & ~127u) | (unsigned)(96 + l31));
      k0 ^= (k0 >> 31) & 0x7fffffff; k1 ^= (k1 >> 31) & 0x7fffffff;
      k2 ^= (k2 >> 31) & 0x7fffffff; k3 ^= (k3 >> 31) & 0x7fffffff;
      int t;
      t = max(k0, k1); k1 = min(k0, k1); k0 = t;
      t = max(k2, k3); k3 = min(k2, k3); k2 = t;
      t = max(k0, k2); k2 = min(k0, k2); k0 = t;
      t = max(k1, k3); k3 = min(k1, k3); k1 = t;
      t = max(k1, k2); k2 = min(k1, k2); k1 = t;
      v0[r] = k0; v1[r] = k1; v2[r] = k2; v3[r] = k3;
      res[r] = (int)0x80000000;
    }
#pragma unroll 1
    for (int jj = 0; jj < 16; ++jj) {
      const bool isj = (l31 == jj);
#pragma unroll
      for (int r = 0; r < 16; ++r) {
        int m = v0[r];
        m = max(m, __builtin_amdgcn_update_dpp(0, m, 0xB1, 0xF, 0xF, true));
        m = max(m, __builtin_amdgcn_update_dpp(0, m, 0x4E, 0xF, 0xF, true));
        m = max(m, __builtin_amdgcn_update_dpp(0, m, 0x141, 0xF, 0xF, true));
        m = max(m, __builtin_amdgcn_update_dpp(0, m, 0x140, 0xF, 0xF, true));
        auto sw = __builtin_amdgcn_permlane16_swap(m, m, false, false);
        m = max((int)sw[0], (int)sw[1]);
        const bool hit = (v0[r] == m);
        v0[r] = hit ? v1[r] : v0[r];
        v1[r] = hit ? v2[r] : v1[r];
        v2[r] = hit ? v3[r] : v2[r];
        v3[r] = hit ? (int)0x80000000 : v3[r];
        res[r] = isj ? m : res[r];
      }
    }
#pragma unroll
    for (int r = 0; r < 16; ++r) {
      const int row = m0 + wid * 32 + (r & 3) + 8 * (r >> 2) + 4 * (lane >> 5);
      const int key = res[r];
      const unsigned pk = (unsigned)(key ^ ((key >> 31) & 0x7fffffff));
      if (l31 < 16) w.cand[((size_t)row * 16 + hp) * 16 + l31] = pk;
    }
  }
  __syncthreads();
}
__global__ void __launch_bounds__(512) k_p4(WS w) {
  extern __shared__ __attribute__((aligned(16))) char smem[];
  for (int tile = blockIdx.x; tile < 1024; tile += gridDim.x) p4_tile(w, tile, smem);
}

typedef __attribute__((ext_vector_type(2))) __bf16 bf16x2_t;
__device__ __forceinline__ float dot2bf(unsigned a, unsigned b, float c) {
  return __builtin_amdgcn_fdot2_f32_bf16(__builtin_bit_cast(bf16x2_t, a), __builtin_bit_cast(bf16x2_t, b), c, false);
}
__device__ __forceinline__ float dot8bf(uint4 a, uint4 b, float c) {
  c = dot2bf(a.x, b.x, c); c = dot2bf(a.y, b.y, c); c = dot2bf(a.z, b.z, c); c = dot2bf(a.w, b.w, c);
  return c;
}
__device__ __forceinline__ void axpy8(float (&acc)[8], float wgt, uint4 v) {
  acc[0] += wgt * __uint_as_float(v.x << 16); acc[1] += wgt * __uint_as_float(v.x & 0xffff0000u);
  acc[2] += wgt * __uint_as_float(v.y << 16); acc[3] += wgt * __uint_as_float(v.y & 0xffff0000u);
  acc[4] += wgt * __uint_as_float(v.z << 16); acc[5] += wgt * __uint_as_float(v.z & 0xffff0000u);
  acc[6] += wgt * __uint_as_float(v.w << 16); acc[7] += wgt * __uint_as_float(v.w & 0xffff0000u);
}

__device__ __forceinline__ void p5_route(const WS& w, int t, int ca, int cb) {
  const int lane = threadIdx.x & 63;
#pragma unroll 1
  for (int h = 0; h < 8; ++h) {
    float s = -3.0e38f; int e = 0;
    if (lane < 50) {
      const unsigned pa = w.cand[((size_t)t * 16 + 2 * h) * 16 + ca];
      const unsigned pb = w.cand[((size_t)t * 16 + 2 * h + 1) * 16 + cb];
      s = __uint_as_float(pa) + __uint_as_float(pb);
      e = (int)(pa & 127u) * 128 + (int)(pb & 127u);
      s = __uint_as_float((__float_as_uint(s) & ~63u) | (unsigned)lane);
    }
    int rank = 0;
#pragma unroll
    for (int jj = 0; jj < 50; ++jj) {
      const float sj = __int_as_float(__builtin_amdgcn_readlane(__float_as_int(s), jj));
      rank += (sj > s) ? 1 : 0;
    }
    const bool sel = (lane < 50) && (rank < 16);
    float mx = sel ? s : -3.0e38f;
#pragma unroll
    for (int o = 32; o > 0; o >>= 1) mx = fmaxf(mx, __shfl_xor(mx, o, 64));
    const float ex = sel ? __expf(s - mx) : 0.f;
    const float sum = wave_sum(ex);
    if (sel) {
      w.sel_e[(size_t)t * 128 + h * 16 + rank] = (u16)e;
      w.gate[(size_t)t * 128 + h * 16 + rank] = ex / sum;
    }
  }
  float sq = (lane < 16) ? w.ssq_h1[(size_t)t * 16 + lane] : 0.f;
  sq = wave_sum(sq);
  if (lane == 0) w.rs2v[t] = rsqrtf(sq * (1.f / 1024.f) + EPS);
}

__device__ __forceinline__ f32x2 fp8lo(unsigned d) { return __builtin_amdgcn_cvt_pk_f32_fp8((int)d, false); }
__device__ __forceinline__ f32x2 fp8hi(unsigned d) { return __builtin_amdgcn_cvt_pk_f32_fp8((int)d, true); }
__device__ __forceinline__ f32x2 bfpair(unsigned d) { f32x2 r; r.x = __uint_as_float(d << 16); r.y = __uint_as_float(d & 0xffff0000u); return r; }

__device__ __forceinline__ void p5_token_slice(const WS& w, int t, int s) {
  const int lane = threadIdx.x & 63;
  const unsigned epair = ((const unsigned*)w.sel_e)[(size_t)t * 64 + lane];
  const u16* xp = w.h1b + (size_t)t * 1024 + s * 128 + (lane & 7) * 16;
  const uint4 xa = *(const uint4*)xp, xb4 = *(const uint4*)(xp + 8);
  f32x2 x2[8];
  x2[0] = bfpair(xa.x); x2[1] = bfpair(xa.y); x2[2] = bfpair(xa.z); x2[3] = bfpair(xa.w);
  x2[4] = bfpair(xb4.x); x2[5] = bfpair(xb4.y); x2[6] = bfpair(xb4.z); x2[7] = bfpair(xb4.w);
  const char* ubase = (const char*)w.Ub + (size_t)s * 16384 * 128 + (lane & 7) * 16;
  uint4 u[16];
#pragma unroll
  for (int i = 0; i < 16; ++i) {
    const int srcl = 4 * i + (lane >> 4);
    const unsigned ep = (unsigned)__shfl((int)epair, srcl, 64);
    const unsigned e = ((lane >> 3) & 1) ? (ep >> 16) : (ep & 0xffffu);
    u[i] = *(const uint4*)(ubase + (size_t)e * 128);
  }
  float p[16];
#pragma unroll
  for (int i = 0; i < 16; ++i) {
    f32x2 a = {0.f, 0.f};
    a = __builtin_elementwise_fma(fp8lo(u[i].x), x2[0], a); a = __builtin_elementwise_fma(fp8hi(u[i].x), x2[1], a);
    a = __builtin_elementwise_fma(fp8lo(u[i].y), x2[2], a); a = __builtin_elementwise_fma(fp8hi(u[i].y), x2[3], a);
    a = __builtin_elementwise_fma(fp8lo(u[i].z), x2[4], a); a = __builtin_elementwise_fma(fp8hi(u[i].z), x2[5], a);
    a = __builtin_elementwise_fma(fp8lo(u[i].w), x2[6], a); a = __builtin_elementwise_fma(fp8hi(u[i].w), x2[7], a);
    p[i] = a.x + a.y;
  }
#pragma unroll
  for (int c = 0; c < 8; ++c) {
    const bool up = (lane & 4) != 0;
    const float send = up ? p[c] : p[c + 8];
    const float keep = up ? p[c + 8] : p[c];
    p[c] = keep + __shfl_xor(send, 4, 64);
  }
#pragma unroll
  for (int c = 0; c < 4; ++c) {
    const bool up = (lane & 2) != 0;
    const float send = up ? p[c] : p[c + 4];
    const float keep = up ? p[c + 4] : p[c];
    p[c] = keep + __shfl_xor(send, 2, 64);
  }
#pragma unroll
  for (int c = 0; c < 2; ++c) {
    const bool up = (lane & 1) != 0;
    const float send = up ? p[c] : p[c + 2];
    const float keep = up ? p[c + 2] : p[c];
    p[c] = keep + __shfl_xor(send, 1, 64);
  }
  const _Float16 h0 = (_Float16)(p[0] * (1.f / PEER_SU)), h1v = (_Float16)(p[1] * (1.f / PEER_SU));
  const unsigned pk = (unsigned)__builtin_bit_cast(unsigned short, h0) | ((unsigned)__builtin_bit_cast(unsigned short, h1v) << 16);
  w.part[((size_t)t * 8 + s) * 64 + lane] = pk;
}

__device__ __forceinline__ void p5_wphase(const WS& w, int t) {
  const int lane = threadIdx.x & 63;
  float d0 = 0.f, d1 = 0.f;
#pragma unroll
  for (int s = 0; s < 8; ++s) {
    const unsigned pk = w.part[((size_t)t * 8 + s) * 64 + lane];
    d0 += (float)__builtin_bit_cast(_Float16, (unsigned short)(pk & 0xffffu));
    d1 += (float)__builtin_bit_cast(_Float16, (unsigned short)(pk >> 16));
  }
  const float rs2 = w.rs2v[t];
  const int p0 = 16 * (lane & 7) + (lane >> 3), p1 = p0 + 8;
  w.wgt[(size_t)t * 128 + p0] = w.gate[(size_t)t * 128 + p0] * gelu_tanh(rs2 * d0);
  w.wgt[(size_t)t * 128 + p1] = w.gate[(size_t)t * 128 + p1] * gelu_tanh(rs2 * d1);
}

__device__ __forceinline__ void p6_token_slice(const WS& w, int t, int s, const float* h1, float* out, bool dry = false) {
  const int lane = threadIdx.x & 63;
  const unsigned epair = ((const unsigned*)w.sel_e)[(size_t)t * 64 + lane];
  const float2 wpair = ((const float2*)w.wgt)[(size_t)t * 64 + lane];
  const char* vbase = (const char*)w.Vb + (size_t)s * 16384 * 128 + (lane & 7) * 16;
  uint4 v[16];
  float wi[16];
#pragma unroll
  for (int i = 0; i < 16; ++i) {
    const int srcl = 4 * i + (lane >> 4);
    const unsigned ep = (unsigned)__shfl((int)epair, srcl, 64);
    const float w0 = __shfl(wpair.x, srcl, 64), w1 = __shfl(wpair.y, srcl, 64);
    const bool hi = (lane >> 3) & 1;
    const unsigned e = hi ? (ep >> 16) : (ep & 0xffffu);
    wi[i] = hi ? w1 : w0;
    v[i] = *(const uint4*)(vbase + (size_t)e * 128);
  }
  f32x2 a2[8];
#pragma unroll
  for (int c = 0; c < 8; ++c) { a2[c].x = 0.f; a2[c].y = 0.f; }
#pragma unroll
  for (int i = 0; i < 16; ++i) {
    f32x2 wv; wv.x = wi[i]; wv.y = wi[i];
    a2[0] = __builtin_elementwise_fma(fp8lo(v[i].x), wv, a2[0]); a2[1] = __builtin_elementwise_fma(fp8hi(v[i].x), wv, a2[1]);
    a2[2] = __builtin_elementwise_fma(fp8lo(v[i].y), wv, a2[2]); a2[3] = __builtin_elementwise_fma(fp8hi(v[i].y), wv, a2[3]);
    a2[4] = __builtin_elementwise_fma(fp8lo(v[i].z), wv, a2[4]); a2[5] = __builtin_elementwise_fma(fp8hi(v[i].z), wv, a2[5]);
    a2[6] = __builtin_elementwise_fma(fp8lo(v[i].w), wv, a2[6]); a2[7] = __builtin_elementwise_fma(fp8hi(v[i].w), wv, a2[7]);
  }
  float acc[16];
#pragma unroll
  for (int c = 0; c < 8; ++c) { acc[2 * c] = a2[c].x; acc[2 * c + 1] = a2[c].y; }
#pragma unroll
  for (int c = 0; c < 8; ++c) {
    const bool up = (lane & 32) != 0;
    const float send = up ? acc[c] : acc[c + 8];
    const float keep = up ? acc[c + 8] : acc[c];
    acc[c] = keep + __shfl_xor(send, 32, 64);
  }
#pragma unroll
  for (int c = 0; c < 4; ++c) {
    const bool up = (lane & 16) != 0;
    const float send = up ? acc[c] : acc[c + 4];
    const float keep = up ? acc[c + 4] : acc[c];
    acc[c] = keep + __shfl_xor(send, 16, 64);
  }
#pragma unroll
  for (int c = 0; c < 2; ++c) {
    const bool up = (lane & 8) != 0;
    const float send = up ? acc[c] : acc[c + 2];
    const float keep = up ? acc[c + 2] : acc[c];
    acc[c] = keep + __shfl_xor(send, 8, 64);
  }
  const int col = s * 128 + (lane & 7) * 16 + ((lane >> 5) & 1) * 8 + ((lane >> 4) & 1) * 4 + ((lane >> 3) & 1) * 2;
  const size_t o = (size_t)t * 1024 + col;
  const float2 hin = *(const float2*)(h1 + o);
  const float hv0 = hin.x + acc[0] * (1.f / PEER_SV), hv1 = hin.y + acc[1] * (1.f / PEER_SV);
  if (dry) { asm volatile("" :: "v"(hv0), "v"(hv1)); return; }
  *(float2*)(out + o) = make_float2(hv0, hv1);
  const float ss = wave_sum(hv0 * hv0 + hv1 * hv1);
  if (lane == 0) w.ssq_out[(size_t)t * 16 + s] = ss;
}

__device__ __forceinline__ void p7_row(const WS& w, int t, const float* __restrict__ gF, float* out, bool dry = false) {
  const int lane = threadIdx.x & 63;
  float s = (lane < 8) ? w.ssq_out[(size_t)t * 16 + lane] : 0.f;
  s = wave_sum(s);
  const float rn = rsqrtf(s * (1.f / 1024.f) + EPS);
  float4* orow = (float4*)(out + (size_t)t * 1024);
#pragma unroll
  for (int i = 0; i < 4; ++i) {
    float4 v = orow[i * 64 + lane];
    const float4 g = ((const float4*)gF)[i * 64 + lane];
    v.x *= rn * g.x; v.y *= rn * g.y; v.z *= rn * g.z; v.w *= rn * g.w;
    if (dry) { asm volatile("" :: "v"(v.x), "v"(v.y), "v"(v.z), "v"(v.w)); continue; }
    orow[i * 64 + lane] = v;
  }
}

__device__ __forceinline__ void staircase_ab(int lane, int& ca, int& cb) {
  ca = 0; cb = 0;
  int cnt = 0;
  for (int a = 0; a < 16; ++a) {
    const int nb = 16 / (a + 1);
    if (lane >= cnt && lane < cnt + nb) { ca = a; cb = lane - cnt; }
    cnt += nb;
  }
}


#define LRU_XCT 0
#define LRU_GX 32768
#define LRU_HF (32768 + 33792)
#define LRU_SUM (LRU_HF + 65536)
#define LRU_CARRY (LRU_SUM + 4096)
#define LRU_LDS_BYTES (LRU_CARRY + 128)

struct LruParams {
  const float* cw; const float* cb; const float* b_rg; const float* b_ig; const float* lam;
};

template <int DIR>
__device__ __forceinline__ void lru_pass(const WS& w, const LruParams& P, int b, int hh, int qq, char* smem) {
  const int tid = threadIdx.x, lane = tid & 63, wid = tid >> 6;
  char* xct = smem + LRU_XCT;
  char* gx = smem + LRU_GX;
  float* Gt = (float*)(smem + LRU_GX);
  u16* hf = (u16*)(smem + LRU_HF);
  float* sumA = (float*)(smem + LRU_SUM);
  float* sumB = sumA + 512;
  float* carry = (float*)(smem + LRU_CARRY);
  bf16x8 bw[4];
  {
    const u16* wg = w.Wg + (((size_t)DIR * 8 + hh) * 4 + qq) * 32 * 64;
#pragma unroll
    for (int ks = 0; ks < 4; ++ks) bw[ks] = *(const bf16x8*)(wg + (lane & 31) * 64 + ks * 16 + 8 * (lane >> 5));
  }
  const int s_sub = tid >> 4, ch = tid & 15;
  const int cglob = hh * 64 + qq * 16 + ch;
  const float br = P.b_rg[DIR * 512 + cglob], bi = P.b_ig[DIR * 512 + cglob];
  const float Kc = 8.f * log_sigmoidf_(P.lam[DIR * 512 + cglob]);
  const int cp = tid & 31, rr = tid >> 5;
  float cw0[4], cw1[4];
#pragma unroll
  for (int k = 0; k < 4; ++k) { cw0[k] = P.cw[k * 512 + hh * 64 + 2 * cp]; cw1[k] = P.cw[k * 512 + hh * 64 + 2 * cp + 1]; }
  const float cb0 = P.cb[hh * 64 + 2 * cp], cb1 = P.cb[hh * 64 + 2 * cp + 1];
  if (tid < 16) carry[tid] = 0.f;

  for (int cs = 0; cs < 8; ++cs) {
    const int chunk = DIR ? (7 - cs) : cs;
    const int s0 = chunk * 256;
#pragma unroll
    for (int i = 0; i < 5; ++i) {
      const int q = tid + 512 * i, row = q >> 3, c = q & 7;
      if (row < 259) {
        const int sp = s0 - 2 + row;
        uint4 v = make_uint4(0, 0, 0, 0);
        if (sp >= 0 && sp < SEQ) v = *(const uint4*)(w.xl + ((size_t)b * SEQ + sp) * 512 + hh * 64 + c * 8);
        *(uint4*)(gx + row * 128 + c * 16) = v;
      }
    }
    __syncthreads();
    {
      const unsigned* gxi = (const unsigned*)gx;
      unsigned win[19];
#pragma unroll
      for (int i = 0; i < 19; ++i) win[i] = gxi[(rr * 16 + i) * 32 + cp];
#pragma unroll
      for (int i = 0; i < 16; ++i) {
        float o0 = cb0, o1 = cb1;
#pragma unroll
        for (int k = 0; k < 4; ++k) {
          o0 += cw0[k] * __uint_as_float(win[i + k] << 16);
          o1 += cw1[k] * __uint_as_float(win[i + k] & 0xffff0000u);
        }
        const int row = rr * 16 + i;
        const unsigned pk = (unsigned)f2bf(o0) | ((unsigned)f2bf(o1) << 16);
        *(unsigned*)(xct + swz_off(row, cp >> 2) + (cp & 3) * 4) = pk;
      }
    }
    __syncthreads();
    {
      f32x16 acc;
#pragma unroll
      for (int r = 0; r < 16; ++r) acc[r] = 0.f;
#pragma unroll
      for (int ks = 0; ks < 4; ++ks) {
        bf16x8 af = *(const bf16x8*)(xct + swz_off(wid * 32 + (lane & 31), ks * 2 + (lane >> 5)));
        acc = __builtin_amdgcn_mfma_f32_32x32x16_bf16(af, bw[ks], acc, 0, 0, 0);
      }
#pragma unroll
      for (int r = 0; r < 16; ++r) {
        const int row = wid * 32 + (r & 3) + 8 * (r >> 2) + 4 * (lane >> 5);
        Gt[row * 33 + (lane & 31)] = acc[r];
      }
    }
    __syncthreads();
    float av[8], uv[8];
    {
      float A = 1.f, B = 0.f;
#pragma unroll
      for (int i = 0; i < 8; ++i) {
        const int p = s_sub * 8 + i;
        const int tok = DIR ? (255 - p) : p;
        const float r = sigmoidf_(Gt[tok * 33 + ch] + br);
        const float ig = sigmoidf_(Gt[tok * 33 + 16 + ch] + bi);
        const int col = qq * 16 + ch;
        const float xcv = bf2f(*(const u16*)(xct + swz_off(tok, col >> 3) + (col & 7) * 2));
        const float a = __expf(Kc * r);
        const float u = sqrtf(fmaxf(1.f - a * a, 0.f)) * ig * xcv;
        av[i] = a; uv[i] = u;
        B = a * B + u; A *= a;
      }
      sumA[s_sub * 16 + ch] = A; sumB[s_sub * 16 + ch] = B;
    }
    __syncthreads();
    {
      float h = carry[(cs & 1) * 16 + ch];
      for (int sp = 0; sp < s_sub; ++sp) h = sumA[sp * 16 + ch] * h + sumB[sp * 16 + ch];
#pragma unroll
      for (int i = 0; i < 8; ++i) {
        const int p = s_sub * 8 + i;
        const int tok = DIR ? (255 - p) : p;
        h = av[i] * h + uv[i];
        const int sq = s0 + tok;
        if (DIR == 0) {
          hf[sq * 16 + ch] = f2bf(h);
        } else {
          const size_t t = (size_t)b * SEQ + sq;
          const float yv = (bf2f(hf[sq * 16 + ch]) + h) * bf2f(w.gg[t * 512 + cglob]);
          w.y[t * 1024 + cglob] = f2bf(yv);
          float ss = yv * yv;
          ss += __shfl_xor(ss, 1, 64); ss += __shfl_xor(ss, 2, 64); ss += __shfl_xor(ss, 4, 64); ss += __shfl_xor(ss, 8, 64);
          if (ch == 0) w.ssq_lru[t * 32 + hh * 4 + qq] = ss;
        }
      }
      if (s_sub == 31) carry[((cs + 1) & 1) * 16 + ch] = h;
    }
    __syncthreads();
  }
}

__device__ __forceinline__ void p2_lru_task(const WS& w, const LruParams& P, int task, char* smem) {
  const int b = task >> 5, hh = (task >> 2) & 7, qq = task & 3;
  lru_pass<0>(w, P, b, hh, qq, smem);
  lru_pass<1>(w, P, b, hh, qq, smem);
}
__global__ void __launch_bounds__(512) k_p2_lru(WS w, LruParams P) {
  extern __shared__ __attribute__((aligned(16))) char smem[];
  for (int task = blockIdx.x; task < 256; task += gridDim.x) p2_lru_task(w, P, task, smem);
}

#define CONV_LDS_BYTES (62 * 1024 + 32 * 4 * 4)
struct ConvParams { const float* cw; const float* cb; const float* ng; const float* nb; };

__device__ __forceinline__ void p2_conv_tile(const WS& w, const ConvParams& P, int tile, char* smem) {
  int tid = threadIdx.x;
  asm volatile("" : "+v"(tid));
  const int lane = tid & 63, wid = tid >> 6;
  const int b = tile >> 6, s0 = (tile & 63) * 32;
  float* red = (float*)(smem + 62 * 1024);
  for (int q = tid; q < 62 * 64; q += 512) {
    const int row = q >> 6, c = q & 63;
    const int sp = s0 - 15 + row;
    uint4 v = make_uint4(0, 0, 0, 0);
    if (sp >= 0 && sp < SEQ) v = *(const uint4*)(w.glu + ((size_t)b * SEQ + sp) * 512 + c * 8);
    *(uint4*)(smem + row * 1024 + c * 16) = v;
  }
  const int cp = tid & 255, th = tid >> 8;
  float w0[31], w1[31];
#pragma unroll
  for (int k = 0; k < 31; ++k) {
    const float2 wv = *(const float2*)(P.cw + k * 512 + 2 * cp);
    w0[k] = wv.x; w1[k] = wv.y;
  }
  const float2 cbv = *(const float2*)(P.cb + 2 * cp);
  const float2 ngv = *(const float2*)(P.ng + 2 * cp);
  const float2 nbv = *(const float2*)(P.nb + 2 * cp);
  __syncthreads();
  const unsigned* gl = (const unsigned*)smem;
  float y0[16], y1[16];
#pragma unroll
  for (int tb = 0; tb < 2; ++tb) {
    float a0[8], a1[8];
#pragma unroll
    for (int i = 0; i < 8; ++i) { a0[i] = cbv.x; a1[i] = cbv.y; }
    const int rbase = th * 16 + tb * 8;
#pragma unroll
    for (int j = 0; j < 38; ++j) {
      const unsigned pk = gl[(rbase + j) * 256 + cp];
      const float xlo = __uint_as_float(pk << 16), xhi = __uint_as_float(pk & 0xffff0000u);
#pragma unroll
      for (int i = 0; i < 8; ++i) {
        const int k = j - i;
        if (k >= 0 && k < 31) { a0[i] += w0[k] * xlo; a1[i] += w1[k] * xhi; }
      }
      if ((j & 3) == 3) __builtin_amdgcn_sched_barrier(0);
    }
#pragma unroll
    for (int i = 0; i < 8; ++i) {
      float s = a0[i] + a1[i];
      s += __shfl_xor(s, 1, 64); s += __shfl_xor(s, 2, 64); s += __shfl_xor(s, 4, 64); s += __shfl_xor(s, 8, 64); s += __shfl_xor(s, 16, 64);
      const float mu = s * (1.f / 64.f);
      const float d0 = a0[i] - mu, d1 = a1[i] - mu;
      float q = d0 * d0 + d1 * d1;
      q += __shfl_xor(q, 1, 64); q += __shfl_xor(q, 2, 64); q += __shfl_xor(q, 4, 64); q += __shfl_xor(q, 8, 64); q += __shfl_xor(q, 16, 64);
      const float rstd = rsqrtf(q * (1.f / 64.f) + EPS);
      const float v0 = d0 * rstd * ngv.x + nbv.x, v1 = d1 * rstd * ngv.y + nbv.y;
      const float yy0 = v0 * sigmoidf_(v0), yy1 = v1 * sigmoidf_(v1);
      y0[tb * 8 + i] = yy0; y1[tb * 8 + i] = yy1;
      float sq = yy0 * yy0 + yy1 * yy1;
      sq = wave_sum(sq);
      if (lane == 0) red[(th * 16 + tb * 8 + i) * 4 + (wid & 3)] = sq;
    }
    __builtin_amdgcn_sched_barrier(0);
  }
  __syncthreads();
#pragma unroll
  for (int i = 0; i < 16; ++i) {
    const int tok = th * 16 + i;
    const float4 r4 = *(const float4*)(red + tok * 4);
    const float rc = rsqrtf((r4.x + r4.y + r4.z + r4.w) * (1.f / 512.f) + EPS);
    const size_t t = (size_t)b * SEQ + s0 + tok;
    const unsigned pk = (unsigned)f2bf(y0[i] * rc) | ((unsigned)f2bf(y1[i] * rc) << 16);
    *(unsigned*)(w.y + t * 1024 + 512 + 2 * cp) = pk;
  }
  __syncthreads();
}
__global__ void __launch_bounds__(512) k_p2_conv(WS w, ConvParams P) {
  extern __shared__ __attribute__((aligned(16))) char smem[];
  for (int tile = blockIdx.x; tile < 512; tile += gridDim.x) p2_conv_tile(w, P, tile, smem);
}


#define XB_TMO      128
#define XB_XCNT(j)  (256  + 64 * (j))
#define XB_XSUB(j)  (1280 + 64 * (j))
#define XB_XGEN(j)  (2304 + 64 * (j))
#define XB_TOP      3328
#define XB_TOPGEN   3392
#define XCD_BAR_WORDS 3456
#define XB_SPIN_CAP (1u << 22)
#define LAS __attribute__((address_space(3)))
__device__ __forceinline__ unsigned xb_ld(unsigned* p) { return __hip_atomic_load(p, __ATOMIC_RELAXED, __HIP_MEMORY_SCOPE_AGENT); }
__device__ __forceinline__ unsigned xb_add(unsigned* p, unsigned v) { return __hip_atomic_fetch_add(p, v, __ATOMIC_RELAXED, __HIP_MEMORY_SCOPE_AGENT); }
__device__ __forceinline__ unsigned xb_xcc_id() { return (unsigned)__builtin_amdgcn_s_getreg((3 << 11) | 20) & 0xFu; }
#define XB_SPIN(cond, bar) do { unsigned _sp = 0; while (cond) { __builtin_amdgcn_s_sleep(1); \
    if ((++_sp & 255u) == 0u) { if (xb_ld(&(bar)[XB_TMO])) break; if (_sp > XB_SPIN_CAP) { atomicAdd(&(bar)[XB_TMO], 1u); break; } } } } while (0)
struct XcdBarrier { unsigned* bar; unsigned x; volatile LAS unsigned* st; };
__device__ __forceinline__ XcdBarrier xcd_barrier_post(unsigned* bar, volatile LAS unsigned* st) {
  XcdBarrier b; b.bar = bar; b.x = xb_xcc_id(); b.st = st;
  if (threadIdx.x == 0) (void)xb_add(&bar[XB_XCNT(b.x)], 1u);
  return b;
}
__device__ __forceinline__ void xcd_barrier_complete(unsigned* bar, unsigned x, unsigned& nloc, unsigned& nx) {
  const unsigned G = gridDim.x * gridDim.y * gridDim.z;
  unsigned sum, cnt, mine, sp = 0u;
  for (;;) {
    sum = 0u; cnt = 0u; mine = 0u;
#pragma unroll
    for (unsigned j = 0; j < 16; ++j) { const unsigned c = xb_ld(&bar[XB_XCNT(j)]); sum += c; cnt += (c > 0u) ? 1u : 0u; mine = (j == x) ? c : mine; }
    if (sum == G) break;
    __builtin_amdgcn_s_sleep(1);
    if ((++sp & 255u) == 0u) { if (xb_ld(&bar[XB_TMO])) break; if (sp > XB_SPIN_CAP) { atomicAdd(&bar[XB_TMO], 1u); break; } }
  }
  nloc = mine > 0u ? mine : 1u; nx = cnt > 0u ? cnt : 1u;
}
__device__ __forceinline__ void xcd_barrier(const XcdBarrier& b) {
  asm volatile("s_waitcnt vmcnt(0)" ::: "memory");
  __syncthreads();
  if (threadIdx.x == 0) {
    unsigned* bar = b.bar;
    __builtin_amdgcn_s_waitcnt(0);
    unsigned nloc = b.st[0], nx = b.st[1];
    if (nloc == 0u) { xcd_barrier_complete(bar, b.x, nloc, nx); b.st[0] = nloc; b.st[1] = nx; }
    const unsigned old = xb_add(&bar[XB_XSUB(b.x)], 1u);
    const unsigned gen = old / nloc;
    if (old + 1u == (gen + 1u) * nloc) {
      __builtin_amdgcn_fence(__ATOMIC_RELEASE, "agent");
      asm volatile("s_waitcnt vmcnt(0)" ::: "memory");
      const unsigned og = xb_add(&bar[XB_TOP], 1u);
      const unsigned tg = og / nx;
      if (og + 1u == (tg + 1u) * nx) xb_add(&bar[XB_TOPGEN], 1u);
      else XB_SPIN(xb_ld(&bar[XB_TOPGEN]) == tg, bar);
      __builtin_amdgcn_fence(__ATOMIC_ACQUIRE, "agent");
      xb_add(&bar[XB_XGEN(b.x)], 1u);
      asm volatile("s_waitcnt vmcnt(0)" ::: "memory");
    } else {
      XB_SPIN(xb_ld(&bar[XB_XGEN(b.x)]) == gen, bar);
      __builtin_amdgcn_fence(__ATOMIC_ACQUIRE, "agent");
      asm volatile("s_waitcnt vmcnt(0)" ::: "memory");
    }
  }
  __syncthreads();
}

struct MK {
  WS w;
  const float* x; const float* mix_norm_g; const float* w_in; const float* lru_conv_w; const float* lru_conv_b;
  const float* lru_w_rg; const float* lru_b_rg; const float* lru_w_ig; const float* lru_b_ig; const float* lru_lambda;
  const float* conf_conv_w; const float* conf_conv_b; const float* conf_norm_g; const float* conf_norm_b;
  const float* beta_lru; const float* beta_conv; const float* w_out; const float* ffn_norm_g; const float* peer_w_q;
  const float* peer_sub_keys; const float* peer_u; const float* peer_v; const float* final_norm_g;
  float* out;
  unsigned* bar;
};

#define MK_LDS_BYTES LRU_LDS_BYTES
#define MK_LDS_TOTAL (MK_LDS_BYTES + 16)

template <int MODE>
__device__ __forceinline__ void prep_wT_tile(const float* __restrict__ wsrc, const float* __restrict__ scale_a,
                                             const float* __restrict__ scale_b, u16* __restrict__ dst, int N, int tile,
                                             int htid, float* tl) {
  const int ntn = N >> 5;
  const int n0 = (tile % ntn) * 32, k0 = (tile / ntn) * 32;
  const int tx = htid & 31, ty = htid >> 5;
#pragma unroll
  for (int i = 0; i < 4; ++i) {
    const int kk = ty + 8 * i, k = k0 + kk, n = n0 + tx;
    const int col = (MODE == 1) ? win_orig_col(n) : n;
    float sc;
    if (MODE == 2) sc = (k < 512) ? scale_a[k] : scale_b[k - 512];
    else sc = scale_a[k];
    tl[kk * 33 + tx] = sc * wsrc[(size_t)k * N + col];
  }
  __syncthreads();
#pragma unroll
  for (int i = 0; i < 4; ++i) {
    const int nn = ty + 8 * i;
    dst[(size_t)(n0 + nn) * 1024 + k0 + tx] = f2bf(tl[tx * 33 + nn]);
  }
  __syncthreads();
}

__device__ __forceinline__ void phase0(const MK& p, char* smem) {
  int tid = threadIdx.x;
  asm volatile("" : "+v"(tid));
  const int lane = tid & 63, wid = tid >> 6;
  const int nb = gridDim.x, bid = blockIdx.x;
  for (int t = bid * 8 + wid; t < T_TOK; t += nb * 8) {
    const float4* xr = (const float4*)(p.x + (size_t)t * 1024);
    float ss = 0.f;
    float4 v[4];
#pragma unroll
    for (int i = 0; i < 4; ++i) {
      v[i] = xr[i * 64 + lane];
      ss += v[i].x * v[i].x + v[i].y * v[i].y + v[i].z * v[i].z + v[i].w * v[i].w;
    }
    ss = wave_sum(ss);
#pragma unroll
    for (int i = 0; i < 4; ++i) {
      ushort4 o;
      o.x = f2bf(v[i].x); o.y = f2bf(v[i].y); o.z = f2bf(v[i].z); o.w = f2bf(v[i].w);
      ((ushort4*)(p.w.xb + (size_t)t * 1024))[i * 64 + lane] = o;
    }
    if (lane == 0) p.w.rs0[t] = rsqrtf(ss * (1.f / 1024.f) + EPS);
  }
  {
    float* tl = (float*)smem + (tid >> 8) * (32 * 33);
    const int htid = tid & 255, hb = bid * 2 + (tid >> 8), nhb = nb * 2;
    for (int tile = hb; tile < 2048; tile += nhb) prep_wT_tile<1>(p.w_in, p.mix_norm_g, nullptr, p.w.WinT, 2048, tile, htid, tl);
    for (int tile = hb; tile < 1024; tile += nhb) prep_wT_tile<2>(p.w_out, p.beta_lru, p.beta_conv, p.w.WoutT, 1024, tile, htid, tl);
    for (int tile = hb; tile < 2048; tile += nhb) prep_wT_tile<0>(p.peer_w_q, p.ffn_norm_g, nullptr, p.w.WqT, 2048, tile, htid, tl);
  }
  for (int i = bid * 512 + tid; i < 16 * 128 * 128; i += nb * 512) {
    p.w.keysb[i] = f2bf(p.peer_sub_keys[i]);
    if (i < 2 * 8 * 4 * 32 * 64) {
      const int k = i & 63, j = (i >> 6) & 31, qq = (i >> 11) & 3, hh = (i >> 13) & 7, dir = (i >> 16) & 1;
      const int o = qq * 16 + (j & 15);
      const float* srcp = (j < 16) ? p.lru_w_rg : p.lru_w_ig;
      p.w.Wg[i] = f2bf(srcp[(((size_t)dir * 8 + hh) * 64 + k) * 64 + o]);
    }
  }
  {
    const size_t n4 = (size_t)16384 * 256;
    for (size_t i = (size_t)bid * 512 + tid; i < n4; i += (size_t)nb * 512) {
      const int d4 = (int)(i & 255);
      const float4 g = ((const float4*)p.ffn_norm_g)[d4];
      const float4 u = ((const float4*)p.peer_u)[i];
      const float4 v = ((const float4*)p.peer_v)[i];
      const int e = (int)(i >> 8), col = d4 * 4;
      const float cu = 448.f;
      const float ux = fminf(fmaxf(u.x * g.x * PEER_SU, -cu), cu), uy = fminf(fmaxf(u.y * g.y * PEER_SU, -cu), cu);
      const float uz = fminf(fmaxf(u.z * g.z * PEER_SU, -cu), cu), uw = fminf(fmaxf(u.w * g.w * PEER_SU, -cu), cu);
      const float vx = fminf(fmaxf(v.x * PEER_SV, -cu), cu), vy = fminf(fmaxf(v.y * PEER_SV, -cu), cu);
      const float vz = fminf(fmaxf(v.z * PEER_SV, -cu), cu), vw = fminf(fmaxf(v.w * PEER_SV, -cu), cu);
      int pu = __builtin_amdgcn_cvt_pk_fp8_f32(ux, uy, 0, false);
      pu = __builtin_amdgcn_cvt_pk_fp8_f32(uz, uw, pu, true);
      int pv = __builtin_amdgcn_cvt_pk_fp8_f32(vx, vy, 0, false);
      pv = __builtin_amdgcn_cvt_pk_fp8_f32(vz, vw, pv, true);
      const size_t so = ((size_t)(col >> 7) * 16384 + e) * 128 + (col & 127);
      *(int*)((char*)p.w.Ub + so) = pu;
      *(int*)((char*)p.w.Vb + so) = pv;
    }
  }
}

__global__ void __launch_bounds__(512) k_mega(MK p) {
  extern __shared__ __attribute__((aligned(16))) char smem[];
  const int nb = gridDim.x, bid = blockIdx.x;
  volatile LAS unsigned* xst = (volatile LAS unsigned*)(smem + MK_LDS_BYTES);
  if (threadIdx.x < 4) xst[threadIdx.x] = 0u;
  __syncthreads();
  XcdBarrier xb = xcd_barrier_post(p.bar, xst);
  for (int rep = 0; rep < (DUP == 1 ? 2 : 1); ++rep) { phase0(p, smem); xcd_barrier(xb); }
  for (int rep = 0; rep < (DUP == 2 ? 2 : 1); ++rep) {
    for (int tile = bid; tile < 1024; tile += nb) p1_tile(p.w, tile, nb, smem);
    xcd_barrier(xb);
  }
  {
    LruParams LP{p.lru_conv_w, p.lru_conv_b, p.lru_b_rg, p.lru_b_ig, p.lru_lambda};
    for (int rep = 0; rep < (DUP == 3 ? 2 : 1); ++rep) {
      for (int task = bid; task < 256; task += nb) p2_lru_task(p.w, LP, task, smem);
      if (DUP == 3 && rep == 0) xcd_barrier(xb);
    }
    ConvParams CP{p.conf_conv_w, p.conf_conv_b, p.conf_norm_g, p.conf_norm_b};
    for (int rep = 0; rep < (DUP == 4 ? 2 : 1); ++rep) {
      for (int tile = bid; tile < 512; tile += nb) p2_conv_tile(p.w, CP, tile, smem);
      if (DUP == 4 && rep == 0) xcd_barrier(xb);
    }
  }
  xcd_barrier(xb);
  for (int rep = 0; rep < (DUP == 5 ? 2 : 1); ++rep) {
    for (int tile = bid; tile < 512; tile += nb) p3_tile(p.w, p.x, p.out, tile, smem);
    xcd_barrier(xb);
  }
  for (int rep = 0; rep < (DUP == 6 ? 2 : 1); ++rep) {
    for (int tile = bid; tile < 1024; tile += nb) p4_tile(p.w, tile, smem);
    xcd_barrier(xb);
  }
  for (int rep = 0; rep < (DUP == 7 ? 2 : 1); ++rep) {
    const int wid = threadIdx.x >> 6, lane = threadIdx.x & 63;
    int ca, cb;
    staircase_ab(lane, ca, cb);
    for (int t = bid * 8 + wid; t < T_TOK; t += nb * 8) p5_route(p.w, t, ca, cb);
    xcd_barrier(xb);
  }
  for (int rep = 0; rep < (DUP == 11 ? 2 : 1); ++rep) {
    const int wid = threadIdx.x >> 6;
    if ((nb & 7) == 0) {
      const int g = bid & 7, j = bid >> 3;
      const int wv = j * 8 + wid, nwv = (nb >> 3) * 8;
      for (int t = wv; t < T_TOK; t += nwv) p5_token_slice(p.w, t, g);
    } else {
      for (int s = 0; s < 8; ++s)
        for (int t = bid * 8 + wid; t < T_TOK; t += nb * 8) p5_token_slice(p.w, t, s);
    }
    xcd_barrier(xb);
  }
  for (int rep = 0; rep < (DUP == 12 ? 2 : 1); ++rep) {
    const int wid = threadIdx.x >> 6;
    for (int t = bid * 8 + wid; t < T_TOK; t += nb * 8) p5_wphase(p.w, t);
    xcd_barrier(xb);
  }
  for (int rep = 0; rep < (DUP == 8 ? 2 : 1); ++rep) {
    const bool dry = (DUP == 8 && rep == 0);
    const int wid = threadIdx.x >> 6;
    if ((nb & 7) == 0) {
      const int g = bid & 7, j = bid >> 3;
      const int wv = j * 8 + wid, nwv = (nb >> 3) * 8;
      for (int t = wv; t < T_TOK; t += nwv) p6_token_slice(p.w, t, g, p.out, p.out, dry);
    } else {
      for (int s = 0; s < 8; ++s)
        for (int t = bid * 8 + wid; t < T_TOK; t += nb * 8) p6_token_slice(p.w, t, s, p.out, p.out, dry);
    }
    xcd_barrier(xb);
  }
  for (int rep = 0; rep < (DUP == 9 ? 2 : 1); ++rep) {
    const bool dry = (DUP == 9 && rep == 0);
    const int wid = threadIdx.x >> 6;
    for (int t = bid * 8 + wid; t < T_TOK; t += nb * 8) p7_row(p.w, t, p.final_norm_g, p.out, dry);
    if (DUP == 9 && rep == 0) xcd_barrier(xb);
  }
#if DUP == 10
  for (int rep = 0; rep < 10; ++rep) xcd_barrier(xb);
#endif
}

extern "C" void kernel_launch(void* const* d_in, const int* in_sizes, int n_in, void* d_out, int out_size, void* d_ws,
                              size_t ws_size, hipStream_t stream) {
  const float* x = (const float*)d_in[0];
  const float* mix_norm_g = (const float*)d_in[1];
  const float* w_in = (const float*)d_in[2];
  const float* lru_conv_w = (const float*)d_in[3];
  const float* lru_conv_b = (const float*)d_in[4];
  const float* lru_w_rg = (const float*)d_in[5];
  const float* lru_b_rg = (const float*)d_in[6];
  const float* lru_w_ig = (const float*)d_in[7];
  const float* lru_b_ig = (const float*)d_in[8];
  const float* lru_lambda = (const float*)d_in[9];
  const float* conf_conv_w = (const float*)d_in[10];
  const float* conf_conv_b = (const float*)d_in[11];
  const float* conf_norm_g = (const float*)d_in[12];
  const float* conf_norm_b = (const float*)d_in[13];
  const float* beta_lru = (const float*)d_in[14];
  const float* beta_conv = (const float*)d_in[15];
  const float* w_out = (const float*)d_in[16];
  const float* ffn_norm_g = (const float*)d_in[17];
  const float* peer_w_q = (const float*)d_in[18];
  const float* peer_sub_keys = (const float*)d_in[19];
  const float* peer_u = (const float*)d_in[20];
  const float* peer_v = (const float*)d_in[21];
  const float* final_norm_g = (const float*)d_in[22];
  float* out = (float*)d_out;
  WS w = make_ws(d_ws);
  static int grid_blocks = 0;
  if (!grid_blocks) {
    (void)hipFuncSetAttribute((const void*)k_mega, hipFuncAttributeMaxDynamicSharedMemorySize, MK_LDS_TOTAL);
    int dev = 0, cus = 0, per_cu = 0;
    (void)hipGetDevice(&dev);
    (void)hipDeviceGetAttribute(&cus, hipDeviceAttributeMultiprocessorCount, dev);
    (void)hipOccupancyMaxActiveBlocksPerMultiprocessor(&per_cu, k_mega, 512, MK_LDS_TOTAL);
    if (per_cu > 1) per_cu = 1;
    grid_blocks = cus * per_cu;
    if (grid_blocks <= 0) grid_blocks = 1;
  }
  MK p{};
  p.w = w;
  p.x = x; p.mix_norm_g = mix_norm_g; p.w_in = w_in; p.lru_conv_w = lru_conv_w; p.lru_conv_b = lru_conv_b;
  p.lru_w_rg = lru_w_rg; p.lru_b_rg = lru_b_rg; p.lru_w_ig = lru_w_ig; p.lru_b_ig = lru_b_ig; p.lru_lambda = lru_lambda;
  p.conf_conv_w = conf_conv_w; p.conf_conv_b = conf_conv_b; p.conf_norm_g = conf_norm_g; p.conf_norm_b = conf_norm_b;
  p.beta_lru = beta_lru; p.beta_conv = beta_conv; p.w_out = w_out; p.ffn_norm_g = ffn_norm_g; p.peer_w_q = peer_w_q;
  p.peer_sub_keys = peer_sub_keys; p.peer_u = peer_u; p.peer_v = peer_v; p.final_norm_g = final_norm_g;
  p.out = out;
  p.bar = w.bar;
  (void)hipMemsetAsync(w.bar, 0, XCD_BAR_WORDS * 4, stream);
  void* args[] = {&p};
  hipError_t e = hipLaunchCooperativeKernel((const void*)k_mega, dim3(grid_blocks), dim3(512), args, MK_LDS_TOTAL, stream);
  if (e != hipSuccess) fprintf(stderr, "cooperative launch failed: %s (grid %d)\n", hipGetErrorString(e), grid_blocks);
}
```

```cpp
#include <hip/hip_runtime.h>
#include <hip/hip_bf16.h>
#include <hip/hip_cooperative_groups.h>
#include <cstdio>
namespace cg = cooperative_groups;
#include <stdint.h>

typedef unsigned short u16;
typedef __attribute__((ext_vector_type(8))) short bf16x8;
typedef __attribute__((ext_vector_type(4))) float f32x4;
typedef __attribute__((ext_vector_type(16))) float f32x16;

#ifndef DUP
#define DUP 0
#endif
#ifndef PROBE
#define PROBE 0
#endif
#define MK_LDS_BYTES 148480
#define PSM(sm) ((sm) + MK_LDS_BYTES + 16)
#if PROBE
#define PROBE_INIT(sm) unsigned long long* _pacc = (unsigned long long*)(sm); const bool _pon = (blockIdx.x == 0 && threadIdx.x == 0); \
   if (_pon) { for (int _i = 0; _i < 31; ++_i) _pacc[_i] = 0ull; _pacc[31] = __builtin_amdgcn_s_memrealtime(); }
#define PROBE_MARK(sm, i) do { unsigned long long* _pa = (unsigned long long*)(sm); if (blockIdx.x == 0 && threadIdx.x == 0) { \
   const unsigned long long _n = __builtin_amdgcn_s_memrealtime(); _pa[i] += _n - _pa[31]; _pa[31] = _n; } } while (0)
#else
#define PROBE_MARK(sm, i) do {} while (0)
#endif
#define T_TOK 16384
#define SEQ 2048
#define NB 8
#define DM 1024
#define DL 512
#define EPS 1e-6f
#define AIDX(t, k) ((((size_t)((k) >> 6)) * T_TOK + (size_t)(t)) * 64 + ((k) & 63))
#define WIDX(n, k, N) ((((size_t)((k) >> 6)) * (N) + (size_t)(n)) * 64 + ((k) & 63))
#define PEER_SU 256.f
#define PEER_SV 16.f
typedef __attribute__((ext_vector_type(2))) float f32x2;

__device__ __forceinline__ float bf2f(u16 v) { return __uint_as_float(((unsigned)v) << 16); }
__device__ __forceinline__ u16 f2bf(float f) {
  unsigned u = __float_as_uint(f);
  u += 0x7fffu + ((u >> 16) & 1u);
  return (u16)(u >> 16);
}
__device__ __forceinline__ float frcp(float x) { return __builtin_amdgcn_rcpf(x); }
__device__ __forceinline__ float sigmoidf_(float x) { return frcp(1.f + __expf(-x)); }
__device__ __forceinline__ float gelu_tanh(float x) {
  float u = 0.7978845608028654f * (x + 0.044715f * x * x * x);
  float e = __expf(2.f * u);
  float th = 1.f - 2.f * frcp(e + 1.f);
  return 0.5f * x * (1.f + th);
}
__device__ __forceinline__ float log_sigmoidf_(float x) {
  return fminf(x, 0.f) - log1pf(__expf(-fabsf(x)));
}
__device__ __forceinline__ int tid_fresh() { int t = threadIdx.x; asm volatile("" : "+v"(t)); return t; }
__device__ __forceinline__ float sum_grp16(float v) {
  v += __int_as_float(__builtin_amdgcn_update_dpp(0, __float_as_int(v), 0xB1, 0xF, 0xF, true));
  v += __int_as_float(__builtin_amdgcn_update_dpp(0, __float_as_int(v), 0x4E, 0xF, 0xF, true));
  v += __int_as_float(__builtin_amdgcn_update_dpp(0, __float_as_int(v), 0x141, 0xF, 0xF, true));
  v += __int_as_float(__builtin_amdgcn_update_dpp(0, __float_as_int(v), 0x140, 0xF, 0xF, true));
  return v;
}
__device__ __forceinline__ float sum_grp32(float v) {
  v = sum_grp16(v);
  auto a = __builtin_amdgcn_permlane16_swap(__float_as_int(v), __float_as_int(v), false, false);
  return __int_as_float(a[0]) + __int_as_float(a[1]);
}
__device__ __forceinline__ float wave_sum(float v) {
  v = sum_grp32(v);
  auto b = __builtin_amdgcn_permlane32_swap(__float_as_int(v), __float_as_int(v), false, false);
  return __int_as_float(b[0]) + __int_as_float(b[1]);
}

struct WS {
  u16* xb;
  float* rs0;
  u16* WinT;
  u16* WoutT;
  u16* WqT;
  u16* keysb;
  u16* Wg;
  u16* Ub;
  u16* Vb;
  u16* xl;
  u16* gg;
  u16* glu;
  u16* y;
  float* ssq_lru;
  float* ssq_h1;
  unsigned* cand;
  u16* h1b;
  float* tmp_a;
  float* tmp_b;
  u16* sel_e;
  float* wgt;
  float* ssq_out;
  unsigned* bar;
  float* gate;
  float* rs2v;
  unsigned* part;
};

static WS make_ws(void* d_ws) {
  char* p = (char*)d_ws;
  WS w;
  size_t off = 0;
  auto take = [&](size_t bytes) { char* r = p + off; off += (bytes + 255) & ~(size_t)255; return r; };
  w.xb = (u16*)take((size_t)T_TOK * 1024 * 2);
  w.rs0 = (float*)take((size_t)T_TOK * 4);
  w.WinT = (u16*)take((size_t)2048 * 1024 * 2);
  w.WoutT = (u16*)take((size_t)1024 * 1024 * 2);
  w.WqT = (u16*)take((size_t)2048 * 1024 * 2);
  w.keysb = (u16*)take((size_t)16 * 128 * 128 * 2);
  w.Wg = (u16*)take((size_t)2 * 8 * 4 * 32 * 64 * 2);
  w.Ub = (u16*)take((size_t)16384 * 1024 * 2);
  w.Vb = (u16*)take((size_t)16384 * 1024 * 2);
  w.xl = (u16*)take((size_t)T_TOK * 512 * 2);
  w.gg = (u16*)take((size_t)T_TOK * 512 * 2);
  w.glu = (u16*)take((size_t)T_TOK * 512 * 2);
  w.y = (u16*)take((size_t)T_TOK * 1024 * 2);
  w.ssq_lru = (float*)take((size_t)T_TOK * 32 * 4);
  w.ssq_h1 = (float*)take((size_t)T_TOK * 16 * 4);
  w.sel_e = (u16*)take((size_t)T_TOK * 128 * 2);
  w.wgt = (float*)take((size_t)T_TOK * 128 * 4);
  w.ssq_out = (float*)take((size_t)T_TOK * 16 * 4);
  w.bar = (unsigned*)take(4096 * 4);
  w.gate = (float*)take((size_t)T_TOK * 128 * 4);
  w.rs2v = (float*)take((size_t)T_TOK * 4);
  w.part = (unsigned*)w.xl;
  w.cand = (unsigned*)w.xl;
  w.h1b = w.xb;
  w.tmp_a = (float*)w.Ub;
  w.tmp_b = (float*)w.Vb;
  return w;
}


__device__ __forceinline__ int win_orig_col(int np) {
  if (np < 1024) return np;
  int r = (np - 1024) >> 6, i = (np - 1024) & 63;
  return (i < 32) ? (1024 + 32 * r + i) : (1536 + 32 * r + (i - 32));
}


__device__ __forceinline__ void load_rows8(const u16* __restrict__ A, int t0, float* xs) {
  for (int i = threadIdx.x; i < 8 * 1024; i += 256) xs[i] = bf2f(A[(size_t)t0 * 1024 + i]);
  __syncthreads();
}
__device__ __forceinline__ void dot8(const u16* __restrict__ wrow, const float* xs, int kbeg, int kend, float acc[8]) {
  for (int k = kbeg; k < kend; k += 8) {
    uint4 wv = *(const uint4*)(wrow + k);
    float wf[8];
    wf[0] = __uint_as_float(wv.x << 16); wf[1] = __uint_as_float(wv.x & 0xffff0000u);
    wf[2] = __uint_as_float(wv.y << 16); wf[3] = __uint_as_float(wv.y & 0xffff0000u);
    wf[4] = __uint_as_float(wv.z << 16); wf[5] = __uint_as_float(wv.z & 0xffff0000u);
    wf[6] = __uint_as_float(wv.w << 16); wf[7] = __uint_as_float(wv.w & 0xffff0000u);
#pragma unroll
    for (int r = 0; r < 8; ++r) {
      const float* xr = xs + r * 1024 + k;
      float a = acc[r];
#pragma unroll
      for (int j = 0; j < 8; ++j) a += wf[j] * xr[j];
      acc[r] = a;
    }
  }
}


__device__ __forceinline__ float rs2_of(const float* ssq_h1, int t) {
  float s = 0.f;
  for (int j = 0; j < 16; ++j) s += ssq_h1[(size_t)t * 16 + j];
  return rsqrtf(s * (1.f / 1024.f) + EPS);
}


#define GEMM_BUF_BYTES 49152
#define GEMM_LDS_BYTES (2 * GEMM_BUF_BYTES)

__device__ __forceinline__ int swz_off(int row, int c) { return row * 128 + ((c ^ ((row >> 1) & 7)) << 4); }

typedef __attribute__((ext_vector_type(4))) unsigned int u32x4;
#define G_LOAD(P, k0) do { \
  P##a0 = *(const u32x4*)(Ap + (size_t)0 * 64 * 1024 + (k0)); P##a1 = *(const u32x4*)(Ap + (size_t)1 * 64 * 1024 + (k0)); \
  P##a2 = *(const u32x4*)(Ap + (size_t)2 * 64 * 1024 + (k0)); P##a3 = *(const u32x4*)(Ap + (size_t)3 * 64 * 1024 + (k0)); \
  P##b0 = *(const u32x4*)(Bp + (size_t)0 * 64 * 1024 + (k0)); P##b1 = *(const u32x4*)(Bp + (size_t)1 * 64 * 1024 + (k0)); } while (0)
#define G_STORE(P, As_) do { char* _As = (As_); char* _Bs = _As + 32768; \
  *(u32x4*)(_As + swz_off(srow + 0, sc)) = P##a0; *(u32x4*)(_As + swz_off(srow + 64, sc)) = P##a1; \
  *(u32x4*)(_As + swz_off(srow + 128, sc)) = P##a2; *(u32x4*)(_As + swz_off(srow + 192, sc)) = P##a3; \
  *(u32x4*)(_Bs + swz_off(srow + 0, sc)) = P##b0; *(u32x4*)(_Bs + swz_off(srow + 64, sc)) = P##b1; } while (0)
__device__ __forceinline__ void g_mma(const char* As, int wm, int wn, int lane, f32x16 (&acc)[2][2]) {
  const char* Bs = As + 32768;
#pragma unroll
  for (int ks = 0; ks < 4; ++ks) {
    const int c = ks * 2 + (lane >> 5);
    bf16x8 af[2], bfr[2];
#pragma unroll
    for (int mi = 0; mi < 2; ++mi) af[mi] = *(const bf16x8*)(As + swz_off(wm * 64 + mi * 32 + (lane & 31), c));
#pragma unroll
    for (int ni = 0; ni < 2; ++ni) bfr[ni] = *(const bf16x8*)(Bs + swz_off(wn * 64 + ni * 32 + (lane & 31), c));
#pragma unroll
    for (int mi = 0; mi < 2; ++mi)
#pragma unroll
      for (int ni = 0; ni < 2; ++ni)
        acc[mi][ni] = __builtin_amdgcn_mfma_f32_32x32x16_bf16(af[mi], bfr[ni], acc[mi][ni], 0, 0, 0);
  }
}

#define GEMM_STAGE_BYTES 49152
#define GEMM3_LDS_BYTES (3 * GEMM_STAGE_BYTES)
template <bool RESCALE, int NBT>
__device__ __forceinline__ void gemm_core(const u16* __restrict__ A, const u16* __restrict__ Bt, int m0, int n0,
                                          char* smem, f32x16 (&acc)[2][2], const float* rls, int koff = 0) {
  const int tid = tid_fresh(), lane = tid & 63, wid = tid >> 6;
  const int wm = wid >> 1, wn = wid & 1;
  const int srow = tid >> 3, pos = tid & 7;
  const int csrc = pos ^ ((srow >> 1) & 7);
  const u16* Ap = A + (size_t)(m0 + srow) * 64 + csrc * 8;
  const u16* Bp = Bt + (size_t)(n0 + srow) * 64 + csrc * 8;
  const size_t ksA = (size_t)T_TOK * 64, ksB = (size_t)NBT * 64;
  char* wbase = smem + wid * 1024;
  asm volatile("" : "+v"(acc[0][0]), "+v"(acc[0][1]), "+v"(acc[1][0]), "+v"(acc[1][1]));
  __builtin_amdgcn_sched_barrier(0);
#define G_DMA(stage, kt_) do { const int _kt = (((kt_) + koff) & 15); char* _sb = wbase + (stage) * GEMM_STAGE_BYTES; \
    const u16* _a = Ap + _kt * ksA; const u16* _b = Bp + _kt * ksB; \
    __builtin_amdgcn_global_load_lds((const unsigned*)(_a + 0 * 4096), (unsigned*)(_sb + 0 * 8192), 16, 0, 0); \
    __builtin_amdgcn_global_load_lds((const unsigned*)(_a + 1 * 4096), (unsigned*)(_sb + 1 * 8192), 16, 0, 0); \
    __builtin_amdgcn_global_load_lds((const unsigned*)(_a + 2 * 4096), (unsigned*)(_sb + 2 * 8192), 16, 0, 0); \
    __builtin_amdgcn_global_load_lds((const unsigned*)(_a + 3 * 4096), (unsigned*)(_sb + 3 * 8192), 16, 0, 0); \
    __builtin_amdgcn_global_load_lds((const unsigned*)(_b + 0 * 4096), (unsigned*)(_sb + 32768 + 0 * 8192), 16, 0, 0); \
    __builtin_amdgcn_global_load_lds((const unsigned*)(_b + 1 * 4096), (unsigned*)(_sb + 32768 + 1 * 8192), 16, 0, 0); } while (0)
  G_DMA(0, 0);
  G_DMA(1, 1);
  int st = 0;
#pragma unroll 1
  for (int kt = 0; kt < 16; ++kt) {
    if (kt < 15) asm volatile("s_waitcnt vmcnt(6)" ::: "memory");
    else asm volatile("s_waitcnt vmcnt(0)" ::: "memory");
    asm volatile("s_waitcnt lgkmcnt(0)" ::: "memory");
    __builtin_amdgcn_s_barrier();
    if (kt + 2 < 16) { const int st2 = (st >= 1) ? st - 1 : st + 2; G_DMA(st2, kt + 2); }
    if (RESCALE && kt == 8) {
#pragma unroll
      for (int mi = 0; mi < 2; ++mi)
#pragma unroll
        for (int r = 0; r < 16; ++r) {
          const float s = rls[wm * 64 + mi * 32 + (r & 3) + 8 * (r >> 2) + 4 * (lane >> 5)];
          acc[mi][0][r] *= s; acc[mi][1][r] *= s;
        }
    }
    g_mma(smem + st * GEMM_STAGE_BYTES, wm, wn, lane, acc);
    st = (st == 2) ? 0 : st + 1;
  }
#undef G_DMA
  __syncthreads();
}

__device__ __forceinline__ void zero_acc(f32x16 (&acc)[2][2]) {
#pragma unroll
  for (int mi = 0; mi < 2; ++mi)
#pragma unroll
    for (int ni = 0; ni < 2; ++ni)
#pragma unroll
      for (int r = 0; r < 16; ++r) acc[mi][ni][r] = 0.f;
}

__device__ __forceinline__ void p1_tile(const WS& w, int tile, int nblk_g, char* smem) {
  const int it = tile >> 8, b = tile & 255, g = b & 7, j = b >> 3;
  const int mt = it * 16 + g * 2 + (j >> 4), nt = j & 15;
  const int m0 = mt * 256, n0 = nt * 128;
  f32x16 acc[2][2];
  zero_acc(acc);
  gemm_core<false, 2048>(w.xb, w.WinT, m0, n0, smem, acc, nullptr, nt);
  const int tidf = tid_fresh(); const int lane = tidf & 63, wid = tidf >> 6, wm = wid >> 1, wn = wid & 1;
  const int nb = n0 + wn * 64;
#pragma unroll
  for (int mi = 0; mi < 2; ++mi) {
#pragma unroll
    for (int r = 0; r < 16; ++r) {
      const int row = m0 + wm * 64 + mi * 32 + (r & 3) + 8 * (r >> 2) + 4 * (lane >> 5);
      const float rs = w.rs0[row];
      if (nb < 512) {
#pragma unroll
        for (int ni = 0; ni < 2; ++ni) w.xl[(size_t)row * 512 + nb + ni * 32 + (lane & 31)] = f2bf(rs * acc[mi][ni][r]);
      } else if (nb < 1024) {
#pragma unroll
        for (int ni = 0; ni < 2; ++ni) w.gg[(size_t)row * 512 + (nb - 512) + ni * 32 + (lane & 31)] = f2bf(gelu_tanh(rs * acc[mi][ni][r]));
      } else {
        const int ch = ((nb - 1024) >> 6) * 32 + (lane & 31);
        const float a = rs * acc[mi][0][r], bb = rs * acc[mi][1][r];
        w.glu[(size_t)row * 512 + ch] = f2bf(a * sigmoidf_(bb));
      }
    }
  }
}


__device__ __forceinline__ void p3_tile(const WS& w, const float* __restrict__ x, float* __restrict__ h1, int tile, char* smem) {
  const int it = tile >> 8, b = tile & 255, g = b & 7, j = b >> 3;
  const int mt = it * 32 + g * 4 + (j >> 3), nt = j & 7;
  const int m0 = mt * 256, n0 = nt * 128;
  const int tidf = tid_fresh(); const int lane = tidf & 63, wid = tidf >> 6, wm = wid >> 1, wn = wid & 1;
  float* rls = (float*)(smem + GEMM3_LDS_BYTES);
  if (tidf < 256) {
    const float4* p = (const float4*)(w.ssq_lru + (size_t)(m0 + tidf) * 32);
    float s = 0.f;
#pragma unroll
    for (int i = 0; i < 8; ++i) { float4 v = p[i]; s += v.x + v.y + v.z + v.w; }
    rls[tidf] = rsqrtf(s * (1.f / 512.f) + EPS);
  }
  f32x16 acc[2][2];
  zero_acc(acc);
  gemm_core<true, 1024>(w.y, w.WoutT, m0, n0, smem, acc, rls);
#pragma unroll
  for (int mi = 0; mi < 2; ++mi) {
#pragma unroll
    for (int r = 0; r < 16; ++r) {
      const int row = m0 + wm * 64 + mi * 32 + (r & 3) + 8 * (r >> 2) + 4 * (lane >> 5);
      float ss = 0.f;
#pragma unroll
      for (int ni = 0; ni < 2; ++ni) {
        const size_t o = (size_t)row * 1024 + n0 + wn * 64 + ni * 32 + (lane & 31);
        const float hv = x[o] + acc[mi][ni][r];
        h1[o] = hv;
        w.h1b[AIDX(row, n0 + wn * 64 + ni * 32 + (lane & 31))] = f2bf(hv);
        ss += hv * hv;
      }
      ss = sum_grp32(ss);
      if ((lane & 31) == 0) w.ssq_h1[(size_t)row * 16 + nt * 2 + wn] = ss;
    }
  }
  __syncthreads();
}


__device__ __forceinline__ int swz256(int row, int c) { return row * 256 + ((c ^ (row & 15)) << 4); }

__device__ __forceinline__ void cmpswap_desc(float& a, float& b) { float mx = fmaxf(a, b), mn = fminf(a, b); a = mx; b = mn; }

__device__ __forceinline__ void p4_tile(const WS& w, int tile, char* smem) {
  const int it = tile >> 8, b = tile & 255, g = b & 7, j = b >> 3;
  const int mt = it * 16 + g * 2 + (j >> 4), hp = j & 15;
  const int m0 = mt * 256, n0 = hp * 128;
  const int tid = tid_fresh(), lane = tid & 63, wid = tid >> 6, wm = wid >> 1, wn = wid & 1;
  float* rls = (float*)(smem + GEMM3_LDS_BYTES);
  if (tid < 256) {
    const float4* p = (const float4*)(w.ssq_h1 + (size_t)(m0 + tid) * 16);
    float s = 0.f;
#pragma unroll
    for (int i = 0; i < 4; ++i) { float4 v = p[i]; s += v.x + v.y + v.z + v.w; }
    rls[tid] = rsqrtf(s * (1.f / 1024.f) + EPS);
  }
  f32x16 acc[2][2];
  zero_acc(acc);
  gemm_core<false, 2048>(w.h1b, w.WqT, m0, n0, smem, acc, nullptr, hp);
  PROBE_MARK(PSM(smem), 13);
  char* qs = smem;
  char* ksm = smem + 65536;
  {
#pragma unroll
  for (int mi = 0; mi < 2; ++mi)
#pragma unroll
    for (int r = 0; r < 16; ++r) {
      const int row = wm * 64 + mi * 32 + (r & 3) + 8 * (r >> 2) + 4 * (lane >> 5);
      const float rs = rls[row];
#pragma unroll
      for (int ni = 0; ni < 2; ++ni) {
        const int col = wn * 64 + ni * 32 + (lane & 31);
        *(u16*)(qs + swz256(row, col >> 3) + (col & 7) * 2) = f2bf(rs * acc[mi][ni][r]);
      }
    }
  {
    const u16* kp = w.keysb + (size_t)hp * 128 * 128;
#pragma unroll
    for (int i = 0; i < 4; ++i) {
      const int q = tid + 512 * i, row = q >> 4, c = q & 15;
      *(uint4*)(ksm + swz256(row, c)) = *(const uint4*)(kp + row * 128 + c * 8);
    }
  }
  __syncthreads();
  }
  PROBE_MARK(PSM(smem), 14);
  f32x16 sacc[4];
  {
#pragma unroll
  for (int ni = 0; ni < 4; ++ni)
#pragma unroll
    for (int r = 0; r < 16; ++r) sacc[ni][r] = 0.f;
#pragma unroll
  for (int ks = 0; ks < 8; ++ks) {
    const int c = ks * 2 + (lane >> 5);
    bf16x8 af = *(const bf16x8*)(qs + swz256(wid * 32 + (lane & 31), c));
#pragma unroll
    for (int ni = 0; ni < 4; ++ni) {
      bf16x8 bfr = *(const bf16x8*)(ksm + swz256(ni * 32 + (lane & 31), c));
      sacc[ni] = __builtin_amdgcn_mfma_f32_32x32x16_bf16(af, bfr, sacc[ni], 0, 0, 0);
    }
  }
  }
  PROBE_MARK(PSM(smem), 15);
  {
    const int l31 = lane & 31;
    int v0[16], v1[16], v2[16], v3[16], res[16];
#pragma unroll
    for (int r = 0; r < 16; ++r) {
      int k0 = (int)((__float_as_uint(sacc[0][r]) & ~127u) | (unsigned)(l31));
      int k1 = (int)((__float_as_uint(sacc[1][r]) & ~127u) | (unsigned)(32 + l31));
      int k2 = (int)((__float_as_uint(sacc[2][r]) & ~127u) | (unsigned)(64 + l31));
      int k3 = (int)((__float_as_uint(sacc[3][r]) & ~127u) | (unsigned)(96 + l31));
      k0 ^= (k0 >> 31) & 0x7fffffff; k1 ^= (k1 >> 31) & 0x7fffffff;
      k2 ^= (k2 >> 31) & 0x7fffffff; k3 ^= (k3 >> 31) & 0x7fffffff;
      int t;
      t = max(k0, k1); k1 = min(k0, k1); k0 = t;
      t = max(k2, k3); k3 = min(k2, k3); k2 = t;
      t = max(k0, k2); k2 = min(k0, k2); k0 = t;
      t = max(k1, k3); k3 = min(k1, k3); k1 = t;
      t = max(k1, k2); k2 = min(k1, k2); k1 = t;
      v0[r] = k0; v1[r] = k1; v2[r] = k2; v3[r] = k3;
      res[r] = (int)0x80000000;
    }
#pragma unroll 1
    for (int jj = 0; jj < 16; ++jj) {
      const int jm = (l31 == jj) ? -1 : 0;
#pragma unroll
      for (int r = 0; r < 16; ++r) {
        int m = v0[r];
        m = max(m, __builtin_amdgcn_update_dpp(0, m, 0xB1, 0xF, 0xF, true));
        m = max(m, __builtin_amdgcn_update_dpp(0, m, 0x4E, 0xF, 0xF, true));
        m = max(m, __builtin_amdgcn_update_dpp(0, m, 0x141, 0xF, 0xF, true));
        m = max(m, __builtin_amdgcn_update_dpp(0, m, 0x140, 0xF, 0xF, true));
        auto sw = __builtin_amdgcn_permlane16_swap(m, m, false, false);
        m = max((int)sw[0], (int)sw[1]);
        const int hm = (v0[r] == m) ? -1 : 0;
        v0[r] ^= (v0[r] ^ v1[r]) & hm;
        v1[r] ^= (v1[r] ^ v2[r]) & hm;
        v2[r] ^= (v2[r] ^ v3[r]) & hm;
        v3[r] ^= (v3[r] ^ (int)0x80000000) & hm;
        res[r] ^= (res[r] ^ m) & jm;
      }
    }
#pragma unroll
    for (int r = 0; r < 16; ++r) {
      const int row = m0 + wid * 32 + (r & 3) + 8 * (r >> 2) + 4 * (lane >> 5);
      const int key = res[r];
      const unsigned pk = (unsigned)(key ^ ((key >> 31) & 0x7fffffff));
      if (l31 < 16) w.cand[((size_t)row * 16 + hp) * 16 + l31] = pk;
    }
  }
  __syncthreads();
  PROBE_MARK(PSM(smem), 16);
}


typedef __attribute__((ext_vector_type(2))) __bf16 bf16x2_t;
__device__ __forceinline__ float dot2bf(unsigned a, unsigned b, float c) {
  return __builtin_amdgcn_fdot2_f32_bf16(__builtin_bit_cast(bf16x2_t, a), __builtin_bit_cast(bf16x2_t, b), c, false);
}
__device__ __forceinline__ float dot8bf(uint4 a, uint4 b, float c) {
  c = dot2bf(a.x, b.x, c); c = dot2bf(a.y, b.y, c); c = dot2bf(a.z, b.z, c); c = dot2bf(a.w, b.w, c);
  return c;
}
__device__ __forceinline__ void axpy8(float (&acc)[8], float wgt, uint4 v) {
  acc[0] += wgt * __uint_as_float(v.x << 16); acc[1] += wgt * __uint_as_float(v.x & 0xffff0000u);
  acc[2] += wgt * __uint_as_float(v.y << 16); acc[3] += wgt * __uint_as_float(v.y & 0xffff0000u);
  acc[4] += wgt * __uint_as_float(v.z << 16); acc[5] += wgt * __uint_as_float(v.z & 0xffff0000u);
  acc[6] += wgt * __uint_as_float(v.w << 16); acc[7] += wgt * __uint_as_float(v.w & 0xffff0000u);
}

__device__ __forceinline__ void p5_route_load(const WS& w, int t, int ca, int cb, unsigned (&pa)[8], unsigned (&pb)[8], float& sq) {
  const int lane = threadIdx.x & 63;
  const unsigned* cp = w.cand + (size_t)t * 256;
#pragma unroll
  for (int h = 0; h < 8; ++h) {
    pa[h] = cp[(2 * h) * 16 + ca];
    pb[h] = cp[(2 * h + 1) * 16 + cb];
  }
  sq = (lane < 16) ? w.ssq_h1[(size_t)t * 16 + lane] : 0.f;
}
__device__ __forceinline__ void p5_route_compute(const WS& w, int t, const unsigned (&pa)[8], const unsigned (&pb)[8], float sq, float* keys  ) {
  const int lane = threadIdx.x & 63;
  float s[8]; int e[8];
#pragma unroll
  for (int h = 0; h < 8; ++h) {
    const float sv = __uint_as_float(pa[h]) + __uint_as_float(pb[h]);
    e[h] = (int)(pa[h] & 127u) * 128 + (int)(pb[h] & 127u);
    s[h] = (lane < 50) ? __uint_as_float((__float_as_uint(sv) & ~63u) | (unsigned)lane) : -3.0e38f;
    keys[h * 64 + lane] = s[h];
  }
  __builtin_amdgcn_fence(__ATOMIC_RELEASE, "wavefront");
  __builtin_amdgcn_wave_barrier();
  __builtin_amdgcn_fence(__ATOMIC_ACQUIRE, "wavefront");
#pragma unroll
  for (int h = 0; h < 8; ++h) {
    int rank = 0;
    const float4* kp = (const float4*)(keys + h * 64);
#pragma unroll
    for (int j4 = 0; j4 < 13; ++j4) {
      const float4 k4 = kp[j4];
      rank += (k4.x > s[h]) ? 1 : 0;
      rank += (k4.y > s[h]) ? 1 : 0;
      if (j4 * 4 + 2 < 50) rank += (k4.z > s[h]) ? 1 : 0;
      if (j4 * 4 + 3 < 50) rank += (k4.w > s[h]) ? 1 : 0;
    }
    const bool sel = (lane < 50) && (rank < 16);
    const unsigned long long top = __ballot(rank == 0 && lane < 50);
    const float mx = __int_as_float(__builtin_amdgcn_readlane(__float_as_int(s[h]), (int)__builtin_ctzll(top)));
    const float ex = sel ? __expf(s[h] - mx) : 0.f;
    const float sum = wave_sum(ex);
    if (sel) {
      w.sel_e[(size_t)t * 128 + h * 16 + rank] = (u16)e[h];
      w.gate[(size_t)t * 128 + h * 16 + rank] = ex * frcp(sum);
    }
  }
  const float sqs = wave_sum(sq);
  if (lane == 0) w.rs2v[t] = rsqrtf(sqs * (1.f / 1024.f) + EPS);
  __builtin_amdgcn_fence(__ATOMIC_RELEASE, "wavefront");
  __builtin_amdgcn_wave_barrier();
  __builtin_amdgcn_fence(__ATOMIC_ACQUIRE, "wavefront");
}

__device__ __forceinline__ f32x2 fp8lo(unsigned d) { return __builtin_amdgcn_cvt_pk_f32_fp8((int)d, false); }
__device__ __forceinline__ f32x2 fp8hi(unsigned d) { return __builtin_amdgcn_cvt_pk_f32_fp8((int)d, true); }
__device__ __forceinline__ f32x2 bfpair(unsigned d) { f32x2 r; r.x = __uint_as_float(d << 16); r.y = __uint_as_float(d & 0xffff0000u); return r; }

__device__ __forceinline__ unsigned pick_e(unsigned epair, int i, int lane) {
  const unsigned ep = (unsigned)__shfl((int)epair, 4 * i + (lane >> 4), 64);
  return ((lane >> 3) & 1) ? (ep >> 16) : (ep & 0xffffu);
}
__device__ __forceinline__ void u_issue(const WS& w, int t, int s, unsigned epair, u32x4 (&u)[16], u32x4& xa, u32x4& xb) {
  const int lane = threadIdx.x & 63;
  const char* ubase = (const char*)w.Ub + (size_t)s * 16384 * 128 + (lane & 7) * 16;
#pragma unroll
  for (int i = 0; i < 16; ++i) u[i] = *(const u32x4*)(ubase + (size_t)pick_e(epair, i, lane) * 128);
  const u16* xp = w.h1b + AIDX(t, s * 128 + (lane & 7) * 16);
  xa = *(const u32x4*)xp; xb = *(const u32x4*)(xp + 8);
}
__device__ __forceinline__ void u_compute(const WS& w, int t, int s, const u32x4 (&u)[16], const u32x4& xa, const u32x4& xb, bool valid) {
  const int lane = threadIdx.x & 63;
  f32x2 x2[8];
  x2[0] = bfpair(xa.x); x2[1] = bfpair(xa.y); x2[2] = bfpair(xa.z); x2[3] = bfpair(xa.w);
  x2[4] = bfpair(xb.x); x2[5] = bfpair(xb.y); x2[6] = bfpair(xb.z); x2[7] = bfpair(xb.w);
  float p[16];
#pragma unroll
  for (int i = 0; i < 16; ++i) {
    f32x2 a = {0.f, 0.f};
    a = __builtin_elementwise_fma(fp8lo(u[i].x), x2[0], a); a = __builtin_elementwise_fma(fp8hi(u[i].x), x2[1], a);
    a = __builtin_elementwise_fma(fp8lo(u[i].y), x2[2], a); a = __builtin_elementwise_fma(fp8hi(u[i].y), x2[3], a);
    a = __builtin_elementwise_fma(fp8lo(u[i].z), x2[4], a); a = __builtin_elementwise_fma(fp8hi(u[i].z), x2[5], a);
    a = __builtin_elementwise_fma(fp8lo(u[i].w), x2[6], a); a = __builtin_elementwise_fma(fp8hi(u[i].w), x2[7], a);
    p[i] = a.x + a.y;
  }
#pragma unroll
  for (int c = 0; c < 8; ++c) {
    const bool up = (lane & 4) != 0;
    const float send = up ? p[c] : p[c + 8];
    const float keep = up ? p[c + 8] : p[c];
    p[c] = keep + __shfl_xor(send, 4, 64);
  }
#pragma unroll
  for (int c = 0; c < 4; ++c) {
    const bool up = (lane & 2) != 0;
    const float send = up ? p[c] : p[c + 4];
    const float keep = up ? p[c + 4] : p[c];
    p[c] = keep + __shfl_xor(send, 2, 64);
  }
#pragma unroll
  for (int c = 0; c < 2; ++c) {
    const bool up = (lane & 1) != 0;
    const float send = up ? p[c] : p[c + 2];
    const float keep = up ? p[c + 2] : p[c];
    p[c] = keep + __shfl_xor(send, 1, 64);
  }
  const _Float16 h0 = (_Float16)(p[0] * (1.f / PEER_SU)), h1v = (_Float16)(p[1] * (1.f / PEER_SU));
  const unsigned pk = (unsigned)__builtin_bit_cast(unsigned short, h0) | ((unsigned)__builtin_bit_cast(unsigned short, h1v) << 16);
  if (valid) w.part[((size_t)t * 8 + s) * 64 + lane] = pk;
}
__device__ __forceinline__ void u_sweep(const WS& w, int s, int t0, int stride, int n) {
  const int lane = threadIdx.x & 63;
  const unsigned* se = (const unsigned*)w.sel_e;
#define TT(i) (t0 + min((i), n - 1) * stride)
  u32x4 uA[16], uB[16], xaA, xbA, xaB, xbB;
  unsigned epA = se[(size_t)TT(0) * 64 + lane];
  unsigned epB = se[(size_t)TT(1) * 64 + lane];
  u_issue(w, TT(0), s, epA, uA, xaA, xbA);
#pragma unroll 1
  for (int i = 0; i < n; i += 2) {
    epA = se[(size_t)TT(i + 2) * 64 + lane];
    u_issue(w, TT(i + 1), s, epB, uB, xaB, xbB);
    u_compute(w, TT(i), s, uA, xaA, xbA, true);
    epB = se[(size_t)TT(i + 3) * 64 + lane];
    u_issue(w, TT(i + 2), s, epA, uA, xaA, xbA);
    u_compute(w, TT(i + 1), s, uB, xaB, xbB, i + 1 < n);
  }
#undef TT
}
__device__ __forceinline__ void p5_token_slice(const WS& w, int t, int s) {
  const int lane = threadIdx.x & 63;
  const unsigned epair = ((const unsigned*)w.sel_e)[(size_t)t * 64 + lane];
  u32x4 u[16], xa, xb;
  u_issue(w, t, s, epair, u, xa, xb);
  u_compute(w, t, s, u, xa, xb, true);
}

__device__ __forceinline__ void p5_wphase(const WS& w, int t) {
  const int lane = threadIdx.x & 63;
  float d0 = 0.f, d1 = 0.f;
#pragma unroll
  for (int s = 0; s < 8; ++s) {
    const unsigned pk = w.part[((size_t)t * 8 + s) * 64 + lane];
    d0 += (float)__builtin_bit_cast(_Float16, (unsigned short)(pk & 0xffffu));
    d1 += (float)__builtin_bit_cast(_Float16, (unsigned short)(pk >> 16));
  }
  const float rs2 = w.rs2v[t];
  const int p0 = 16 * (lane & 7) + (lane >> 3), p1 = p0 + 8;
  w.wgt[(size_t)t * 128 + p0] = w.gate[(size_t)t * 128 + p0] * gelu_tanh(rs2 * d0);
  w.wgt[(size_t)t * 128 + p1] = w.gate[(size_t)t * 128 + p1] * gelu_tanh(rs2 * d1);
}

__device__ __forceinline__ int v_col(int s, int lane) {
  return s * 128 + (lane & 7) * 16 + ((lane >> 5) & 1) * 8 + ((lane >> 4) & 1) * 4 + ((lane >> 3) & 1) * 2;
}
__device__ __forceinline__ void v_issue(const WS& w, int t, int s, unsigned epair, u32x4 (&v)[16], float2& hin, const float* h1) {
  const int lane = threadIdx.x & 63;
  const char* vbase = (const char*)w.Vb + (size_t)s * 16384 * 128 + (lane & 7) * 16;
#pragma unroll
  for (int i = 0; i < 16; ++i) v[i] = *(const u32x4*)(vbase + (size_t)pick_e(epair, i, lane) * 128);
  hin = *(const float2*)(h1 + (size_t)t * 1024 + v_col(s, lane));
}
__device__ __forceinline__ void v_compute(const WS& w, int t, int s, const u32x4 (&v)[16], float2 wpair, float2 hin, float* out, bool valid) {
  const int lane = threadIdx.x & 63;
  f32x2 a2[8];
#pragma unroll
  for (int c = 0; c < 8; ++c) { a2[c].x = 0.f; a2[c].y = 0.f; }
#pragma unroll
  for (int i = 0; i < 16; ++i) {
    const int srcl = 4 * i + (lane >> 4);
    const float w0 = __shfl(wpair.x, srcl, 64), w1 = __shfl(wpair.y, srcl, 64);
    const float wi = ((lane >> 3) & 1) ? w1 : w0;
    f32x2 wv; wv.x = wi; wv.y = wi;
    a2[0] = __builtin_elementwise_fma(fp8lo(v[i].x), wv, a2[0]); a2[1] = __builtin_elementwise_fma(fp8hi(v[i].x), wv, a2[1]);
    a2[2] = __builtin_elementwise_fma(fp8lo(v[i].y), wv, a2[2]); a2[3] = __builtin_elementwise_fma(fp8hi(v[i].y), wv, a2[3]);
    a2[4] = __builtin_elementwise_fma(fp8lo(v[i].z), wv, a2[4]); a2[5] = __builtin_elementwise_fma(fp8hi(v[i].z), wv, a2[5]);
    a2[6] = __builtin_elementwise_fma(fp8lo(v[i].w), wv, a2[6]); a2[7] = __builtin_elementwise_fma(fp8hi(v[i].w), wv, a2[7]);
  }
  float acc[16];
#pragma unroll
  for (int c = 0; c < 8; ++c) { acc[2 * c] = a2[c].x; acc[2 * c + 1] = a2[c].y; }
#pragma unroll
  for (int c = 0; c < 8; ++c) {
    const bool up = (lane & 32) != 0;
    const float send = up ? acc[c] : acc[c + 8];
    const float keep = up ? acc[c + 8] : acc[c];
    acc[c] = keep + __shfl_xor(send, 32, 64);
  }
#pragma unroll
  for (int c = 0; c < 4; ++c) {
    const bool up = (lane & 16) != 0;
    const float send = up ? acc[c] : acc[c + 4];
    const float keep = up ? acc[c + 4] : acc[c];
    acc[c] = keep + __shfl_xor(send, 16, 64);
  }
#pragma unroll
  for (int c = 0; c < 2; ++c) {
    const bool up = (lane & 8) != 0;
    const float send = up ? acc[c] : acc[c + 2];
    const float keep = up ? acc[c + 2] : acc[c];
    acc[c] = keep + __shfl_xor(send, 8, 64);
  }
  const size_t o = (size_t)t * 1024 + v_col(s, lane);
  const float hv0 = hin.x + acc[0] * (1.f / PEER_SV), hv1 = hin.y + acc[1] * (1.f / PEER_SV);
  const float ss = wave_sum(hv0 * hv0 + hv1 * hv1);
  if (valid) {
    *(float2*)(out + o) = make_float2(hv0, hv1);
    if (lane == 0) w.ssq_out[(size_t)t * 16 + s] = ss;
  }
}
__device__ __forceinline__ void v_sweep(const WS& w, int s, int t0, int stride, int n, const float* h1, float* out, bool dry) {
  const int lane = threadIdx.x & 63;
  const unsigned* se = (const unsigned*)w.sel_e;
  const float2* wg = (const float2*)w.wgt;
#define TT(i) (t0 + min((i), n - 1) * stride)
  u32x4 vA[16], vB[16];
  float2 hA, hB, wA, wB;
  unsigned epA = se[(size_t)TT(0) * 64 + lane];
  unsigned epB = se[(size_t)TT(1) * 64 + lane];
  wA = wg[(size_t)TT(0) * 64 + lane];
  v_issue(w, TT(0), s, epA, vA, hA, h1);
#pragma unroll 1
  for (int i = 0; i < n; i += 2) {
    epA = se[(size_t)TT(i + 2) * 64 + lane];
    wB = wg[(size_t)TT(i + 1) * 64 + lane];
    v_issue(w, TT(i + 1), s, epB, vB, hB, h1);
    v_compute(w, TT(i), s, vA, wA, hA, out, !dry);
    epB = se[(size_t)TT(i + 3) * 64 + lane];
    wA = wg[(size_t)TT(i + 2) * 64 + lane];
    v_issue(w, TT(i + 2), s, epA, vA, hA, h1);
    v_compute(w, TT(i + 1), s, vB, wB, hB, out, !dry && (i + 1 < n));
  }
#undef TT
}
__device__ __forceinline__ void p6_token_slice(const WS& w, int t, int s, const float* h1, float* out, bool dry = false) {
  const int lane = threadIdx.x & 63;
  const unsigned epair = ((const unsigned*)w.sel_e)[(size_t)t * 64 + lane];
  const float2 wpair = ((const float2*)w.wgt)[(size_t)t * 64 + lane];
  u32x4 v[16]; float2 hin;
  v_issue(w, t, s, epair, v, hin, h1);
  v_compute(w, t, s, v, wpair, hin, out, !dry);
}

__device__ __forceinline__ void p7_row(const WS& w, int t, const float* __restrict__ gF, float* out, bool dry = false) {
  const int lane = threadIdx.x & 63;
  float s = (lane < 8) ? w.ssq_out[(size_t)t * 16 + lane] : 0.f;
  s = wave_sum(s);
  const float rn = rsqrtf(s * (1.f / 1024.f) + EPS);
  float4* orow = (float4*)(out + (size_t)t * 1024);
#pragma unroll
  for (int i = 0; i < 4; ++i) {
    float4 v = orow[i * 64 + lane];
    const float4 g = ((const float4*)gF)[i * 64 + lane];
    v.x *= rn * g.x; v.y *= rn * g.y; v.z *= rn * g.z; v.w *= rn * g.w;
    if (dry) { asm volatile("" :: "v"(v.x), "v"(v.y), "v"(v.z), "v"(v.w)); continue; }
    orow[i * 64 + lane] = v;
  }
}

__device__ __forceinline__ void staircase_ab(int lane, int& ca, int& cb) {
  ca = 0; cb = 0;
  int cnt = 0;
  for (int a = 0; a < 16; ++a) {
    const int nb = 16 / (a + 1);
    if (lane >= cnt && lane < cnt + nb) { ca = a; cb = lane - cnt; }
    cnt += nb;
  }
}


#define LRU_XCT 0
#define LRU_GX 32768
#define LRU_HF (32768 + 33792)
#define LRU_SUM (LRU_HF + 65536)
#define LRU_CARRY (LRU_SUM + 4096)
#define LRU_GGT (LRU_CARRY + 128)
#define LRU_LDS_BYTES (LRU_GGT + 8192)

struct LruParams {
  const float* cw; const float* cb; const float* b_rg; const float* b_ig; const float* lam;
};

template <int DIR>
__device__ __forceinline__ void lru_pass(const WS& w, const LruParams& P, int b, int hh, int qq, char* smem) {
  const int tid = tid_fresh(), lane = tid & 63, wid = tid >> 6;
  char* xct = smem + LRU_XCT;
  char* gx = smem + LRU_GX;
  float* Gt = (float*)(smem + LRU_GX);
  u16* hf = (u16*)(smem + LRU_HF);
  float* sumA = (float*)(smem + LRU_SUM);
  float* sumB = sumA + 512;
  float* carry = (float*)(smem + LRU_CARRY);
  bf16x8 bw[4];
  {
    const u16* wg = w.Wg + (((size_t)DIR * 8 + hh) * 4 + qq) * 32 * 64;
#pragma unroll
    for (int ks = 0; ks < 4; ++ks) bw[ks] = *(const bf16x8*)(wg + (lane & 31) * 64 + ks * 16 + 8 * (lane >> 5));
  }
  const int s_sub = tid >> 4, ch = tid & 15;
  const int cglob = hh * 64 + qq * 16 + ch;
  const float br = P.b_rg[DIR * 512 + cglob], bi = P.b_ig[DIR * 512 + cglob];
  const float Kc = 8.f * log_sigmoidf_(P.lam[DIR * 512 + cglob]);
  const int cp = tid & 31, rr = tid >> 5;
  float cw0[4], cw1[4];
#pragma unroll
  for (int k = 0; k < 4; ++k) { cw0[k] = P.cw[k * 512 + hh * 64 + 2 * cp]; cw1[k] = P.cw[k * 512 + hh * 64 + 2 * cp + 1]; }
  const float cb0 = P.cb[hh * 64 + 2 * cp], cb1 = P.cb[hh * 64 + 2 * cp + 1];
  if (tid < 16) carry[tid] = 0.f;
  u16* ggt = (u16*)(smem + LRU_GGT);
  u32x4 pf0, pf1, pf2, pf3, pf4, pgg;
  const u16* xlb = w.xl + (size_t)b * SEQ * 512 + hh * 64 + (tid & 7) * 8;
  const u16* ggb = w.gg + (size_t)b * SEQ * 512 + hh * 64 + qq * 16 + (tid & 1) * 8;
#define LRU_PF(c_) do { const int _s0 = (c_) * 256 - 2 + (tid >> 3); \
    pf0 = *(const u32x4*)(xlb + (size_t)min(max(_s0, 0), SEQ - 1) * 512); \
    pf1 = *(const u32x4*)(xlb + (size_t)min(max(_s0 + 64, 0), SEQ - 1) * 512); \
    pf2 = *(const u32x4*)(xlb + (size_t)min(max(_s0 + 128, 0), SEQ - 1) * 512); \
    pf3 = *(const u32x4*)(xlb + (size_t)min(max(_s0 + 192, 0), SEQ - 1) * 512); \
    pf4 = *(const u32x4*)(xlb + (size_t)min(max(_s0 + 256, 0), SEQ - 1) * 512); \
    if (DIR == 1) pgg = *(const u32x4*)(ggb + (size_t)((c_) * 256 + (tid >> 1)) * 512); } while (0)
  LRU_PF(DIR ? 7 : 0);

  for (int cs = 0; cs < 8; ++cs) {
    const int chunk = DIR ? (7 - cs) : cs;
    const int s0 = chunk * 256;
    {
      const u32x4 z = {0u, 0u, 0u, 0u};
      const int r0 = tid >> 3, c = tid & 7;
      const int sp0 = s0 - 2 + r0;
      *(u32x4*)(gx + (r0) * 128 + c * 16) = (sp0 >= 0 && sp0 < SEQ) ? pf0 : z;
      *(u32x4*)(gx + (r0 + 64) * 128 + c * 16) = (sp0 + 64 >= 0 && sp0 + 64 < SEQ) ? pf1 : z;
      *(u32x4*)(gx + (r0 + 128) * 128 + c * 16) = (sp0 + 128 >= 0 && sp0 + 128 < SEQ) ? pf2 : z;
      *(u32x4*)(gx + (r0 + 192) * 128 + c * 16) = (sp0 + 192 >= 0 && sp0 + 192 < SEQ) ? pf3 : z;
      if (r0 + 256 < 259) *(u32x4*)(gx + (r0 + 256) * 128 + c * 16) = (sp0 + 256 >= 0 && sp0 + 256 < SEQ) ? pf4 : z;
      if (DIR == 1) *(u32x4*)((char*)ggt + (tid >> 1) * 32 + (tid & 1) * 16) = pgg;
      const int cn = DIR ? max(6 - cs, 0) : min(cs + 1, 7);
      LRU_PF(cn);
    }
    __syncthreads();
    {
      const unsigned* gxi = (const unsigned*)gx;
      unsigned win[19];
#pragma unroll
      for (int i = 0; i < 19; ++i) win[i] = gxi[(rr * 16 + i) * 32 + cp];
#pragma unroll
      for (int i = 0; i < 16; ++i) {
        float o0 = cb0, o1 = cb1;
#pragma unroll
        for (int k = 0; k < 4; ++k) {
          o0 += cw0[k] * __uint_as_float(win[i + k] << 16);
          o1 += cw1[k] * __uint_as_float(win[i + k] & 0xffff0000u);
        }
        const int row = rr * 16 + i;
        const unsigned pk = (unsigned)f2bf(o0) | ((unsigned)f2bf(o1) << 16);
        *(unsigned*)(xct + swz_off(row, cp >> 2) + (cp & 3) * 4) = pk;
      }
    }
    __syncthreads();
    {
      f32x16 acc;
#pragma unroll
      for (int r = 0; r < 16; ++r) acc[r] = 0.f;
#pragma unroll
      for (int ks = 0; ks < 4; ++ks) {
        bf16x8 af = *(const bf16x8*)(xct + swz_off(wid * 32 + (lane & 31), ks * 2 + (lane >> 5)));
        acc = __builtin_amdgcn_mfma_f32_32x32x16_bf16(af, bw[ks], acc, 0, 0, 0);
      }
#pragma unroll
      for (int r = 0; r < 16; ++r) {
        const int row = wid * 32 + (r & 3) + 8 * (r >> 2) + 4 * (lane >> 5);
        Gt[row * 33 + (lane & 31)] = acc[r];
      }
    }
    __syncthreads();
    float av[8], uv[8];
    {
      float A = 1.f, B = 0.f;
#pragma unroll
      for (int i = 0; i < 8; ++i) {
        const int p = s_sub * 8 + i;
        const int tok = DIR ? (255 - p) : p;
        const float r = sigmoidf_(Gt[tok * 33 + ch] + br);
        const float ig = sigmoidf_(Gt[tok * 33 + 16 + ch] + bi);
        const int col = qq * 16 + ch;
        const float xcv = bf2f(*(const u16*)(xct + swz_off(tok, col >> 3) + (col & 7) * 2));
        const float a = __expf(Kc * r);
        const float u = __builtin_amdgcn_sqrtf(fmaxf(1.f - a * a, 0.f)) * ig * xcv;
        av[i] = a; uv[i] = u;
        B = a * B + u; A *= a;
      }
      sumA[s_sub * 16 + ch] = A; sumB[s_sub * 16 + ch] = B;
    }
    __syncthreads();
    {
      float h = carry[(cs & 1) * 16 + ch];
#pragma unroll 4
      for (int sp = 0; sp < 31; ++sp) {
        const float hn = sumA[sp * 16 + ch] * h + sumB[sp * 16 + ch];
        h = (sp < s_sub) ? hn : h;
      }
#pragma unroll
      for (int i = 0; i < 8; ++i) {
        const int p = s_sub * 8 + i;
        const int tok = DIR ? (255 - p) : p;
        h = av[i] * h + uv[i];
        const int sq = s0 + tok;
        if (DIR == 0) {
          hf[sq * 16 + ch] = f2bf(h);
        } else {
          const size_t t = (size_t)b * SEQ + sq;
          const float yv = (bf2f(hf[sq * 16 + ch]) + h) * bf2f(ggt[tok * 16 + ch]);
          w.y[AIDX(t, cglob)] = f2bf(yv);
          float ss = yv * yv;
          ss = sum_grp16(ss);
          if (ch == 0) w.ssq_lru[t * 32 + hh * 4 + qq] = ss;
        }
      }
      if (s_sub == 31) carry[((cs + 1) & 1) * 16 + ch] = h;
    }
    __syncthreads();
  }
#undef LRU_PF
}

__device__ __forceinline__ void p2_lru_task(const WS& w, const LruParams& P, int task, char* smem) {
  const int b = task >> 5, hh = (task >> 2) & 7, qq = task & 3;
  lru_pass<0>(w, P, b, hh, qq, smem);
  lru_pass<1>(w, P, b, hh, qq, smem);
}


#define CONV_LDS_BYTES (62 * 1024 + 32 * 4 * 4)
struct ConvParams { const float* cw; const float* cb; const float* ng; const float* nb; };

__device__ __forceinline__ void p2_conv_tile(const WS& w, const ConvParams& P, int tile, char* smem) {
  int tid = threadIdx.x;
  asm volatile("" : "+v"(tid));
  const int lane = tid & 63, wid = tid >> 6;
  const int b = tile >> 6, s0 = (tile & 63) * 32;
  float* red = (float*)(smem + 62 * 1024);
  for (int q = tid; q < 62 * 64; q += 512) {
    const int row = q >> 6, c = q & 63;
    const int sp = s0 - 15 + row;
    uint4 v = make_uint4(0, 0, 0, 0);
    if (sp >= 0 && sp < SEQ) v = *(const uint4*)(w.glu + ((size_t)b * SEQ + sp) * 512 + c * 8);
    *(uint4*)(smem + row * 1024 + c * 16) = v;
  }
  const int cp = tid & 255, th = tid >> 8;
  float w0[31], w1[31];
#pragma unroll
  for (int k = 0; k < 31; ++k) {
    const float2 wv = *(const float2*)(P.cw + k * 512 + 2 * cp);
    w0[k] = wv.x; w1[k] = wv.y;
  }
  const float2 cbv = *(const float2*)(P.cb + 2 * cp);
  const float2 ngv = *(const float2*)(P.ng + 2 * cp);
  const float2 nbv = *(const float2*)(P.nb + 2 * cp);
  __syncthreads();
  const unsigned* gl = (const unsigned*)smem;
  float y0[16], y1[16];
#pragma unroll
  for (int tb = 0; tb < 2; ++tb) {
    float a0[8], a1[8];
#pragma unroll
    for (int i = 0; i < 8; ++i) { a0[i] = cbv.x; a1[i] = cbv.y; }
    const int rbase = th * 16 + tb * 8;
#pragma unroll
    for (int j = 0; j < 38; ++j) {
      const unsigned pk = gl[(rbase + j) * 256 + cp];
      const float xlo = __uint_as_float(pk << 16), xhi = __uint_as_float(pk & 0xffff0000u);
#pragma unroll
      for (int i = 0; i < 8; ++i) {
        const int k = j - i;
        if (k >= 0 && k < 31) { a0[i] += w0[k] * xlo; a1[i] += w1[k] * xhi; }
      }
      if ((j & 3) == 3) __builtin_amdgcn_sched_barrier(0);
    }
#pragma unroll
    for (int i = 0; i < 8; ++i) {
      float s = a0[i] + a1[i];
      s = sum_grp32(s);
      const float mu = s * (1.f / 64.f);
      const float d0 = a0[i] - mu, d1 = a1[i] - mu;
      float q = d0 * d0 + d1 * d1;
      q = sum_grp32(q);
      const float rstd = rsqrtf(q * (1.f / 64.f) + EPS);
      const float v0 = d0 * rstd * ngv.x + nbv.x, v1 = d1 * rstd * ngv.y + nbv.y;
      const float yy0 = v0 * sigmoidf_(v0), yy1 = v1 * sigmoidf_(v1);
      y0[tb * 8 + i] = yy0; y1[tb * 8 + i] = yy1;
      float sq = yy0 * yy0 + yy1 * yy1;
      sq = wave_sum(sq);
      if (lane == 0) red[(th * 16 + tb * 8 + i) * 4 + (wid & 3)] = sq;
    }
    __builtin_amdgcn_sched_barrier(0);
  }
  __syncthreads();
#pragma unroll
  for (int i = 0; i < 16; ++i) {
    const int tok = th * 16 + i;
    const float4 r4 = *(const float4*)(red + tok * 4);
    const float rc = rsqrtf((r4.x + r4.y + r4.z + r4.w) * (1.f / 512.f) + EPS);
    const size_t t = (size_t)b * SEQ + s0 + tok;
    const unsigned pk = (unsigned)f2bf(y0[i] * rc) | ((unsigned)f2bf(y1[i] * rc) << 16);
    *(unsigned*)(w.y + AIDX(t, 512 + 2 * cp)) = pk;
  }
  __syncthreads();
}


#define XB_TMO      128
#define XB_XCNT(j)  (256  + 64 * (j))
#define XB_XSUB(j)  (1280 + 64 * (j))
#define XB_XGEN(j)  (2304 + 64 * (j))
#define XB_TOP      3328
#define XB_TOPGEN   3392
#define XCD_BAR_WORDS 3456
#define XB_SPIN_CAP (1u << 22)
#define LAS __attribute__((address_space(3)))
__device__ __forceinline__ unsigned xb_ld(unsigned* p) { return __hip_atomic_load(p, __ATOMIC_RELAXED, __HIP_MEMORY_SCOPE_AGENT); }
__device__ __forceinline__ unsigned xb_add(unsigned* p, unsigned v) { return __hip_atomic_fetch_add(p, v, __ATOMIC_RELAXED, __HIP_MEMORY_SCOPE_AGENT); }
__device__ __forceinline__ unsigned xb_xcc_id() { return (unsigned)__builtin_amdgcn_s_getreg((3 << 11) | 20) & 0xFu; }
#define XB_SPIN(cond, bar) do { unsigned _sp = 0; while (cond) { __builtin_amdgcn_s_sleep(1); \
    if ((++_sp & 255u) == 0u) { if (xb_ld(&(bar)[XB_TMO])) break; if (_sp > XB_SPIN_CAP) { atomicAdd(&(bar)[XB_TMO], 1u); break; } } } } while (0)
struct XcdBarrier { unsigned* bar; unsigned x; volatile LAS unsigned* st; };
__device__ __forceinline__ XcdBarrier xcd_barrier_post(unsigned* bar, volatile LAS unsigned* st) {
  XcdBarrier b; b.bar = bar; b.x = xb_xcc_id(); b.st = st;
  if (threadIdx.x == 0) (void)xb_add(&bar[XB_XCNT(b.x)], 1u);
  return b;
}
__device__ __forceinline__ void xcd_barrier_complete(unsigned* bar, unsigned x, unsigned& nloc, unsigned& nx) {
  const unsigned G = gridDim.x * gridDim.y * gridDim.z;
  unsigned sum, cnt, mine, sp = 0u;
  for (;;) {
    sum = 0u; cnt = 0u; mine = 0u;
#pragma unroll
    for (unsigned j = 0; j < 16; ++j) { const unsigned c = xb_ld(&bar[XB_XCNT(j)]); sum += c; cnt += (c > 0u) ? 1u : 0u; mine = (j == x) ? c : mine; }
    if (sum == G) break;
    __builtin_amdgcn_s_sleep(1);
    if ((++sp & 255u) == 0u) { if (xb_ld(&bar[XB_TMO])) break; if (sp > XB_SPIN_CAP) { atomicAdd(&bar[XB_TMO], 1u); break; } }
  }
  nloc = mine > 0u ? mine : 1u; nx = cnt > 0u ? cnt : 1u;
}
__device__ __forceinline__ void xcd_barrier(const XcdBarrier& b) {
  asm volatile("s_waitcnt vmcnt(0)" ::: "memory");
  __syncthreads();
  if (threadIdx.x == 0) {
    unsigned* bar = b.bar;
    __builtin_amdgcn_s_waitcnt(0);
    unsigned nloc = b.st[0], nx = b.st[1];
    if (nloc == 0u) { xcd_barrier_complete(bar, b.x, nloc, nx); b.st[0] = nloc; b.st[1] = nx; }
    const unsigned old = xb_add(&bar[XB_XSUB(b.x)], 1u);
    const unsigned gen = old / nloc;
    if (old + 1u == (gen + 1u) * nloc) {
      __builtin_amdgcn_fence(__ATOMIC_RELEASE, "agent");
      asm volatile("s_waitcnt vmcnt(0)" ::: "memory");
      const unsigned og = xb_add(&bar[XB_TOP], 1u);
      const unsigned tg = og / nx;
      if (og + 1u == (tg + 1u) * nx) xb_add(&bar[XB_TOPGEN], 1u);
      else XB_SPIN(xb_ld(&bar[XB_TOPGEN]) == tg, bar);
      __builtin_amdgcn_fence(__ATOMIC_ACQUIRE, "agent");
      xb_add(&bar[XB_XGEN(b.x)], 1u);
      asm volatile("s_waitcnt vmcnt(0)" ::: "memory");
    } else {
      XB_SPIN(xb_ld(&bar[XB_XGEN(b.x)]) == gen, bar);
      __builtin_amdgcn_fence(__ATOMIC_ACQUIRE, "agent");
      asm volatile("s_waitcnt vmcnt(0)" ::: "memory");
    }
  }
  __syncthreads();
}

struct MK {
  WS w;
  const float* x; const float* mix_norm_g; const float* w_in; const float* lru_conv_w; const float* lru_conv_b;
  const float* lru_w_rg; const float* lru_b_rg; const float* lru_w_ig; const float* lru_b_ig; const float* lru_lambda;
  const float* conf_conv_w; const float* conf_conv_b; const float* conf_norm_g; const float* conf_norm_b;
  const float* beta_lru; const float* beta_conv; const float* w_out; const float* ffn_norm_g; const float* peer_w_q;
  const float* peer_sub_keys; const float* peer_u; const float* peer_v; const float* final_norm_g;
  float* out;
  unsigned* bar;
};

static_assert(MK_LDS_BYTES >= LRU_LDS_BYTES && MK_LDS_BYTES >= GEMM3_LDS_BYTES + 1024, "lds size");
#define MK_LDS_TOTAL (MK_LDS_BYTES + 16 + 256)

template <int MODE>
__device__ __forceinline__ void prep_wT_tile(const float* __restrict__ wsrc, const float* __restrict__ scale_a,
                                             const float* __restrict__ scale_b, u16* __restrict__ dst, int N, int tile,
                                             int htid, float* tl) {
  const int ntn = N >> 5;
  const int n0 = (tile % ntn) * 32, k0 = (tile / ntn) * 32;
  const int tx = htid & 31, ty = htid >> 5;
#pragma unroll
  for (int i = 0; i < 4; ++i) {
    const int kk = ty + 8 * i, k = k0 + kk, n = n0 + tx;
    const int col = (MODE == 1) ? win_orig_col(n) : n;
    float sc;
    if (MODE == 2) sc = (k < 512) ? scale_a[k] : scale_b[k - 512];
    else sc = scale_a[k];
    tl[kk * 33 + tx] = sc * wsrc[(size_t)k * N + col];
  }
  __syncthreads();
#pragma unroll
  for (int i = 0; i < 4; ++i) {
    const int nn = ty + 8 * i;
    dst[WIDX(n0 + nn, k0 + tx, N)] = f2bf(tl[tx * 33 + nn]);
  }
  __syncthreads();
}

__device__ __forceinline__ void phase0(const MK& p, char* smem) {
  int tid = threadIdx.x;
  asm volatile("" : "+v"(tid));
  const int lane = tid & 63, wid = tid >> 6;
  const int nb = gridDim.x, bid = blockIdx.x;
  for (int t = bid * 8 + wid; t < T_TOK; t += nb * 8) {
    const float4* xr = (const float4*)(p.x + (size_t)t * 1024);
    float ss = 0.f;
    float4 v[4];
#pragma unroll
    for (int i = 0; i < 4; ++i) {
      v[i] = xr[i * 64 + lane];
      ss += v[i].x * v[i].x + v[i].y * v[i].y + v[i].z * v[i].z + v[i].w * v[i].w;
    }
    ss = wave_sum(ss);
#pragma unroll
    for (int i = 0; i < 4; ++i) {
      ushort4 o;
      o.x = f2bf(v[i].x); o.y = f2bf(v[i].y); o.z = f2bf(v[i].z); o.w = f2bf(v[i].w);
      *(ushort4*)(p.w.xb + AIDX(t, (i * 64 + lane) * 4)) = o;
    }
    if (lane == 0) p.w.rs0[t] = rsqrtf(ss * (1.f / 1024.f) + EPS);
  }
  {
    float* tl = (float*)smem + (tid >> 8) * (32 * 33);
    const int htid = tid & 255, hb = bid * 2 + (tid >> 8), nhb = nb * 2;
    for (int tile = hb; tile < 2048; tile += nhb) prep_wT_tile<1>(p.w_in, p.mix_norm_g, nullptr, p.w.WinT, 2048, tile, htid, tl);
    for (int tile = hb; tile < 1024; tile += nhb) prep_wT_tile<2>(p.w_out, p.beta_lru, p.beta_conv, p.w.WoutT, 1024, tile, htid, tl);
    for (int tile = hb; tile < 2048; tile += nhb) prep_wT_tile<0>(p.peer_w_q, p.ffn_norm_g, nullptr, p.w.WqT, 2048, tile, htid, tl);
  }
  for (int i = bid * 512 + tid; i < 16 * 128 * 128; i += nb * 512) {
    p.w.keysb[i] = f2bf(p.peer_sub_keys[i]);
    if (i < 2 * 8 * 4 * 32 * 64) {
      const int k = i & 63, j = (i >> 6) & 31, qq = (i >> 11) & 3, hh = (i >> 13) & 7, dir = (i >> 16) & 1;
      const int o = qq * 16 + (j & 15);
      const float* srcp = (j < 16) ? p.lru_w_rg : p.lru_w_ig;
      p.w.Wg[i] = f2bf(srcp[(((size_t)dir * 8 + hh) * 64 + k) * 64 + o]);
    }
  }
  {
    const size_t n4 = (size_t)16384 * 256;
    for (size_t i = (size_t)bid * 512 + tid; i < n4; i += (size_t)nb * 512) {
      const int d4 = (int)(i & 255);
      const float4 g = ((const float4*)p.ffn_norm_g)[d4];
      const float4 u = ((const float4*)p.peer_u)[i];
      const float4 v = ((const float4*)p.peer_v)[i];
      const int e = (int)(i >> 8), col = d4 * 4;
      const float cu = 448.f;
      const float ux = fminf(fmaxf(u.x * g.x * PEER_SU, -cu), cu), uy = fminf(fmaxf(u.y * g.y * PEER_SU, -cu), cu);
      const float uz = fminf(fmaxf(u.z * g.z * PEER_SU, -cu), cu), uw = fminf(fmaxf(u.w * g.w * PEER_SU, -cu), cu);
      const float vx = fminf(fmaxf(v.x * PEER_SV, -cu), cu), vy = fminf(fmaxf(v.y * PEER_SV, -cu), cu);
      const float vz = fminf(fmaxf(v.z * PEER_SV, -cu), cu), vw = fminf(fmaxf(v.w * PEER_SV, -cu), cu);
      int pu = __builtin_amdgcn_cvt_pk_fp8_f32(ux, uy, 0, false);
      pu = __builtin_amdgcn_cvt_pk_fp8_f32(uz, uw, pu, true);
      int pv = __builtin_amdgcn_cvt_pk_fp8_f32(vx, vy, 0, false);
      pv = __builtin_amdgcn_cvt_pk_fp8_f32(vz, vw, pv, true);
      const size_t so = ((size_t)(col >> 7) * 16384 + e) * 128 + (col & 127);
      *(int*)((char*)p.w.Ub + so) = pu;
      *(int*)((char*)p.w.Vb + so) = pv;
    }
  }
}

#define BAR_MARK() do { xcd_barrier(xb); PROBE_MARK(PSM(smem), 12); } while (0)
__global__ void __launch_bounds__(512) k_mega(MK p) {
  extern __shared__ __attribute__((aligned(16))) char smem[];
  const int nb = gridDim.x, bid = blockIdx.x;
  volatile LAS unsigned* xst = (volatile LAS unsigned*)(smem + MK_LDS_BYTES);
  if (threadIdx.x < 4) xst[threadIdx.x] = 0u;
#if PROBE
  PROBE_INIT(PSM(smem));
#endif
  __syncthreads();
  XcdBarrier xb = xcd_barrier_post(p.bar, xst);
  for (int rep = 0; rep < (DUP == 1 ? 2 : 1); ++rep) { phase0(p, smem); PROBE_MARK(PSM(smem), 1); BAR_MARK(); }
  for (int rep = 0; rep < (DUP == 2 ? 2 : 1); ++rep) {
    for (int tile = bid; tile < 1024; tile += nb) p1_tile(p.w, tile, nb, smem);
    PROBE_MARK(PSM(smem), 2); BAR_MARK();
  }
  {
    LruParams LP{p.lru_conv_w, p.lru_conv_b, p.lru_b_rg, p.lru_b_ig, p.lru_lambda};
    for (int rep = 0; rep < (DUP == 3 ? 2 : 1); ++rep) {
      for (int task = bid; task < 256; task += nb) p2_lru_task(p.w, LP, task, smem);
      if (DUP == 3 && rep == 0) xcd_barrier(xb);
    }
    PROBE_MARK(PSM(smem), 3);
    ConvParams CP{p.conf_conv_w, p.conf_conv_b, p.conf_norm_g, p.conf_norm_b};
    for (int rep = 0; rep < (DUP == 4 ? 2 : 1); ++rep) {
      for (int tile = bid; tile < 512; tile += nb) p2_conv_tile(p.w, CP, tile, smem);
      if (DUP == 4 && rep == 0) xcd_barrier(xb);
    }
    PROBE_MARK(PSM(smem), 4);
  }
  BAR_MARK();
  for (int rep = 0; rep < (DUP == 5 ? 2 : 1); ++rep) {
    for (int tile = bid; tile < 512; tile += nb) p3_tile(p.w, p.x, p.out, tile, smem);
    PROBE_MARK(PSM(smem), 5); BAR_MARK();
  }
  for (int rep = 0; rep < (DUP == 6 ? 2 : 1); ++rep) {
    for (int tile = bid; tile < 1024; tile += nb) p4_tile(p.w, tile, smem);
    PROBE_MARK(PSM(smem), 6); BAR_MARK();
  }
  for (int rep = 0; rep < (DUP == 7 ? 2 : 1); ++rep) {
    const int wid = threadIdx.x >> 6, lane = threadIdx.x & 63;
    int ca, cb;
    staircase_ab(lane, ca, cb);
    {
      unsigned pa[8], pb[8], na[8], nb8[8]; float sq, nsq;
      int t = bid * 8 + wid;
      if (t < T_TOK) p5_route_load(p.w, t, ca, cb, pa, pb, sq);
      for (; t < T_TOK; t += nb * 8) {
        const int tn = t + nb * 8;
        if (tn < T_TOK) p5_route_load(p.w, tn, ca, cb, na, nb8, nsq);
        p5_route_compute(p.w, t, pa, pb, sq, (float*)smem + wid * 512);
#pragma unroll
        for (int h = 0; h < 8; ++h) { pa[h] = na[h]; pb[h] = nb8[h]; }
        sq = nsq;
      }
    }
    PROBE_MARK(PSM(smem), 7); BAR_MARK();
  }
  for (int rep = 0; rep < (DUP == 11 ? 2 : 1); ++rep) {
    const int wid = threadIdx.x >> 6;
    if ((nb & 7) == 0 && (T_TOK % nb) == 0 && ((T_TOK / nb) & 1) == 0) {
      const int g = bid & 7, j = bid >> 3;
      const int wv = j * 8 + wid, nwv = (nb >> 3) * 8;
      u_sweep(p.w, g, wv, nwv, T_TOK / nwv);
    } else {
      for (int s = 0; s < 8; ++s)
        for (int t = bid * 8 + wid; t < T_TOK; t += nb * 8) p5_token_slice(p.w, t, s);
    }
    PROBE_MARK(PSM(smem), 8); BAR_MARK();
  }
  for (int rep = 0; rep < (DUP == 12 ? 2 : 1); ++rep) {
    const int wid = threadIdx.x >> 6;
    for (int t = bid * 8 + wid; t < T_TOK; t += nb * 8) p5_wphase(p.w, t);
    PROBE_MARK(PSM(smem), 9); BAR_MARK();
  }
  for (int rep = 0; rep < (DUP == 8 ? 2 : 1); ++rep) {
    const bool dry = (DUP == 8 && rep == 0);
    const int wid = threadIdx.x >> 6;
    if ((nb & 7) == 0 && (T_TOK % nb) == 0 && ((T_TOK / nb) & 1) == 0) {
      const int g = bid & 7, j = bid >> 3;
      const int wv = j * 8 + wid, nwv = (nb >> 3) * 8;
      v_sweep(p.w, g, wv, nwv, T_TOK / nwv, p.out, p.out, dry);
    } else {
      for (int s = 0; s < 8; ++s)
        for (int t = bid * 8 + wid; t < T_TOK; t += nb * 8) p6_token_slice(p.w, t, s, p.out, p.out, dry);
    }
    PROBE_MARK(PSM(smem), 10); BAR_MARK();
  }
  for (int rep = 0; rep < (DUP == 9 ? 2 : 1); ++rep) {
    const bool dry = (DUP == 9 && rep == 0);
    const int wid = threadIdx.x >> 6;
    for (int t = bid * 8 + wid; t < T_TOK; t += nb * 8) p7_row(p.w, t, p.final_norm_g, p.out, dry);
    if (DUP == 9 && rep == 0) xcd_barrier(xb);
  }
  PROBE_MARK(PSM(smem), 11);
#if DUP == 10
  for (int rep = 0; rep < 10; ++rep) xcd_barrier(xb);
#endif
#if PROBE
  if (bid == 0 && threadIdx.x == 0) {
    const unsigned long long* pa = (const unsigned long long*)PSM(smem);
    const unsigned long long dur = pa[PROBE];
    const unsigned long long st = __builtin_amdgcn_s_memrealtime();
    while (__builtin_amdgcn_s_memrealtime() - st < dur) __builtin_amdgcn_s_sleep(8);
  }
#endif
}

extern "C" void kernel_launch(void* const* d_in, const int* in_sizes, int n_in, void* d_out, int out_size, void* d_ws,
                              size_t ws_size, hipStream_t stream) {
  const float* x = (const float*)d_in[0];
  const float* mix_norm_g = (const float*)d_in[1];
  const float* w_in = (const float*)d_in[2];
  const float* lru_conv_w = (const float*)d_in[3];
  const float* lru_conv_b = (const float*)d_in[4];
  const float* lru_w_rg = (const float*)d_in[5];
  const float* lru_b_rg = (const float*)d_in[6];
  const float* lru_w_ig = (const float*)d_in[7];
  const float* lru_b_ig = (const float*)d_in[8];
  const float* lru_lambda = (const float*)d_in[9];
  const float* conf_conv_w = (const float*)d_in[10];
  const float* conf_conv_b = (const float*)d_in[11];
  const float* conf_norm_g = (const float*)d_in[12];
  const float* conf_norm_b = (const float*)d_in[13];
  const float* beta_lru = (const float*)d_in[14];
  const float* beta_conv = (const float*)d_in[15];
  const float* w_out = (const float*)d_in[16];
  const float* ffn_norm_g = (const float*)d_in[17];
  const float* peer_w_q = (const float*)d_in[18];
  const float* peer_sub_keys = (const float*)d_in[19];
  const float* peer_u = (const float*)d_in[20];
  const float* peer_v = (const float*)d_in[21];
  const float* final_norm_g = (const float*)d_in[22];
  float* out = (float*)d_out;
  WS w = make_ws(d_ws);
  static int grid_blocks = 0;
  if (!grid_blocks) {
    (void)hipFuncSetAttribute((const void*)k_mega, hipFuncAttributeMaxDynamicSharedMemorySize, MK_LDS_TOTAL);
    int dev = 0, cus = 0, per_cu = 0;
    (void)hipGetDevice(&dev);
    (void)hipDeviceGetAttribute(&cus, hipDeviceAttributeMultiprocessorCount, dev);
    (void)hipOccupancyMaxActiveBlocksPerMultiprocessor(&per_cu, k_mega, 512, MK_LDS_TOTAL);
    if (per_cu > 1) per_cu = 1;
    grid_blocks = cus * per_cu;
    if (grid_blocks <= 0) grid_blocks = 1;
  }
  MK p{};
  p.w = w;
  p.x = x; p.mix_norm_g = mix_norm_g; p.w_in = w_in; p.lru_conv_w = lru_conv_w; p.lru_conv_b = lru_conv_b;
  p.lru_w_rg = lru_w_rg; p.lru_b_rg = lru_b_rg; p.lru_w_ig = lru_w_ig; p.lru_b_ig = lru_b_ig; p.lru_lambda = lru_lambda;
  p.conf_conv_w = conf_conv_w; p.conf_conv_b = conf_conv_b; p.conf_norm_g = conf_norm_g; p.conf_norm_b = conf_norm_b;
  p.beta_lru = beta_lru; p.beta_conv = beta_conv; p.w_out = w_out; p.ffn_norm_g = ffn_norm_g; p.peer_w_q = peer_w_q;
  p.peer_sub_keys = peer_sub_keys; p.peer_u = peer_u; p.peer_v = peer_v; p.final_norm_g = final_norm_g;
  p.out = out;
  p.bar = w.bar;
  (void)hipMemsetAsync(w.bar, 0, XCD_BAR_WORDS * 4, stream);
  hipLaunchKernelGGL(k_mega, dim3(grid_blocks), dim3(512), MK_LDS_TOTAL, stream, p);
}
```

```cpp
#include <hip/hip_runtime.h>
#include <hip/hip_bf16.h>
#include <hip/hip_cooperative_groups.h>
#include <cstdio>
namespace cg = cooperative_groups;
#include <stdint.h>

typedef unsigned short u16;
typedef __attribute__((ext_vector_type(8))) short bf16x8;
typedef __attribute__((ext_vector_type(4))) float f32x4;
typedef __attribute__((ext_vector_type(16))) float f32x16;

#ifndef DUP
#define DUP 0
#endif
#ifndef PROBE
#define PROBE 0
#endif
#define MK_LDS_BYTES 148480
#define PSM(sm) ((sm) + MK_LDS_BYTES + 16)
#ifndef PBLK
#define PBLK 0
#endif
#if PROBE
#define PROBE_INIT(sm) unsigned long long* _pacc = (unsigned long long*)(sm); const bool _pon = (blockIdx.x == PBLK && threadIdx.x == 0); \
   if (_pon) { for (int _i = 0; _i < 31; ++_i) _pacc[_i] = 0ull; _pacc[31] = __builtin_amdgcn_s_memrealtime(); }
#define PROBE_MARK(sm, i) do { unsigned long long* _pa = (unsigned long long*)(sm); if (blockIdx.x == PBLK && threadIdx.x == 0) { \
   const unsigned long long _n = __builtin_amdgcn_s_memrealtime(); _pa[i] += _n - _pa[31]; _pa[31] = _n; } } while (0)
#else
#define PROBE_MARK(sm, i) do {} while (0)
#endif
#define T_TOK 16384
#define SEQ 2048
#define NB 8
#define DM 1024
#define DL 512
#define EPS 1e-6f
#define AIDX(t, k) ((((size_t)((k) >> 6)) * T_TOK + (size_t)(t)) * 64 + ((k) & 63))
#define WIDX(n, k, N) ((((size_t)((k) >> 6)) * (N) + (size_t)(n)) * 64 + ((k) & 63))
#define PEER_SU 256.f
#define PEER_SV 16.f
typedef __attribute__((ext_vector_type(2))) float f32x2;

__device__ __forceinline__ float bf2f(u16 v) { return __uint_as_float(((unsigned)v) << 16); }
__device__ __forceinline__ u16 f2bf(float f) {
  unsigned u = __float_as_uint(f);
  u += 0x7fffu + ((u >> 16) & 1u);
  return (u16)(u >> 16);
}
__device__ __forceinline__ float frcp(float x) { return __builtin_amdgcn_rcpf(x); }
__device__ __forceinline__ float sigmoidf_(float x) { return frcp(1.f + __expf(-x)); }
__device__ __forceinline__ float gelu_tanh(float x) {
  float u = 0.7978845608028654f * (x + 0.044715f * x * x * x);
  float e = __expf(2.f * u);
  float th = 1.f - 2.f * frcp(e + 1.f);
  return 0.5f * x * (1.f + th);
}
__device__ __forceinline__ float log_sigmoidf_(float x) {
  return fminf(x, 0.f) - log1pf(__expf(-fabsf(x)));
}
__device__ __forceinline__ int tid_fresh() { int t = threadIdx.x; asm volatile("" : "+v"(t)); return t; }
__device__ __forceinline__ float sum_grp16(float v) {
  v += __int_as_float(__builtin_amdgcn_update_dpp(0, __float_as_int(v), 0xB1, 0xF, 0xF, true));
  v += __int_as_float(__builtin_amdgcn_update_dpp(0, __float_as_int(v), 0x4E, 0xF, 0xF, true));
  v += __int_as_float(__builtin_amdgcn_update_dpp(0, __float_as_int(v), 0x141, 0xF, 0xF, true));
  v += __int_as_float(__builtin_amdgcn_update_dpp(0, __float_as_int(v), 0x140, 0xF, 0xF, true));
  return v;
}
__device__ __forceinline__ float sum_grp32(float v) {
  v = sum_grp16(v);
  auto a = __builtin_amdgcn_permlane16_swap(__float_as_int(v), __float_as_int(v), false, false);
  return __int_as_float(a[0]) + __int_as_float(a[1]);
}
__device__ __forceinline__ float wave_sum(float v) {
  v = sum_grp32(v);
  auto b = __builtin_amdgcn_permlane32_swap(__float_as_int(v), __float_as_int(v), false, false);
  return __int_as_float(b[0]) + __int_as_float(b[1]);
}

struct WS {
  u16* xb;
  float* rs0;
  u16* WinT;
  u16* WoutT;
  u16* WqT;
  u16* keysb;
  u16* Wg;
  u16* Ub;
  u16* Vb;
  u16* xl;
  u16* gg;
  u16* glu;
  u16* y;
  float* ssq_lru;
  float* ssq_h1;
  unsigned* cand;
  u16* h1b;
  float* tmp_a;
  float* tmp_b;
  u16* sel_e;
  float* wgt;
  float* ssq_out;
  unsigned* bar;
  float* gate;
  float* rs2v;
  unsigned* part;
};

static WS make_ws(void* d_ws) {
  char* p = (char*)d_ws;
  WS w;
  size_t off = 0;
  auto take = [&](size_t bytes) { char* r = p + off; off += (bytes + 255) & ~(size_t)255; return r; };
  w.xb = (u16*)take((size_t)T_TOK * 1024 * 2);
  w.rs0 = (float*)take((size_t)T_TOK * 4);
  w.WinT = (u16*)take((size_t)2048 * 1024 * 2);
  w.WoutT = (u16*)take((size_t)1024 * 1024 * 2);
  w.WqT = (u16*)take((size_t)2048 * 1024 * 2);
  w.keysb = (u16*)take((size_t)16 * 128 * 128 * 2);
  w.Wg = (u16*)take((size_t)2 * 8 * 4 * 32 * 64 * 2);
  w.Ub = (u16*)take((size_t)16384 * 1024 * 2);
  w.Vb = (u16*)take((size_t)16384 * 1024 * 2);
  w.xl = (u16*)take((size_t)T_TOK * 512 * 2);
  w.gg = (u16*)take((size_t)T_TOK * 512 * 2);
  w.glu = (u16*)take((size_t)T_TOK * 512 * 2);
  w.y = (u16*)take((size_t)T_TOK * 1024 * 2);
  w.ssq_lru = (float*)take((size_t)T_TOK * 32 * 4);
  w.ssq_h1 = (float*)take((size_t)T_TOK * 16 * 4);
  w.sel_e = (u16*)take((size_t)T_TOK * 128 * 2);
  w.wgt = (float*)take((size_t)T_TOK * 128 * 4);
  w.ssq_out = (float*)take((size_t)T_TOK * 16 * 4);
  w.bar = (unsigned*)take(4096 * 4);
  w.gate = (float*)take((size_t)T_TOK * 128 * 4);
  w.rs2v = (float*)take((size_t)T_TOK * 4);
  w.part = (unsigned*)w.xl;
  w.cand = (unsigned*)w.xl;
  w.h1b = w.xb;
  w.tmp_a = (float*)w.Ub;
  w.tmp_b = (float*)w.Vb;
  return w;
}


__device__ __forceinline__ int win_orig_col(int np) {
  if (np < 1024) return np;
  int r = (np - 1024) >> 6, i = (np - 1024) & 63;
  return (i < 32) ? (1024 + 32 * r + i) : (1536 + 32 * r + (i - 32));
}


__device__ __forceinline__ void load_rows8(const u16* __restrict__ A, int t0, float* xs) {
  for (int i = threadIdx.x; i < 8 * 1024; i += 256) xs[i] = bf2f(A[(size_t)t0 * 1024 + i]);
  __syncthreads();
}
__device__ __forceinline__ void dot8(const u16* __restrict__ wrow, const float* xs, int kbeg, int kend, float acc[8]) {
  for (int k = kbeg; k < kend; k += 8) {
    uint4 wv = *(const uint4*)(wrow + k);
    float wf[8];
    wf[0] = __uint_as_float(wv.x << 16); wf[1] = __uint_as_float(wv.x & 0xffff0000u);
    wf[2] = __uint_as_float(wv.y << 16); wf[3] = __uint_as_float(wv.y & 0xffff0000u);
    wf[4] = __uint_as_float(wv.z << 16); wf[5] = __uint_as_float(wv.z & 0xffff0000u);
    wf[6] = __uint_as_float(wv.w << 16); wf[7] = __uint_as_float(wv.w & 0xffff0000u);
#pragma unroll
    for (int r = 0; r < 8; ++r) {
      const float* xr = xs + r * 1024 + k;
      float a = acc[r];
#pragma unroll
      for (int j = 0; j < 8; ++j) a += wf[j] * xr[j];
      acc[r] = a;
    }
  }
}


__device__ __forceinline__ float rs2_of(const float* ssq_h1, int t) {
  float s = 0.f;
  for (int j = 0; j < 16; ++j) s += ssq_h1[(size_t)t * 16 + j];
  return rsqrtf(s * (1.f / 1024.f) + EPS);
}


#define GEMM_BUF_BYTES 49152
#define GEMM_LDS_BYTES (2 * GEMM_BUF_BYTES)

__device__ __forceinline__ int swz_off(int row, int c) { return row * 128 + ((c ^ ((row >> 1) & 7)) << 4); }

typedef __attribute__((ext_vector_type(4))) unsigned int u32x4;
#define G_LOAD(P, k0) do { \
  P##a0 = *(const u32x4*)(Ap + (size_t)0 * 64 * 1024 + (k0)); P##a1 = *(const u32x4*)(Ap + (size_t)1 * 64 * 1024 + (k0)); \
  P##a2 = *(const u32x4*)(Ap + (size_t)2 * 64 * 1024 + (k0)); P##a3 = *(const u32x4*)(Ap + (size_t)3 * 64 * 1024 + (k0)); \
  P##b0 = *(const u32x4*)(Bp + (size_t)0 * 64 * 1024 + (k0)); P##b1 = *(const u32x4*)(Bp + (size_t)1 * 64 * 1024 + (k0)); } while (0)
#define G_STORE(P, As_) do { char* _As = (As_); char* _Bs = _As + 32768; \
  *(u32x4*)(_As + swz_off(srow + 0, sc)) = P##a0; *(u32x4*)(_As + swz_off(srow + 64, sc)) = P##a1; \
  *(u32x4*)(_As + swz_off(srow + 128, sc)) = P##a2; *(u32x4*)(_As + swz_off(srow + 192, sc)) = P##a3; \
  *(u32x4*)(_Bs + swz_off(srow + 0, sc)) = P##b0; *(u32x4*)(_Bs + swz_off(srow + 64, sc)) = P##b1; } while (0)
__device__ __forceinline__ void g_mma(const char* As, int wm, int wn, int lane, f32x16 (&acc)[2][2]) {
  const char* Bs = As + 32768;
#pragma unroll
  for (int ks = 0; ks < 4; ++ks) {
    const int c = ks * 2 + (lane >> 5);
    bf16x8 af[2], bfr[2];
#pragma unroll
    for (int mi = 0; mi < 2; ++mi) af[mi] = *(const bf16x8*)(As + swz_off(wm * 64 + mi * 32 + (lane & 31), c));
#pragma unroll
    for (int ni = 0; ni < 2; ++ni) bfr[ni] = *(const bf16x8*)(Bs + swz_off(wn * 64 + ni * 32 + (lane & 31), c));
#pragma unroll
    for (int mi = 0; mi < 2; ++mi)
#pragma unroll
      for (int ni = 0; ni < 2; ++ni)
        acc[mi][ni] = __builtin_amdgcn_mfma_f32_32x32x16_bf16(af[mi], bfr[ni], acc[mi][ni], 0, 0, 0);
  }
}

#define GEMM_STAGE_BYTES 49152
#define GEMM3_LDS_BYTES (3 * GEMM_STAGE_BYTES)
template <bool RESCALE, int NBT>
__device__ __forceinline__ void gemm_core(const u16* __restrict__ A, const u16* __restrict__ Bt, int m0, int n0,
                                          char* smem, f32x16 (&acc)[2][2], const float* rls, int koff = 0) {
  const int tid = tid_fresh(), lane = tid & 63, wid = tid >> 6;
  const int wm = wid >> 1, wn = wid & 1;
  const int srow = tid >> 3, pos = tid & 7;
  const int csrc = pos ^ ((srow >> 1) & 7);
  const u16* Ap = A + (size_t)(m0 + srow) * 64 + csrc * 8;
  const u16* Bp = Bt + (size_t)(n0 + srow) * 64 + csrc * 8;
  const size_t ksA = (size_t)T_TOK * 64, ksB = (size_t)NBT * 64;
  char* wbase = smem + wid * 1024;
  asm volatile("" : "+v"(acc[0][0]), "+v"(acc[0][1]), "+v"(acc[1][0]), "+v"(acc[1][1]));
  __builtin_amdgcn_sched_barrier(0);
#define G_DMA(stage, kt_) do { const int _kt = (((kt_) + koff) & 15); char* _sb = wbase + (stage) * GEMM_STAGE_BYTES; \
    const u16* _a = Ap + _kt * ksA; const u16* _b = Bp + _kt * ksB; \
    __builtin_amdgcn_global_load_lds((const unsigned*)(_a + 0 * 4096), (unsigned*)(_sb + 0 * 8192), 16, 0, 0); \
    __builtin_amdgcn_global_load_lds((const unsigned*)(_a + 1 * 4096), (unsigned*)(_sb + 1 * 8192), 16, 0, 0); \
    __builtin_amdgcn_global_load_lds((const unsigned*)(_a + 2 * 4096), (unsigned*)(_sb + 2 * 8192), 16, 0, 0); \
    __builtin_amdgcn_global_load_lds((const unsigned*)(_a + 3 * 4096), (unsigned*)(_sb + 3 * 8192), 16, 0, 0); \
    __builtin_amdgcn_global_load_lds((const unsigned*)(_b + 0 * 4096), (unsigned*)(_sb + 32768 + 0 * 8192), 16, 0, 0); \
    __builtin_amdgcn_global_load_lds((const unsigned*)(_b + 1 * 4096), (unsigned*)(_sb + 32768 + 1 * 8192), 16, 0, 0); } while (0)
  G_DMA(0, 0);
  G_DMA(1, 1);
  int st = 0;
#pragma unroll 1
  for (int kt = 0; kt < 16; ++kt) {
    if (kt < 15) asm volatile("s_waitcnt vmcnt(6)" ::: "memory");
    else asm volatile("s_waitcnt vmcnt(0)" ::: "memory");
    asm volatile("s_waitcnt lgkmcnt(0)" ::: "memory");
    __builtin_amdgcn_s_barrier();
    if (kt + 2 < 16) { const int st2 = (st >= 1) ? st - 1 : st + 2; G_DMA(st2, kt + 2); }
    if (RESCALE && kt == 8) {
#pragma unroll
      for (int mi = 0; mi < 2; ++mi)
#pragma unroll
        for (int r = 0; r < 16; ++r) {
          const float s = rls[wm * 64 + mi * 32 + (r & 3) + 8 * (r >> 2) + 4 * (lane >> 5)];
          acc[mi][0][r] *= s; acc[mi][1][r] *= s;
        }
    }
    g_mma(smem + st * GEMM_STAGE_BYTES, wm, wn, lane, acc);
    st = (st == 2) ? 0 : st + 1;
  }
#undef G_DMA
  __syncthreads();
}

#define G256_STAGE_BYTES 32768
#define G256_LDS_BYTES (4 * G256_STAGE_BYTES)
__device__ __forceinline__ int swz64(int row, int c) { return row * 64 + ((c ^ ((row >> 2) & 3)) << 4); }
template <bool RESCALE, int NBT>
__device__ __forceinline__ void gemm_core256(const u16* __restrict__ A, const u16* __restrict__ Bt, int m0, int n0,
                                             char* smem, f32x16 (&acc)[4][2], const float* rls) {
  const int tid = tid_fresh(), lane = tid & 63, wid = tid >> 6;
  const int wm = wid >> 2, wn = wid & 3;
  const int rowi = wid * 16 + (lane >> 2);
  const int csrc = (lane & 3) ^ ((lane >> 4) & 3);
  const u16* Ap = A + (size_t)(m0 + rowi) * 64 + csrc * 8;
  const u16* Bp = Bt + (size_t)(n0 + rowi) * 64 + csrc * 8;
  const size_t ksA = (size_t)T_TOK * 64, ksB = (size_t)NBT * 64;
  char* wbase = smem + wid * 1024;
  asm volatile("" : "+v"(acc[0][0]), "+v"(acc[0][1]), "+v"(acc[1][0]), "+v"(acc[1][1]), "+v"(acc[2][0]), "+v"(acc[2][1]), "+v"(acc[3][0]), "+v"(acc[3][1]));
  __builtin_amdgcn_sched_barrier(0);
#define G2_DMA(s_) do { const int _s = (s_); char* _sb = wbase + (_s & 3) * G256_STAGE_BYTES; \
    const u16* _a = Ap + (_s >> 1) * ksA + (_s & 1) * 32; const u16* _b = Bp + (_s >> 1) * ksB + (_s & 1) * 32; \
    __builtin_amdgcn_global_load_lds((const unsigned*)(_a), (unsigned*)(_sb), 16, 0, 0); \
    __builtin_amdgcn_global_load_lds((const unsigned*)(_a + 8192), (unsigned*)(_sb + 8192), 16, 0, 0); \
    __builtin_amdgcn_global_load_lds((const unsigned*)(_b), (unsigned*)(_sb + 16384), 16, 0, 0); \
    __builtin_amdgcn_global_load_lds((const unsigned*)(_b + 8192), (unsigned*)(_sb + 16384 + 8192), 16, 0, 0); } while (0)
  G2_DMA(0);
  G2_DMA(1);
  G2_DMA(2);
#pragma unroll 1
  for (int s = 0; s < 32; ++s) {
    if (s < 30) asm volatile("s_waitcnt vmcnt(8)" ::: "memory");
    else if (s == 30) asm volatile("s_waitcnt vmcnt(4)" ::: "memory");
    else asm volatile("s_waitcnt vmcnt(0)" ::: "memory");
    asm volatile("s_waitcnt lgkmcnt(0)" ::: "memory");
    __builtin_amdgcn_s_barrier();
    if (s + 3 < 32) G2_DMA(s + 3);
    if (RESCALE && s == 16) {
#pragma unroll
      for (int mi = 0; mi < 4; ++mi)
#pragma unroll
        for (int r = 0; r < 16; ++r) {
          const float sc = rls[wm * 128 + mi * 32 + (r & 3) + 8 * (r >> 2) + 4 * (lane >> 5)];
          acc[mi][0][r] *= sc; acc[mi][1][r] *= sc;
        }
    }
    const char* As = smem + (s & 3) * G256_STAGE_BYTES;
    const char* Bs = As + 16384;
#pragma unroll
    for (int ks = 0; ks < 2; ++ks) {
      const int c = ks * 2 + (lane >> 5);
      bf16x8 af[4], bfr[2];
#pragma unroll
      for (int mi = 0; mi < 4; ++mi) af[mi] = *(const bf16x8*)(As + swz64(wm * 128 + mi * 32 + (lane & 31), c));
#pragma unroll
      for (int ni = 0; ni < 2; ++ni) bfr[ni] = *(const bf16x8*)(Bs + swz64(wn * 64 + ni * 32 + (lane & 31), c));
#pragma unroll
      for (int mi = 0; mi < 4; ++mi)
#pragma unroll
        for (int ni = 0; ni < 2; ++ni)
          acc[mi][ni] = __builtin_amdgcn_mfma_f32_32x32x16_bf16(af[mi], bfr[ni], acc[mi][ni], 0, 0, 0);
    }
  }
#undef G2_DMA
  __syncthreads();
}

__device__ __forceinline__ void zero_acc(f32x16 (&acc)[2][2]) {
#pragma unroll
  for (int mi = 0; mi < 2; ++mi)
#pragma unroll
    for (int ni = 0; ni < 2; ++ni)
#pragma unroll
      for (int r = 0; r < 16; ++r) acc[mi][ni][r] = 0.f;
}

__device__ __forceinline__ void p1_tile(const WS& w, int tile, int nblk_g, char* smem) {
  const int it = tile >> 8, b = tile & 255, g = b & 7, j = b >> 3;
  const int mt = it * 32 + g * 4 + (j >> 3), nt = j & 7;
  const int m0 = mt * 256, n0 = nt * 256;
  f32x16 acc[4][2];
#pragma unroll
  for (int mi = 0; mi < 4; ++mi)
#pragma unroll
    for (int ni = 0; ni < 2; ++ni)
#pragma unroll
      for (int r = 0; r < 16; ++r) acc[mi][ni][r] = 0.f;
  gemm_core256<false, 2048>(w.xb, w.WinT, m0, n0, smem, acc, nullptr);
  const int tidf = tid_fresh(); const int lane = tidf & 63, wid = tidf >> 6, wm = wid >> 2, wn = wid & 3;
  const int nb = n0 + wn * 64;
  const int rowb = m0 + wm * 128 + 4 * (lane >> 5);
#pragma unroll
  for (int mi = 0; mi < 4; ++mi) {
    float rs[16];
#pragma unroll
    for (int r = 0; r < 16; ++r) rs[r] = w.rs0[rowb + mi * 32 + (r & 3) + 8 * (r >> 2)];
    if (nb < 512) {
#pragma unroll
      for (int r = 0; r < 16; ++r) {
        const int row = rowb + mi * 32 + (r & 3) + 8 * (r >> 2);
#pragma unroll
        for (int ni = 0; ni < 2; ++ni) w.xl[(size_t)row * 512 + nb + ni * 32 + (lane & 31)] = f2bf(rs[r] * acc[mi][ni][r]);
      }
    } else if (nb < 1024) {
#pragma unroll
      for (int r = 0; r < 16; ++r) {
        const int row = rowb + mi * 32 + (r & 3) + 8 * (r >> 2);
#pragma unroll
        for (int ni = 0; ni < 2; ++ni) w.gg[(size_t)row * 512 + (nb - 512) + ni * 32 + (lane & 31)] = f2bf(gelu_tanh(rs[r] * acc[mi][ni][r]));
      }
    } else {
      const int ch = ((nb - 1024) >> 6) * 32 + (lane & 31);
#pragma unroll
      for (int r = 0; r < 16; ++r) {
        const int row = rowb + mi * 32 + (r & 3) + 8 * (r >> 2);
        const float a = rs[r] * acc[mi][0][r], bb = rs[r] * acc[mi][1][r];
        w.glu[(size_t)row * 512 + ch] = f2bf(a * sigmoidf_(bb));
      }
    }
  }
}
__device__ __forceinline__ void p3_tile(const WS& w, const float* __restrict__ x, float* __restrict__ h1, int tile, char* smem) {
  const int b = tile & 255, g = b & 7, j = b >> 3;
  const int mt = (tile >> 8) * 64 + g * 8 + (j >> 2), nt = j & 3;
  const int m0 = mt * 256, n0 = nt * 256;
  const int tidf = tid_fresh(); const int lane = tidf & 63, wid = tidf >> 6, wm = wid >> 2, wn = wid & 3;
  float* rls = (float*)(smem + G256_LDS_BYTES);
  if (tidf < 256) {
    const float4* p = (const float4*)(w.ssq_lru + (size_t)(m0 + tidf) * 32);
    float s = 0.f;
#pragma unroll
    for (int i = 0; i < 8; ++i) { float4 v = p[i]; s += v.x + v.y + v.z + v.w; }
    rls[tidf] = rsqrtf(s * (1.f / 512.f) + EPS);
  }
  f32x16 acc[4][2];
#pragma unroll
  for (int mi = 0; mi < 4; ++mi)
#pragma unroll
    for (int ni = 0; ni < 2; ++ni)
#pragma unroll
      for (int r = 0; r < 16; ++r) acc[mi][ni][r] = 0.f;
  gemm_core256<true, 1024>(w.y, w.WoutT, m0, n0, smem, acc, rls);
  const size_t ob = (size_t)(m0 + wm * 128 + 4 * (lane >> 5)) * 1024 + n0 + wn * 64 + (lane & 31);
#pragma unroll
  for (int mi = 0; mi < 4; ++mi) {
    float xr[2][16];
#pragma unroll
    for (int r = 0; r < 16; ++r)
#pragma unroll
      for (int ni = 0; ni < 2; ++ni) xr[ni][r] = x[ob + (size_t)(mi * 32 + (r & 3) + 8 * (r >> 2)) * 1024 + ni * 32];
#pragma unroll
    for (int r = 0; r < 16; ++r) {
      const int row = m0 + wm * 128 + mi * 32 + (r & 3) + 8 * (r >> 2) + 4 * (lane >> 5);
      float ss = 0.f;
#pragma unroll
      for (int ni = 0; ni < 2; ++ni) {
        const int col = n0 + wn * 64 + ni * 32 + (lane & 31);
        const float hv = xr[ni][r] + acc[mi][ni][r];
        h1[(size_t)row * 1024 + col] = hv;
        w.h1b[AIDX(row, col)] = f2bf(hv);
        ss += hv * hv;
      }
      ss = sum_grp32(ss);
      if ((lane & 31) == 0) w.ssq_h1[(size_t)row * 16 + nt * 4 + wn] = ss;
    }
  }
  __syncthreads();
}

__device__ __forceinline__ int swz256(int row, int c) { return row * 256 + ((c ^ (row & 15)) << 4); }

__device__ __forceinline__ void cmpswap_desc(float& a, float& b) { float mx = fmaxf(a, b), mn = fminf(a, b); a = mx; b = mn; }

__device__ __forceinline__ void p4_tile(const WS& w, int tile, char* smem) {
  const int it = tile >> 8, b = tile & 255, g = b & 7, j = b >> 3;
  const int mt = it * 16 + g * 2 + (j >> 4), hp = j & 15;
  const int m0 = mt * 256, n0 = hp * 128;
  const int tid = tid_fresh(), lane = tid & 63, wid = tid >> 6, wm = wid >> 1, wn = wid & 1;
  float* rls = (float*)(smem + GEMM3_LDS_BYTES);
  if (tid < 256) {
    const float4* p = (const float4*)(w.ssq_h1 + (size_t)(m0 + tid) * 16);
    float s = 0.f;
#pragma unroll
    for (int i = 0; i < 4; ++i) { float4 v = p[i]; s += v.x + v.y + v.z + v.w; }
    rls[tid] = rsqrtf(s * (1.f / 1024.f) + EPS);
  }
  f32x16 acc[2][2];
  zero_acc(acc);
  gemm_core<false, 2048>(w.h1b, w.WqT, m0, n0, smem, acc, nullptr, hp);
  PROBE_MARK(PSM(smem), 13);
  char* qs = smem;
  char* ksm = smem + 65536;
  {
#pragma unroll
  for (int mi = 0; mi < 2; ++mi)
#pragma unroll
    for (int r = 0; r < 16; ++r) {
      const int row = wm * 64 + mi * 32 + (r & 3) + 8 * (r >> 2) + 4 * (lane >> 5);
      const float rs = rls[row];
#pragma unroll
      for (int ni = 0; ni < 2; ++ni) {
        const int col = wn * 64 + ni * 32 + (lane & 31);
        *(u16*)(qs + swz256(row, col >> 3) + (col & 7) * 2) = f2bf(rs * acc[mi][ni][r]);
      }
    }
  {
    const u16* kp = w.keysb + (size_t)hp * 128 * 128;
#pragma unroll
    for (int i = 0; i < 4; ++i) {
      const int q = tid + 512 * i, row = q >> 4, c = q & 15;
      *(uint4*)(ksm + swz256(row, c)) = *(const uint4*)(kp + row * 128 + c * 8);
    }
  }
  __syncthreads();
  }
  PROBE_MARK(PSM(smem), 14);
  f32x16 sacc[4];
  {
#pragma unroll
  for (int ni = 0; ni < 4; ++ni)
#pragma unroll
    for (int r = 0; r < 16; ++r) sacc[ni][r] = 0.f;
#pragma unroll
  for (int ks = 0; ks < 8; ++ks) {
    const int c = ks * 2 + (lane >> 5);
    bf16x8 af = *(const bf16x8*)(qs + swz256(wid * 32 + (lane & 31), c));
#pragma unroll
    for (int ni = 0; ni < 4; ++ni) {
      bf16x8 bfr = *(const bf16x8*)(ksm + swz256(ni * 32 + (lane & 31), c));
      sacc[ni] = __builtin_amdgcn_mfma_f32_32x32x16_bf16(af, bfr, sacc[ni], 0, 0, 0);
    }
  }
  }
  PROBE_MARK(PSM(smem), 15);
  {
    const int l31 = lane & 31;
    int v0[16], v1[16], v2[16], v3[16], res[16];
#pragma unroll
    for (int r = 0; r < 16; ++r) {
      int k0 = (int)((__float_as_uint(sacc[0][r]) & ~127u) | (unsigned)(l31));
      int k1 = (int)((__float_as_uint(sacc[1][r]) & ~127u) | (unsigned)(32 + l31));
      int k2 = (int)((__float_as_uint(sacc[2][r]) & ~127u) | (unsigned)(64 + l31));
      int k3 = (int)((__float_as_uint(sacc[3][r]) & ~127u) | (unsigned)(96 + l31));
      k0 ^= (k0 >> 31) & 0x7fffffff; k1 ^= (k1 >> 31) & 0x7fffffff;
      k2 ^= (k2 >> 31) & 0x7fffffff; k3 ^= (k3 >> 31) & 0x7fffffff;
      int t;
      t = max(k0, k1); k1 = min(k0, k1); k0 = t;
      t = max(k2, k3); k3 = min(k2, k3); k2 = t;
      t = max(k0, k2); k2 = min(k0, k2); k0 = t;
      t = max(k1, k3); k3 = min(k1, k3); k1 = t;
      t = max(k1, k2); k2 = min(k1, k2); k1 = t;
      v0[r] = k0; v1[r] = k1; v2[r] = k2; v3[r] = k3;
      res[r] = (int)0x80000000;
    }
#pragma unroll 1
    for (int jj = 0; jj < 16; ++jj) {
      const int jm = (l31 == jj) ? -1 : 0;
#pragma unroll
      for (int r = 0; r < 16; ++r) {
        int m = v0[r];
        m = max(m, __builtin_amdgcn_update_dpp(0, m, 0xB1, 0xF, 0xF, true));
        m = max(m, __builtin_amdgcn_update_dpp(0, m, 0x4E, 0xF, 0xF, true));
        m = max(m, __builtin_amdgcn_update_dpp(0, m, 0x141, 0xF, 0xF, true));
        m = max(m, __builtin_amdgcn_update_dpp(0, m, 0x140, 0xF, 0xF, true));
        auto sw = __builtin_amdgcn_permlane16_swap(m, m, false, false);
        m = max((int)sw[0], (int)sw[1]);
        const int hm = (v0[r] == m) ? -1 : 0;
        v0[r] ^= (v0[r] ^ v1[r]) & hm;
        v1[r] ^= (v1[r] ^ v2[r]) & hm;
        v2[r] ^= (v2[r] ^ v3[r]) & hm;
        v3[r] ^= (v3[r] ^ (int)0x80000000) & hm;
        res[r] ^= (res[r] ^ m) & jm;
      }
    }
#pragma unroll
    for (int r = 0; r < 16; ++r) {
      const int row = m0 + wid * 32 + (r & 3) + 8 * (r >> 2) + 4 * (lane >> 5);
      const int key = res[r];
      const unsigned pk = (unsigned)(key ^ ((key >> 31) & 0x7fffffff));
      if (l31 < 16) w.cand[((size_t)row * 16 + hp) * 16 + l31] = pk;
    }
  }
  __syncthreads();
  PROBE_MARK(PSM(smem), 16);
}


typedef __attribute__((ext_vector_type(2))) __bf16 bf16x2_t;
__device__ __forceinline__ float dot2bf(unsigned a, unsigned b, float c) {
  return __builtin_amdgcn_fdot2_f32_bf16(__builtin_bit_cast(bf16x2_t, a), __builtin_bit_cast(bf16x2_t, b), c, false);
}
__device__ __forceinline__ float dot8bf(uint4 a, uint4 b, float c) {
  c = dot2bf(a.x, b.x, c); c = dot2bf(a.y, b.y, c); c = dot2bf(a.z, b.z, c); c = dot2bf(a.w, b.w, c);
  return c;
}
__device__ __forceinline__ void axpy8(float (&acc)[8], float wgt, uint4 v) {
  acc[0] += wgt * __uint_as_float(v.x << 16); acc[1] += wgt * __uint_as_float(v.x & 0xffff0000u);
  acc[2] += wgt * __uint_as_float(v.y << 16); acc[3] += wgt * __uint_as_float(v.y & 0xffff0000u);
  acc[4] += wgt * __uint_as_float(v.z << 16); acc[5] += wgt * __uint_as_float(v.z & 0xffff0000u);
  acc[6] += wgt * __uint_as_float(v.w << 16); acc[7] += wgt * __uint_as_float(v.w & 0xffff0000u);
}

__device__ __forceinline__ void p5_route_load(const WS& w, int t, int ca, int cb, unsigned (&pa)[8], unsigned (&pb)[8], float& sq) {
  const int lane = threadIdx.x & 63;
  const unsigned* cp = w.cand + (size_t)t * 256;
#pragma unroll
  for (int h = 0; h < 8; ++h) {
    pa[h] = cp[(2 * h) * 16 + ca];
    pb[h] = cp[(2 * h + 1) * 16 + cb];
  }
  sq = (lane < 16) ? w.ssq_h1[(size_t)t * 16 + lane] : 0.f;
}
__device__ __forceinline__ void p5_route_compute(const WS& w, int t, const unsigned (&pa)[8], const unsigned (&pb)[8], float sq, float* keys  ) {
  const int lane = threadIdx.x & 63;
  float s[8]; int e[8];
#pragma unroll
  for (int h = 0; h < 8; ++h) {
    const float sv = __uint_as_float(pa[h]) + __uint_as_float(pb[h]);
    e[h] = (int)(pa[h] & 127u) * 128 + (int)(pb[h] & 127u);
    s[h] = (lane < 50) ? __uint_as_float((__float_as_uint(sv) & ~63u) | (unsigned)lane) : -3.0e38f;
    keys[h * 64 + lane] = s[h];
  }
  __builtin_amdgcn_fence(__ATOMIC_RELEASE, "wavefront");
  __builtin_amdgcn_wave_barrier();
  __builtin_amdgcn_fence(__ATOMIC_ACQUIRE, "wavefront");
#pragma unroll
  for (int h = 0; h < 8; ++h) {
    int rank = 0;
    const float4* kp = (const float4*)(keys + h * 64);
#pragma unroll
    for (int j4 = 0; j4 < 13; ++j4) {
      const float4 k4 = kp[j4];
      rank += (k4.x > s[h]) ? 1 : 0;
      rank += (k4.y > s[h]) ? 1 : 0;
      if (j4 * 4 + 2 < 50) rank += (k4.z > s[h]) ? 1 : 0;
      if (j4 * 4 + 3 < 50) rank += (k4.w > s[h]) ? 1 : 0;
    }
    const bool sel = (lane < 50) && (rank < 16);
    const unsigned long long top = __ballot(rank == 0 && lane < 50);
    const float mx = __int_as_float(__builtin_amdgcn_readlane(__float_as_int(s[h]), (int)__builtin_ctzll(top)));
    const float ex = sel ? __expf(s[h] - mx) : 0.f;
    const float sum = wave_sum(ex);
    if (sel) {
      w.sel_e[(size_t)t * 128 + h * 16 + rank] = (u16)e[h];
      w.gate[(size_t)t * 128 + h * 16 + rank] = ex * frcp(sum);
    }
  }
  const float sqs = wave_sum(sq);
  if (lane == 0) w.rs2v[t] = rsqrtf(sqs * (1.f / 1024.f) + EPS);
  __builtin_amdgcn_fence(__ATOMIC_RELEASE, "wavefront");
  __builtin_amdgcn_wave_barrier();
  __builtin_amdgcn_fence(__ATOMIC_ACQUIRE, "wavefront");
}

__device__ __forceinline__ f32x2 fp8lo(unsigned d) { return __builtin_amdgcn_cvt_pk_f32_fp8((int)d, false); }
__device__ __forceinline__ f32x2 fp8hi(unsigned d) { return __builtin_amdgcn_cvt_pk_f32_fp8((int)d, true); }
__device__ __forceinline__ f32x2 bfpair(unsigned d) { f32x2 r; r.x = __uint_as_float(d << 16); r.y = __uint_as_float(d & 0xffff0000u); return r; }

__device__ __forceinline__ unsigned pick_e(unsigned epair, int i, int lane) {
  const unsigned ep = (unsigned)__shfl((int)epair, 4 * i + (lane >> 4), 64);
  return ((lane >> 3) & 1) ? (ep >> 16) : (ep & 0xffffu);
}
__device__ __forceinline__ void u_issue(const WS& w, int t, int s, unsigned epair, u32x4 (&u)[16], u32x4& xa, u32x4& xb) {
  const int lane = threadIdx.x & 63;
  const char* ubase = (const char*)w.Ub + (size_t)s * 16384 * 128 + (lane & 7) * 16;
#pragma unroll
  for (int i = 0; i < 16; ++i) u[i] = *(const u32x4*)(ubase + (size_t)pick_e(epair, i, lane) * 128);
  const u16* xp = w.h1b + AIDX(t, s * 128 + (lane & 7) * 16);
  xa = *(const u32x4*)xp; xb = *(const u32x4*)(xp + 8);
}
__device__ __forceinline__ void u_compute(const WS& w, int t, int s, const u32x4 (&u)[16], const u32x4& xa, const u32x4& xb, bool valid) {
  const int lane = threadIdx.x & 63;
  f32x2 x2[8];
  x2[0] = bfpair(xa.x); x2[1] = bfpair(xa.y); x2[2] = bfpair(xa.z); x2[3] = bfpair(xa.w);
  x2[4] = bfpair(xb.x); x2[5] = bfpair(xb.y); x2[6] = bfpair(xb.z); x2[7] = bfpair(xb.w);
  float p[16];
#pragma unroll
  for (int i = 0; i < 16; ++i) {
    f32x2 a = {0.f, 0.f};
    a = __builtin_elementwise_fma(fp8lo(u[i].x), x2[0], a); a = __builtin_elementwise_fma(fp8hi(u[i].x), x2[1], a);
    a = __builtin_elementwise_fma(fp8lo(u[i].y), x2[2], a); a = __builtin_elementwise_fma(fp8hi(u[i].y), x2[3], a);
    a = __builtin_elementwise_fma(fp8lo(u[i].z), x2[4], a); a = __builtin_elementwise_fma(fp8hi(u[i].z), x2[5], a);
    a = __builtin_elementwise_fma(fp8lo(u[i].w), x2[6], a); a = __builtin_elementwise_fma(fp8hi(u[i].w), x2[7], a);
    p[i] = a.x + a.y;
  }
#pragma unroll
  for (int c = 0; c < 8; ++c) {
    const bool up = (lane & 4) != 0;
    const float send = up ? p[c] : p[c + 8];
    const float keep = up ? p[c + 8] : p[c];
    p[c] = keep + __shfl_xor(send, 4, 64);
  }
#pragma unroll
  for (int c = 0; c < 4; ++c) {
    const bool up = (lane & 2) != 0;
    const float send = up ? p[c] : p[c + 4];
    const float keep = up ? p[c + 4] : p[c];
    p[c] = keep + __shfl_xor(send, 2, 64);
  }
#pragma unroll
  for (int c = 0; c < 2; ++c) {
    const bool up = (lane & 1) != 0;
    const float send = up ? p[c] : p[c + 2];
    const float keep = up ? p[c + 2] : p[c];
    p[c] = keep + __shfl_xor(send, 1, 64);
  }
  const _Float16 h0 = (_Float16)(p[0] * (1.f / PEER_SU)), h1v = (_Float16)(p[1] * (1.f / PEER_SU));
  const unsigned pk = (unsigned)__builtin_bit_cast(unsigned short, h0) | ((unsigned)__builtin_bit_cast(unsigned short, h1v) << 16);
  if (valid) w.part[((size_t)t * 8 + s) * 64 + lane] = pk;
}
__device__ __forceinline__ void u_sweep(const WS& w, int s, int t0, int stride) {
  const int n = (t0 < T_TOK) ? (T_TOK - t0 + stride - 1) / stride : 0;
  if (n <= 0) return;
  const int lane = threadIdx.x & 63;
  const unsigned* se = (const unsigned*)w.sel_e;
#define TT(i) (t0 + min((i), n - 1) * stride)
  u32x4 uA[16], uB[16], xaA, xbA, xaB, xbB;
  unsigned epA = se[(size_t)TT(0) * 64 + lane];
  unsigned epB = se[(size_t)TT(1) * 64 + lane];
  u_issue(w, TT(0), s, epA, uA, xaA, xbA);
#pragma unroll 1
  for (int i = 0; i < n; i += 2) {
    epA = se[(size_t)TT(i + 2) * 64 + lane];
    u_issue(w, TT(i + 1), s, epB, uB, xaB, xbB);
    u_compute(w, TT(i), s, uA, xaA, xbA, i < n);
    epB = se[(size_t)TT(i + 3) * 64 + lane];
    u_issue(w, TT(i + 2), s, epA, uA, xaA, xbA);
    u_compute(w, TT(i + 1), s, uB, xaB, xbB, i + 1 < n);
  }
#undef TT
}
__device__ __forceinline__ void p5_token_slice(const WS& w, int t, int s) {
  const int lane = threadIdx.x & 63;
  const unsigned epair = ((const unsigned*)w.sel_e)[(size_t)t * 64 + lane];
  u32x4 u[16], xa, xb;
  u_issue(w, t, s, epair, u, xa, xb);
  u_compute(w, t, s, u, xa, xb, true);
}

__device__ __forceinline__ void p5_wphase(const WS& w, int t) {
  const int lane = threadIdx.x & 63;
  float d0 = 0.f, d1 = 0.f;
#pragma unroll
  for (int s = 0; s < 8; ++s) {
    const unsigned pk = w.part[((size_t)t * 8 + s) * 64 + lane];
    d0 += (float)__builtin_bit_cast(_Float16, (unsigned short)(pk & 0xffffu));
    d1 += (float)__builtin_bit_cast(_Float16, (unsigned short)(pk >> 16));
  }
  const float rs2 = w.rs2v[t];
  const int p0 = 16 * (lane & 7) + (lane >> 3), p1 = p0 + 8;
  w.wgt[(size_t)t * 128 + p0] = w.gate[(size_t)t * 128 + p0] * gelu_tanh(rs2 * d0);
  w.wgt[(size_t)t * 128 + p1] = w.gate[(size_t)t * 128 + p1] * gelu_tanh(rs2 * d1);
}

__device__ __forceinline__ int v_col(int s, int lane) {
  return s * 128 + (lane & 7) * 16 + ((lane >> 5) & 1) * 8 + ((lane >> 4) & 1) * 4 + ((lane >> 3) & 1) * 2;
}
__device__ __forceinline__ void v_issue(const WS& w, int t, int s, unsigned epair, u32x4 (&v)[16], float2& hin, const float* h1) {
  const int lane = threadIdx.x & 63;
  const char* vbase = (const char*)w.Vb + (size_t)s * 16384 * 128 + (lane & 7) * 16;
#pragma unroll
  for (int i = 0; i < 16; ++i) v[i] = *(const u32x4*)(vbase + (size_t)pick_e(epair, i, lane) * 128);
  hin = *(const float2*)(h1 + (size_t)t * 1024 + v_col(s, lane));
}
__device__ __forceinline__ void v_compute(const WS& w, int t, int s, const u32x4 (&v)[16], float2 wpair, float2 hin, float* out, bool valid) {
  const int lane = threadIdx.x & 63;
  f32x2 a2[8];
#pragma unroll
  for (int c = 0; c < 8; ++c) { a2[c].x = 0.f; a2[c].y = 0.f; }
#pragma unroll
  for (int i = 0; i < 16; ++i) {
    const int srcl = 4 * i + (lane >> 4);
    const float w0 = __shfl(wpair.x, srcl, 64), w1 = __shfl(wpair.y, srcl, 64);
    const float wi = ((lane >> 3) & 1) ? w1 : w0;
    f32x2 wv; wv.x = wi; wv.y = wi;
    a2[0] = __builtin_elementwise_fma(fp8lo(v[i].x), wv, a2[0]); a2[1] = __builtin_elementwise_fma(fp8hi(v[i].x), wv, a2[1]);
    a2[2] = __builtin_elementwise_fma(fp8lo(v[i].y), wv, a2[2]); a2[3] = __builtin_elementwise_fma(fp8hi(v[i].y), wv, a2[3]);
    a2[4] = __builtin_elementwise_fma(fp8lo(v[i].z), wv, a2[4]); a2[5] = __builtin_elementwise_fma(fp8hi(v[i].z), wv, a2[5]);
    a2[6] = __builtin_elementwise_fma(fp8lo(v[i].w), wv, a2[6]); a2[7] = __builtin_elementwise_fma(fp8hi(v[i].w), wv, a2[7]);
  }
  float acc[16];
#pragma unroll
  for (int c = 0; c < 8; ++c) { acc[2 * c] = a2[c].x; acc[2 * c + 1] = a2[c].y; }
#pragma unroll
  for (int c = 0; c < 8; ++c) {
    const bool up = (lane & 32) != 0;
    const float send = up ? acc[c] : acc[c + 8];
    const float keep = up ? acc[c + 8] : acc[c];
    acc[c] = keep + __shfl_xor(send, 32, 64);
  }
#pragma unroll
  for (int c = 0; c < 4; ++c) {
    const bool up = (lane & 16) != 0;
    const float send = up ? acc[c] : acc[c + 4];
    const float keep = up ? acc[c + 4] : acc[c];
    acc[c] = keep + __shfl_xor(send, 16, 64);
  }
#pragma unroll
  for (int c = 0; c < 2; ++c) {
    const bool up = (lane & 8) != 0;
    const float send = up ? acc[c] : acc[c + 2];
    const float keep = up ? acc[c + 2] : acc[c];
    acc[c] = keep + __shfl_xor(send, 8, 64);
  }
  const size_t o = (size_t)t * 1024 + v_col(s, lane);
  const float hv0 = hin.x + acc[0] * (1.f / PEER_SV), hv1 = hin.y + acc[1] * (1.f / PEER_SV);
  const float ss = wave_sum(hv0 * hv0 + hv1 * hv1);
  if (valid) {
    *(float2*)(out + o) = make_float2(hv0, hv1);
    if (lane == 0) w.ssq_out[(size_t)t * 16 + s] = ss;
  }
}
__device__ __forceinline__ void v_sweep(const WS& w, int s, int t0, int stride, const float* h1, float* out, bool dry) {
  const int n = (t0 < T_TOK) ? (T_TOK - t0 + stride - 1) / stride : 0;
  if (n <= 0) return;
  const int lane = threadIdx.x & 63;
  const unsigned* se = (const unsigned*)w.sel_e;
  const float2* wg = (const float2*)w.wgt;
#define TT(i) (t0 + min((i), n - 1) * stride)
  u32x4 vA[16], vB[16];
  float2 hA, hB, wA, wB;
  unsigned epA = se[(size_t)TT(0) * 64 + lane];
  unsigned epB = se[(size_t)TT(1) * 64 + lane];
  wA = wg[(size_t)TT(0) * 64 + lane];
  v_issue(w, TT(0), s, epA, vA, hA, h1);
#pragma unroll 1
  for (int i = 0; i < n; i += 2) {
    epA = se[(size_t)TT(i + 2) * 64 + lane];
    wB = wg[(size_t)TT(i + 1) * 64 + lane];
    v_issue(w, TT(i + 1), s, epB, vB, hB, h1);
    v_compute(w, TT(i), s, vA, wA, hA, out, !dry);
    epB = se[(size_t)TT(i + 3) * 64 + lane];
    wA = wg[(size_t)TT(i + 2) * 64 + lane];
    v_issue(w, TT(i + 2), s, epA, vA, hA, h1);
    v_compute(w, TT(i + 1), s, vB, wB, hB, out, !dry && (i + 1 < n));
  }
#undef TT
}
__device__ __forceinline__ void p6_token_slice(const WS& w, int t, int s, const float* h1, float* out, bool dry = false) {
  const int lane = threadIdx.x & 63;
  const unsigned epair = ((const unsigned*)w.sel_e)[(size_t)t * 64 + lane];
  const float2 wpair = ((const float2*)w.wgt)[(size_t)t * 64 + lane];
  u32x4 v[16]; float2 hin;
  v_issue(w, t, s, epair, v, hin, h1);
  v_compute(w, t, s, v, wpair, hin, out, !dry);
}

__device__ __forceinline__ void p7_row(const WS& w, int t, const float* __restrict__ gF, float* out, bool dry = false) {
  const int lane = threadIdx.x & 63;
  float s = (lane < 8) ? w.ssq_out[(size_t)t * 16 + lane] : 0.f;
  s = wave_sum(s);
  const float rn = rsqrtf(s * (1.f / 1024.f) + EPS);
  float4* orow = (float4*)(out + (size_t)t * 1024);
#pragma unroll
  for (int i = 0; i < 4; ++i) {
    float4 v = orow[i * 64 + lane];
    const float4 g = ((const float4*)gF)[i * 64 + lane];
    v.x *= rn * g.x; v.y *= rn * g.y; v.z *= rn * g.z; v.w *= rn * g.w;
    if (dry) { asm volatile("" :: "v"(v.x), "v"(v.y), "v"(v.z), "v"(v.w)); continue; }
    orow[i * 64 + lane] = v;
  }
}

__device__ __forceinline__ void staircase_ab(int lane, int& ca, int& cb) {
  ca = 0; cb = 0;
  int cnt = 0;
  for (int a = 0; a < 16; ++a) {
    const int nb = 16 / (a + 1);
    if (lane >= cnt && lane < cnt + nb) { ca = a; cb = lane - cnt; }
    cnt += nb;
  }
}


struct UvJob { const float* U; const float* V; const float* g2; u16* Ub; u16* Vb; size_t i0; size_t stride; };
#define UV_N4 ((size_t)16384 * 256)
__device__ __forceinline__ void uv_store(const UvJob& J, size_t i, const float4& u, const float4& v, const float4& g) {
  const int e = (int)(i >> 8), col = (int)(i & 255) * 4;
  const float cu = 448.f;
  const float ux = fminf(fmaxf(u.x * g.x * PEER_SU, -cu), cu), uy = fminf(fmaxf(u.y * g.y * PEER_SU, -cu), cu);
  const float uz = fminf(fmaxf(u.z * g.z * PEER_SU, -cu), cu), uw = fminf(fmaxf(u.w * g.w * PEER_SU, -cu), cu);
  const float vx = fminf(fmaxf(v.x * PEER_SV, -cu), cu), vy = fminf(fmaxf(v.y * PEER_SV, -cu), cu);
  const float vz = fminf(fmaxf(v.z * PEER_SV, -cu), cu), vw = fminf(fmaxf(v.w * PEER_SV, -cu), cu);
  int pu = __builtin_amdgcn_cvt_pk_fp8_f32(ux, uy, 0, false);
  pu = __builtin_amdgcn_cvt_pk_fp8_f32(uz, uw, pu, true);
  int pv = __builtin_amdgcn_cvt_pk_fp8_f32(vx, vy, 0, false);
  pv = __builtin_amdgcn_cvt_pk_fp8_f32(vz, vw, pv, true);
  const size_t so = ((size_t)(col >> 7) * 16384 + e) * 128 + (col & 127);
  *(int*)((char*)J.Ub + so) = pu;
  *(int*)((char*)J.Vb + so) = pv;
}

#define LRU_XCT 0
#define LRU_GX 32768
#define LRU_HF (32768 + 33792)
#define LRU_SUM (LRU_HF + 65536)
#define LRU_CARRY (LRU_SUM + 4096)
#define LRU_GGT (LRU_CARRY + 128)
#define LRU_LDS_BYTES (LRU_GGT + 8192)

struct LruParams {
  const float* cw; const float* cb; const float* b_rg; const float* b_ig; const float* lam;
};

template <int DIR>
__device__ __forceinline__ void lru_pass(const WS& w, const LruParams& P, int b, int hh, int qq, char* smem, const UvJob& J, int& uvk) {
  const int tid = tid_fresh(), lane = tid & 63, wid = tid >> 6;
  char* xct = smem + LRU_XCT;
  char* gx = smem + LRU_GX;
  float* Gt = (float*)(smem + LRU_GX);
  u16* hf = (u16*)(smem + LRU_HF);
  float* sumA = (float*)(smem + LRU_SUM);
  float* sumB = sumA + 512;
  float* carry = (float*)(smem + LRU_CARRY);
  bf16x8 bw[4];
  {
    const u16* wg = w.Wg + (((size_t)DIR * 8 + hh) * 4 + qq) * 32 * 64;
#pragma unroll
    for (int ks = 0; ks < 4; ++ks) bw[ks] = *(const bf16x8*)(wg + (lane & 31) * 64 + ks * 16 + 8 * (lane >> 5));
  }
  const int s_sub = tid >> 4, ch = tid & 15;
  const int cglob = hh * 64 + qq * 16 + ch;
  const float br = P.b_rg[DIR * 512 + cglob], bi = P.b_ig[DIR * 512 + cglob];
  const float Kc = 8.f * log_sigmoidf_(P.lam[DIR * 512 + cglob]);
  const int cp = tid & 31, rr = tid >> 5;
  float cw0[4], cw1[4];
#pragma unroll
  for (int k = 0; k < 4; ++k) { cw0[k] = P.cw[k * 512 + hh * 64 + 2 * cp]; cw1[k] = P.cw[k * 512 + hh * 64 + 2 * cp + 1]; }
  const float cb0 = P.cb[hh * 64 + 2 * cp], cb1 = P.cb[hh * 64 + 2 * cp + 1];
  if (tid < 16) carry[tid] = 0.f;
  u16* ggt = (u16*)(smem + LRU_GGT);
  u32x4 pf0, pf1, pf2, pf3, pf4, pgg;
  const u16* xlb = w.xl + (size_t)b * SEQ * 512 + hh * 64 + (tid & 7) * 8;
  const u16* ggb = w.gg + (size_t)b * SEQ * 512 + hh * 64 + qq * 16 + (tid & 1) * 8;
#define LRU_PF(c_) do { const int _s0 = (c_) * 256 - 2 + (tid >> 3); \
    pf0 = *(const u32x4*)(xlb + (size_t)min(max(_s0, 0), SEQ - 1) * 512); \
    pf1 = *(const u32x4*)(xlb + (size_t)min(max(_s0 + 64, 0), SEQ - 1) * 512); \
    pf2 = *(const u32x4*)(xlb + (size_t)min(max(_s0 + 128, 0), SEQ - 1) * 512); \
    pf3 = *(const u32x4*)(xlb + (size_t)min(max(_s0 + 192, 0), SEQ - 1) * 512); \
    pf4 = *(const u32x4*)(xlb + (size_t)min(max(_s0 + 256, 0), SEQ - 1) * 512); \
    if (DIR == 1) pgg = *(const u32x4*)(ggb + (size_t)((c_) * 256 + (tid >> 1)) * 512); } while (0)
  LRU_PF(DIR ? 7 : 0);

  for (int cs = 0; cs < 8; ++cs) {
    const int chunk = DIR ? (7 - cs) : cs;
    const int s0 = chunk * 256;
    {
      const u32x4 z = {0u, 0u, 0u, 0u};
      const int r0 = tid >> 3, c = tid & 7;
      const int sp0 = s0 - 2 + r0;
      *(u32x4*)(gx + (r0) * 128 + c * 16) = (sp0 >= 0 && sp0 < SEQ) ? pf0 : z;
      *(u32x4*)(gx + (r0 + 64) * 128 + c * 16) = (sp0 + 64 >= 0 && sp0 + 64 < SEQ) ? pf1 : z;
      *(u32x4*)(gx + (r0 + 128) * 128 + c * 16) = (sp0 + 128 >= 0 && sp0 + 128 < SEQ) ? pf2 : z;
      *(u32x4*)(gx + (r0 + 192) * 128 + c * 16) = (sp0 + 192 >= 0 && sp0 + 192 < SEQ) ? pf3 : z;
      if (r0 + 256 < 259) *(u32x4*)(gx + (r0 + 256) * 128 + c * 16) = (sp0 + 256 >= 0 && sp0 + 256 < SEQ) ? pf4 : z;
      if (DIR == 1) *(u32x4*)((char*)ggt + (tid >> 1) * 32 + (tid & 1) * 16) = pgg;
      const int cn = DIR ? max(6 - cs, 0) : min(cs + 1, 7);
      LRU_PF(cn);
    }
    const size_t ja = J.i0 + (size_t)uvk * J.stride, jb = ja + J.stride;
    const size_t jac = ja < UV_N4 ? ja : 0, jbc = jb < UV_N4 ? jb : 0;
    const float4 juA = ((const float4*)J.U)[jac], jvA = ((const float4*)J.V)[jac], jgA = ((const float4*)J.g2)[jac & 255];
    const float4 juB = ((const float4*)J.U)[jbc], jvB = ((const float4*)J.V)[jbc], jgB = ((const float4*)J.g2)[jbc & 255];
    __syncthreads();
    {
      const unsigned* gxi = (const unsigned*)gx;
      unsigned win[19];
#pragma unroll
      for (int i = 0; i < 19; ++i) win[i] = gxi[(rr * 16 + i) * 32 + cp];
#pragma unroll
      for (int i = 0; i < 16; ++i) {
        float o0 = cb0, o1 = cb1;
#pragma unroll
        for (int k = 0; k < 4; ++k) {
          o0 += cw0[k] * __uint_as_float(win[i + k] << 16);
          o1 += cw1[k] * __uint_as_float(win[i + k] & 0xffff0000u);
        }
        const int row = rr * 16 + i;
        const unsigned pk = (unsigned)f2bf(o0) | ((unsigned)f2bf(o1) << 16);
        *(unsigned*)(xct + swz_off(row, cp >> 2) + (cp & 3) * 4) = pk;
      }
    }
    __syncthreads();
    {
      f32x16 acc;
#pragma unroll
      for (int r = 0; r < 16; ++r) acc[r] = 0.f;
#pragma unroll
      for (int ks = 0; ks < 4; ++ks) {
        bf16x8 af = *(const bf16x8*)(xct + swz_off(wid * 32 + (lane & 31), ks * 2 + (lane >> 5)));
        acc = __builtin_amdgcn_mfma_f32_32x32x16_bf16(af, bw[ks], acc, 0, 0, 0);
      }
#pragma unroll
      for (int r = 0; r < 16; ++r) {
        const int row = wid * 32 + (r & 3) + 8 * (r >> 2) + 4 * (lane >> 5);
        Gt[row * 33 + (lane & 31)] = acc[r];
      }
    }
    __syncthreads();
    float av[8], uv[8];
    {
      float A = 1.f, B = 0.f;
#pragma unroll
      for (int i = 0; i < 8; ++i) {
        const int p = s_sub * 8 + i;
        const int tok = DIR ? (255 - p) : p;
        const float r = sigmoidf_(Gt[tok * 33 + ch] + br);
        const float ig = sigmoidf_(Gt[tok * 33 + 16 + ch] + bi);
        const int col = qq * 16 + ch;
        const float xcv = bf2f(*(const u16*)(xct + swz_off(tok, col >> 3) + (col & 7) * 2));
        const float a = __expf(Kc * r);
        const float u = __builtin_amdgcn_sqrtf(fmaxf(1.f - a * a, 0.f)) * ig * xcv;
        av[i] = a; uv[i] = u;
        B = a * B + u; A *= a;
      }
      sumA[s_sub * 16 + ch] = A; sumB[s_sub * 16 + ch] = B;
    }
    __syncthreads();
    {
      float h = carry[(cs & 1) * 16 + ch];
#pragma unroll 4
      for (int sp = 0; sp < 31; ++sp) {
        const float hn = sumA[sp * 16 + ch] * h + sumB[sp * 16 + ch];
        h = (sp < s_sub) ? hn : h;
      }
#pragma unroll
      for (int i = 0; i < 8; ++i) {
        const int p = s_sub * 8 + i;
        const int tok = DIR ? (255 - p) : p;
        h = av[i] * h + uv[i];
        const int sq = s0 + tok;
        if (DIR == 0) {
          hf[sq * 16 + ch] = f2bf(h);
        } else {
          const size_t t = (size_t)b * SEQ + sq;
          const float yv = (bf2f(hf[sq * 16 + ch]) + h) * bf2f(ggt[tok * 16 + ch]);
          w.y[AIDX(t, cglob)] = f2bf(yv);
          float ss = yv * yv;
          ss = sum_grp16(ss);
          if (ch == 0) w.ssq_lru[t * 32 + hh * 4 + qq] = ss;
        }
      }
      if (s_sub == 31) carry[((cs + 1) & 1) * 16 + ch] = h;
    }
    if (ja < UV_N4) uv_store(J, ja, juA, jvA, jgA);
    if (jb < UV_N4) uv_store(J, jb, juB, jvB, jgB);
    uvk += 2;
    __syncthreads();
  }
#undef LRU_PF
}

__device__ __forceinline__ void p2_lru_task(const WS& w, const LruParams& P, int task, char* smem, const UvJob& J, int& uvk) {
  const int b = task >> 5, hh = (task >> 2) & 7, qq = task & 3;
  lru_pass<0>(w, P, b, hh, qq, smem, J, uvk);
  lru_pass<1>(w, P, b, hh, qq, smem, J, uvk);
}


#define CONV_LDS_BYTES (62 * 1024 + 32 * 4 * 4)
struct ConvParams { const float* cw; const float* cb; const float* ng; const float* nb; };

__device__ __forceinline__ void p2_conv_tile(const WS& w, const ConvParams& P, int tile, char* smem) {
  int tid = threadIdx.x;
  asm volatile("" : "+v"(tid));
  const int lane = tid & 63, wid = tid >> 6;
  const int b = tile >> 6, s0 = (tile & 63) * 32;
  float* red = (float*)(smem + 62 * 1024);
  for (int q = tid; q < 62 * 64; q += 512) {
    const int row = q >> 6, c = q & 63;
    const int sp = s0 - 15 + row;
    uint4 v = make_uint4(0, 0, 0, 0);
    if (sp >= 0 && sp < SEQ) v = *(const uint4*)(w.glu + ((size_t)b * SEQ + sp) * 512 + c * 8);
    *(uint4*)(smem + row * 1024 + c * 16) = v;
  }
  const int cp = tid & 255, th = tid >> 8;
  float w0[31], w1[31];
#pragma unroll
  for (int k = 0; k < 31; ++k) {
    const float2 wv = *(const float2*)(P.cw + k * 512 + 2 * cp);
    w0[k] = wv.x; w1[k] = wv.y;
  }
  const float2 cbv = *(const float2*)(P.cb + 2 * cp);
  const float2 ngv = *(const float2*)(P.ng + 2 * cp);
  const float2 nbv = *(const float2*)(P.nb + 2 * cp);
  __syncthreads();
  const unsigned* gl = (const unsigned*)smem;
  float y0[16], y1[16];
#pragma unroll
  for (int tb = 0; tb < 2; ++tb) {
    float a0[8], a1[8];
#pragma unroll
    for (int i = 0; i < 8; ++i) { a0[i] = cbv.x; a1[i] = cbv.y; }
    const int rbase = th * 16 + tb * 8;
#pragma unroll
    for (int j = 0; j < 38; ++j) {
      const unsigned pk = gl[(rbase + j) * 256 + cp];
      const float xlo = __uint_as_float(pk << 16), xhi = __uint_as_float(pk & 0xffff0000u);
#pragma unroll
      for (int i = 0; i < 8; ++i) {
        const int k = j - i;
        if (k >= 0 && k < 31) { a0[i] += w0[k] * xlo; a1[i] += w1[k] * xhi; }
      }
      if ((j & 3) == 3) __builtin_amdgcn_sched_barrier(0);
    }
#pragma unroll
    for (int i = 0; i < 8; ++i) {
      float s = a0[i] + a1[i];
      s = sum_grp32(s);
      const float mu = s * (1.f / 64.f);
      const float d0 = a0[i] - mu, d1 = a1[i] - mu;
      float q = d0 * d0 + d1 * d1;
      q = sum_grp32(q);
      const float rstd = rsqrtf(q * (1.f / 64.f) + EPS);
      const float v0 = d0 * rstd * ngv.x + nbv.x, v1 = d1 * rstd * ngv.y + nbv.y;
      const float yy0 = v0 * sigmoidf_(v0), yy1 = v1 * sigmoidf_(v1);
      y0[tb * 8 + i] = yy0; y1[tb * 8 + i] = yy1;
      float sq = yy0 * yy0 + yy1 * yy1;
      sq = wave_sum(sq);
      if (lane == 0) red[(th * 16 + tb * 8 + i) * 4 + (wid & 3)] = sq;
    }
    __builtin_amdgcn_sched_barrier(0);
  }
  __syncthreads();
#pragma unroll
  for (int i = 0; i < 16; ++i) {
    const int tok = th * 16 + i;
    const float4 r4 = *(const float4*)(red + tok * 4);
    const float rc = rsqrtf((r4.x + r4.y + r4.z + r4.w) * (1.f / 512.f) + EPS);
    const size_t t = (size_t)b * SEQ + s0 + tok;
    const unsigned pk = (unsigned)f2bf(y0[i] * rc) | ((unsigned)f2bf(y1[i] * rc) << 16);
    *(unsigned*)(w.y + AIDX(t, 512 + 2 * cp)) = pk;
  }
  __syncthreads();
}


#define XB_TMO      128
#define XB_XCNT(j)  (256  + 64 * (j))
#define XB_XSUB(j)  (1280 + 64 * (j))
#define XB_XGEN(j)  (2304 + 64 * (j))
#define XB_TOP      3328
#define XB_TOPGEN   3392
#define XCD_BAR_WORDS 3456
#define XB_SPIN_CAP (1u << 22)
#define LAS __attribute__((address_space(3)))
__device__ __forceinline__ unsigned xb_ld(unsigned* p) { return __hip_atomic_load(p, __ATOMIC_RELAXED, __HIP_MEMORY_SCOPE_AGENT); }
__device__ __forceinline__ unsigned xb_add(unsigned* p, unsigned v) { return __hip_atomic_fetch_add(p, v, __ATOMIC_RELAXED, __HIP_MEMORY_SCOPE_AGENT); }
__device__ __forceinline__ unsigned xb_xcc_id() { return (unsigned)__builtin_amdgcn_s_getreg((3 << 11) | 20) & 0xFu; }
#define XB_SPIN(cond, bar) do { unsigned _sp = 0; while (cond) { __builtin_amdgcn_s_sleep(1); \
    if ((++_sp & 255u) == 0u) { if (xb_ld(&(bar)[XB_TMO])) break; if (_sp > XB_SPIN_CAP) { atomicAdd(&(bar)[XB_TMO], 1u); break; } } } } while (0)
struct XcdBarrier { unsigned* bar; unsigned x; volatile LAS unsigned* st; };
__device__ __forceinline__ XcdBarrier xcd_barrier_post(unsigned* bar, volatile LAS unsigned* st) {
  XcdBarrier b; b.bar = bar; b.x = xb_xcc_id(); b.st = st;
  if (threadIdx.x == 0) st[2] = xb_add(&bar[XB_XCNT(b.x)], 1u);
  return b;
}
__device__ __forceinline__ void xcd_barrier_complete(unsigned* bar, unsigned x, unsigned& nloc, unsigned& nx) {
  const unsigned G = gridDim.x * gridDim.y * gridDim.z;
  unsigned sum, cnt, mine, sp = 0u;
  for (;;) {
    sum = 0u; cnt = 0u; mine = 0u;
#pragma unroll
    for (unsigned j = 0; j < 16; ++j) { const unsigned c = xb_ld(&bar[XB_XCNT(j)]); sum += c; cnt += (c > 0u) ? 1u : 0u; mine = (j == x) ? c : mine; }
    if (sum == G) break;
    __builtin_amdgcn_s_sleep(1);
    if ((++sp & 255u) == 0u) { if (xb_ld(&bar[XB_TMO])) break; if (sp > XB_SPIN_CAP) { atomicAdd(&bar[XB_TMO], 1u); break; } }
  }
  nloc = mine > 0u ? mine : 1u; nx = cnt > 0u ? cnt : 1u;
}
__device__ __forceinline__ void xcd_barrier(const XcdBarrier& b) {
  asm volatile("s_waitcnt vmcnt(0)" ::: "memory");
  __syncthreads();
  if (threadIdx.x == 0) {
    unsigned* bar = b.bar;
    __builtin_amdgcn_s_waitcnt(0);
    unsigned nloc = b.st[0], nx = b.st[1];
    if (nloc == 0u) { xcd_barrier_complete(bar, b.x, nloc, nx); b.st[0] = nloc; b.st[1] = nx; }
    const unsigned old = xb_add(&bar[XB_XSUB(b.x)], 1u);
    const unsigned gen = old / nloc;
    if (old + 1u == (gen + 1u) * nloc) {
      __builtin_amdgcn_fence(__ATOMIC_RELEASE, "agent");
      asm volatile("s_waitcnt vmcnt(0)" ::: "memory");
      const unsigned og = xb_add(&bar[XB_TOP], 1u);
      const unsigned tg = og / nx;
      if (og + 1u == (tg + 1u) * nx) xb_add(&bar[XB_TOPGEN], 1u);
      else XB_SPIN(xb_ld(&bar[XB_TOPGEN]) == tg, bar);
      __builtin_amdgcn_fence(__ATOMIC_ACQUIRE, "agent");
      xb_add(&bar[XB_XGEN(b.x)], 1u);
      asm volatile("s_waitcnt vmcnt(0)" ::: "memory");
    } else {
      XB_SPIN(xb_ld(&bar[XB_XGEN(b.x)]) == gen, bar);
      __builtin_amdgcn_fence(__ATOMIC_ACQUIRE, "agent");
      asm volatile("s_waitcnt vmcnt(0)" ::: "memory");
    }
  }
  __syncthreads();
}

struct MK {
  WS w;
  const float* x; const float* mix_norm_g; const float* w_in; const float* lru_conv_w; const float* lru_conv_b;
  const float* lru_w_rg; const float* lru_b_rg; const float* lru_w_ig; const float* lru_b_ig; const float* lru_lambda;
  const float* conf_conv_w; const float* conf_conv_b; const float* conf_norm_g; const float* conf_norm_b;
  const float* beta_lru; const float* beta_conv; const float* w_out; const float* ffn_norm_g; const float* peer_w_q;
  const float* peer_sub_keys; const float* peer_u; const float* peer_v; const float* final_norm_g;
  float* out;
  unsigned* bar;
};

static_assert(MK_LDS_BYTES >= LRU_LDS_BYTES && MK_LDS_BYTES >= GEMM3_LDS_BYTES + 1024, "lds size");
#define MK_LDS_TOTAL (MK_LDS_BYTES + 16 + 256)

template <int MODE>
__device__ __forceinline__ void prep_wT_tile(const float* __restrict__ wsrc, const float* __restrict__ scale_a,
                                             const float* __restrict__ scale_b, u16* __restrict__ dst, int N, int tile,
                                             int htid, float* tl) {
  const int ntn = N >> 5;
  const int n0 = (tile % ntn) * 32, k0 = (tile / ntn) * 32;
  const int tx = htid & 31, ty = htid >> 5;
#pragma unroll
  for (int i = 0; i < 4; ++i) {
    const int kk = ty + 8 * i, k = k0 + kk, n = n0 + tx;
    const int col = (MODE == 1) ? win_orig_col(n) : n;
    float sc;
    if (MODE == 2) sc = (k < 512) ? scale_a[k] : scale_b[k - 512];
    else sc = scale_a[k];
    tl[kk * 33 + tx] = sc * wsrc[(size_t)k * N + col];
  }
  __syncthreads();
#pragma unroll
  for (int i = 0; i < 4; ++i) {
    const int nn = ty + 8 * i;
    dst[WIDX(n0 + nn, k0 + tx, N)] = f2bf(tl[tx * 33 + nn]);
  }
  __syncthreads();
}

__device__ __forceinline__ void phase0(const MK& p, char* smem) {
  int tid = threadIdx.x;
  asm volatile("" : "+v"(tid));
  const int lane = tid & 63, wid = tid >> 6;
  const int nb = gridDim.x, bid = blockIdx.x;
  {
    auto row_store = [&](int t, const float4 (&v)[4]) {
      float ss = 0.f;
#pragma unroll
      for (int i = 0; i < 4; ++i) ss += v[i].x * v[i].x + v[i].y * v[i].y + v[i].z * v[i].z + v[i].w * v[i].w;
      ss = wave_sum(ss);
#pragma unroll
      for (int i = 0; i < 4; ++i) {
        ushort4 o;
        o.x = f2bf(v[i].x); o.y = f2bf(v[i].y); o.z = f2bf(v[i].z); o.w = f2bf(v[i].w);
        *(ushort4*)(p.w.xb + AIDX(t, (i * 64 + lane) * 4)) = o;
      }
      if (lane == 0) p.w.rs0[t] = rsqrtf(ss * (1.f / 1024.f) + EPS);
    };
    const int st = nb * 8;
    int t = bid * 8 + wid;
    for (; t + st < T_TOK; t += 2 * st) {
      float4 va[4], vb[4];
#pragma unroll
      for (int i = 0; i < 4; ++i) va[i] = ((const float4*)(p.x + (size_t)t * 1024))[i * 64 + lane];
#pragma unroll
      for (int i = 0; i < 4; ++i) vb[i] = ((const float4*)(p.x + (size_t)(t + st) * 1024))[i * 64 + lane];
      row_store(t, va);
      row_store(t + st, vb);
    }
    for (; t < T_TOK; t += st) {
      float4 va[4];
#pragma unroll
      for (int i = 0; i < 4; ++i) va[i] = ((const float4*)(p.x + (size_t)t * 1024))[i * 64 + lane];
      row_store(t, va);
    }
  }
  {
    float* tl = (float*)smem + (tid >> 8) * (32 * 33);
    const int htid = tid & 255, hb = bid * 2 + (tid >> 8), nhb = nb * 2;
    for (int tile = hb; tile < 2048; tile += nhb) prep_wT_tile<1>(p.w_in, p.mix_norm_g, nullptr, p.w.WinT, 2048, tile, htid, tl);
    for (int tile = hb; tile < 1024; tile += nhb) prep_wT_tile<2>(p.w_out, p.beta_lru, p.beta_conv, p.w.WoutT, 1024, tile, htid, tl);
    for (int tile = hb; tile < 2048; tile += nhb) prep_wT_tile<0>(p.peer_w_q, p.ffn_norm_g, nullptr, p.w.WqT, 2048, tile, htid, tl);
  }
  for (int i = bid * 512 + tid; i < 16 * 128 * 128; i += nb * 512) {
    p.w.keysb[i] = f2bf(p.peer_sub_keys[i]);
    if (i < 2 * 8 * 4 * 32 * 64) {
      const int k = i & 63, j = (i >> 6) & 31, qq = (i >> 11) & 3, hh = (i >> 13) & 7, dir = (i >> 16) & 1;
      const int o = qq * 16 + (j & 15);
      const float* srcp = (j < 16) ? p.lru_w_rg : p.lru_w_ig;
      p.w.Wg[i] = f2bf(srcp[(((size_t)dir * 8 + hh) * 64 + k) * 64 + o]);
    }
  }
}

#define BAR_MARK() do { xcd_barrier(xb); PROBE_MARK(PSM(smem), 12); } while (0)
__global__ void __launch_bounds__(512) k_mega(MK p) {
  extern __shared__ __attribute__((aligned(16))) char smem[];
  const int nb = gridDim.x, bid = blockIdx.x;
  volatile LAS unsigned* xst = (volatile LAS unsigned*)(smem + MK_LDS_BYTES);
  if (threadIdx.x < 4) xst[threadIdx.x] = 0u;
#if PROBE
  PROBE_INIT(PSM(smem));
#endif
  __syncthreads();
  XcdBarrier xb = xcd_barrier_post(p.bar, xst);
  for (int rep = 0; rep < (DUP == 1 ? 2 : 1); ++rep) { phase0(p, smem); PROBE_MARK(PSM(smem), 1); BAR_MARK(); }
  for (int rep = 0; rep < (DUP == 2 ? 2 : 1); ++rep) {
    for (int tile = bid; tile < 512; tile += nb) p1_tile(p.w, tile, nb, smem);
    PROBE_MARK(PSM(smem), 2); BAR_MARK();
  }
  {
    LruParams LP{p.lru_conv_w, p.lru_conv_b, p.lru_b_rg, p.lru_b_ig, p.lru_lambda};
    UvJob UJ{p.peer_u, p.peer_v, p.ffn_norm_g, p.w.Ub, p.w.Vb, (size_t)bid * 512 + threadIdx.x, (size_t)nb * 512};
    int uvk = 0;
    for (int rep = 0; rep < (DUP == 3 ? 2 : 1); ++rep) {
      for (int task = bid; task < 256; task += nb) p2_lru_task(p.w, LP, task, smem, UJ, uvk);
      if (DUP == 3 && rep == 0) xcd_barrier(xb);
    }
    for (size_t i = UJ.i0 + (size_t)uvk * UJ.stride; i < UV_N4; i += UJ.stride)
      uv_store(UJ, i, ((const float4*)UJ.U)[i], ((const float4*)UJ.V)[i], ((const float4*)UJ.g2)[i & 255]);
    PROBE_MARK(PSM(smem), 3);
    ConvParams CP{p.conf_conv_w, p.conf_conv_b, p.conf_norm_g, p.conf_norm_b};
    for (int rep = 0; rep < (DUP == 4 ? 2 : 1); ++rep) {
      for (int tile = bid; tile < 512; tile += nb) p2_conv_tile(p.w, CP, tile, smem);
      if (DUP == 4 && rep == 0) xcd_barrier(xb);
    }
    PROBE_MARK(PSM(smem), 4);
  }
  BAR_MARK();
  for (int rep = 0; rep < (DUP == 5 ? 2 : 1); ++rep) {
    for (int tile = bid; tile < 256; tile += nb) p3_tile(p.w, p.x, p.out, tile, smem);
    PROBE_MARK(PSM(smem), 5); BAR_MARK();
  }
  for (int rep = 0; rep < (DUP == 6 ? 2 : 1); ++rep) {
    for (int tile = bid; tile < 1024; tile += nb) p4_tile(p.w, tile, smem);
    PROBE_MARK(PSM(smem), 6); BAR_MARK();
  }
  for (int rep = 0; rep < (DUP == 7 ? 2 : 1); ++rep) {
    const int wid = threadIdx.x >> 6, lane = threadIdx.x & 63;
    int ca, cb;
    staircase_ab(lane, ca, cb);
    {
      unsigned pa[8], pb[8], na[8], nb8[8]; float sq, nsq;
      int t = bid * 8 + wid;
      if (t < T_TOK) p5_route_load(p.w, t, ca, cb, pa, pb, sq);
      for (; t < T_TOK; t += nb * 8) {
        const int tn = t + nb * 8;
        if (tn < T_TOK) p5_route_load(p.w, tn, ca, cb, na, nb8, nsq);
        p5_route_compute(p.w, t, pa, pb, sq, (float*)smem + wid * 512);
#pragma unroll
        for (int h = 0; h < 8; ++h) { pa[h] = na[h]; pb[h] = nb8[h]; }
        sq = nsq;
      }
    }
    PROBE_MARK(PSM(smem), 7); BAR_MARK();
  }
  int gs_slice, gs_t0, gs_stride;
  {
    const unsigned nloc = xst[0], nx = xst[1], rank = xst[2];
    const int wid = threadIdx.x >> 6;
    bool all8 = (nx == 8u);
    if (all8) { for (int j = 0; j < 8; ++j) all8 = all8 && (xb_ld(&p.bar[XB_XCNT(j)]) > 0u); }
    if (all8 && xb.x < 8u) { gs_slice = (int)xb.x; gs_t0 = (int)rank * 8 + wid; gs_stride = (int)nloc * 8; }
    else if ((nb & 7) == 0) { gs_slice = bid & 7; gs_t0 = (bid >> 3) * 8 + wid; gs_stride = (nb >> 3) * 8; }
    else { gs_slice = -1; gs_t0 = bid * 8 + wid; gs_stride = nb * 8; }
  }
  for (int rep = 0; rep < (DUP == 11 ? 2 : 1); ++rep) {
    if (gs_slice >= 0) u_sweep(p.w, gs_slice, gs_t0, gs_stride);
    else for (int s = 0; s < 8; ++s) u_sweep(p.w, s, gs_t0, gs_stride);
    PROBE_MARK(PSM(smem), 8); BAR_MARK();
  }
  for (int rep = 0; rep < (DUP == 12 ? 2 : 1); ++rep) {
    const int wid = threadIdx.x >> 6;
    for (int t = bid * 8 + wid; t < T_TOK; t += nb * 8) p5_wphase(p.w, t);
    PROBE_MARK(PSM(smem), 9); BAR_MARK();
  }
  for (int rep = 0; rep < (DUP == 8 ? 2 : 1); ++rep) {
    const bool dry = (DUP == 8 && rep == 0);
    if (gs_slice >= 0) v_sweep(p.w, gs_slice, gs_t0, gs_stride, p.out, p.out, dry);
    else for (int s = 0; s < 8; ++s) v_sweep(p.w, s, gs_t0, gs_stride, p.out, p.out, dry);
    PROBE_MARK(PSM(smem), 10); BAR_MARK();
  }
  for (int rep = 0; rep < (DUP == 9 ? 2 : 1); ++rep) {
    const bool dry = (DUP == 9 && rep == 0);
    const int wid = threadIdx.x >> 6;
    for (int t = bid * 8 + wid; t < T_TOK; t += nb * 8) p7_row(p.w, t, p.final_norm_g, p.out, dry);
    if (DUP == 9 && rep == 0) xcd_barrier(xb);
  }
  PROBE_MARK(PSM(smem), 11);
#if DUP == 10
  for (int rep = 0; rep < 10; ++rep) xcd_barrier(xb);
#endif
#if PROBE
  if (bid == PBLK && threadIdx.x == 0) {
    const unsigned long long* pa = (const unsigned long long*)PSM(smem);
    const unsigned long long dur = pa[PROBE];
    const unsigned long long st = __builtin_amdgcn_s_memrealtime();
    while (__builtin_amdgcn_s_memrealtime() - st < dur) __builtin_amdgcn_s_sleep(8);
  }
#endif
}

extern "C" void kernel_launch(void* const* d_in, const int* in_sizes, int n_in, void* d_out, int out_size, void* d_ws,
                              size_t ws_size, hipStream_t stream) {
  const float* x = (const float*)d_in[0];
  const float* mix_norm_g = (const float*)d_in[1];
  const float* w_in = (const float*)d_in[2];
  const float* lru_conv_w = (const float*)d_in[3];
  const float* lru_conv_b = (const float*)d_in[4];
  const float* lru_w_rg = (const float*)d_in[5];
  const float* lru_b_rg = (const float*)d_in[6];
  const float* lru_w_ig = (const float*)d_in[7];
  const float* lru_b_ig = (const float*)d_in[8];
  const float* lru_lambda = (const float*)d_in[9];
  const float* conf_conv_w = (const float*)d_in[10];
  const float* conf_conv_b = (const float*)d_in[11];
  const float* conf_norm_g = (const float*)d_in[12];
  const float* conf_norm_b = (const float*)d_in[13];
  const float* beta_lru = (const float*)d_in[14];
  const float* beta_conv = (const float*)d_in[15];
  const float* w_out = (const float*)d_in[16];
  const float* ffn_norm_g = (const float*)d_in[17];
  const float* peer_w_q = (const float*)d_in[18];
  const float* peer_sub_keys = (const float*)d_in[19];
  const float* peer_u = (const float*)d_in[20];
  const float* peer_v = (const float*)d_in[21];
  const float* final_norm_g = (const float*)d_in[22];
  float* out = (float*)d_out;
  WS w = make_ws(d_ws);
  static int grid_blocks = 0;
  if (!grid_blocks) {
    (void)hipFuncSetAttribute((const void*)k_mega, hipFuncAttributeMaxDynamicSharedMemorySize, MK_LDS_TOTAL);
    int dev = 0, cus = 0, per_cu = 0;
    (void)hipGetDevice(&dev);
    (void)hipDeviceGetAttribute(&cus, hipDeviceAttributeMultiprocessorCount, dev);
    (void)hipOccupancyMaxActiveBlocksPerMultiprocessor(&per_cu, k_mega, 512, MK_LDS_TOTAL);
    if (per_cu > 1) per_cu = 1;
    grid_blocks = cus * per_cu;
    if (grid_blocks <= 0) grid_blocks = 1;
  }
  MK p{};
  p.w = w;
  p.x = x; p.mix_norm_g = mix_norm_g; p.w_in = w_in; p.lru_conv_w = lru_conv_w; p.lru_conv_b = lru_conv_b;
  p.lru_w_rg = lru_w_rg; p.lru_b_rg = lru_b_rg; p.lru_w_ig = lru_w_ig; p.lru_b_ig = lru_b_ig; p.lru_lambda = lru_lambda;
  p.conf_conv_w = conf_conv_w; p.conf_conv_b = conf_conv_b; p.conf_norm_g = conf_norm_g; p.conf_norm_b = conf_norm_b;
  p.beta_lru = beta_lru; p.beta_conv = beta_conv; p.w_out = w_out; p.ffn_norm_g = ffn_norm_g; p.peer_w_q = peer_w_q;
  p.peer_sub_keys = peer_sub_keys; p.peer_u = peer_u; p.peer_v = peer_v; p.final_norm_g = final_norm_g;
  p.out = out;
  p.bar = w.bar;
  (void)hipMemsetAsync(w.bar, 0, XCD_BAR_WORDS * 4, stream);
  hipLaunchKernelGGL(k_mega, dim3(grid_blocks), dim3(512), MK_LDS_TOTAL, stream, p);
}
```

```cpp
#include <hip/hip_runtime.h>
#include <hip/hip_bf16.h>
#include <hip/hip_cooperative_groups.h>
#include <cstdio>
namespace cg = cooperative_groups;
#include <stdint.h>

typedef unsigned short u16;
typedef __attribute__((ext_vector_type(8))) short bf16x8;
typedef __attribute__((ext_vector_type(4))) float f32x4;
typedef __attribute__((ext_vector_type(16))) float f32x16;

#ifndef DUP
#define DUP 0
#endif
#ifndef PROBE
#define PROBE 0
#endif
#define MK_LDS_BYTES 148480
#define PSM(sm) ((sm) + MK_LDS_BYTES + 16)
#ifndef PBLK
#define PBLK 0
#endif
#if PROBE
#define PROBE_INIT(sm) unsigned long long* _pacc = (unsigned long long*)(sm); const bool _pon = (blockIdx.x == PBLK && threadIdx.x == 0); \
   if (_pon) { for (int _i = 0; _i < 31; ++_i) _pacc[_i] = 0ull; _pacc[31] = __builtin_amdgcn_s_memrealtime(); }
#define PROBE_MARK(sm, i) do { unsigned long long* _pa = (unsigned long long*)(sm); if (blockIdx.x == PBLK && threadIdx.x == 0) { \
   const unsigned long long _n = __builtin_amdgcn_s_memrealtime(); _pa[i] += _n - _pa[31]; _pa[31] = _n; } } while (0)
#else
#define PROBE_MARK(sm, i) do {} while (0)
#endif
#define T_TOK 16384
#define SEQ 2048
#define NB 8
#define DM 1024
#define DL 512
#define EPS 1e-6f
#define AIDX(t, k) ((((size_t)((k) >> 6)) * T_TOK + (size_t)(t)) * 64 + ((k) & 63))
#define WIDX(n, k, N) ((((size_t)((k) >> 6)) * (N) + (size_t)(n)) * 64 + ((k) & 63))
#define PEER_SU 256.f
#define PEER_SV 16.f
typedef __attribute__((ext_vector_type(2))) float f32x2;

__device__ __forceinline__ float bf2f(u16 v) { return __uint_as_float(((unsigned)v) << 16); }
__device__ __forceinline__ u16 f2bf(float f) {
  unsigned u = __float_as_uint(f);
  u += 0x7fffu + ((u >> 16) & 1u);
  return (u16)(u >> 16);
}
__device__ __forceinline__ float frcp(float x) { return __builtin_amdgcn_rcpf(x); }
__device__ __forceinline__ float sigmoidf_(float x) { return frcp(1.f + __expf(-x)); }
__device__ __forceinline__ float gelu_tanh(float x) {
  float u = 0.7978845608028654f * (x + 0.044715f * x * x * x);
  float e = __expf(2.f * u);
  float th = 1.f - 2.f * frcp(e + 1.f);
  return 0.5f * x * (1.f + th);
}
__device__ __forceinline__ float log_sigmoidf_(float x) {
  return fminf(x, 0.f) - log1pf(__expf(-fabsf(x)));
}
__device__ __forceinline__ int tid_fresh() { int t = threadIdx.x; asm volatile("" : "+v"(t)); return t; }
__device__ __forceinline__ float sum_grp16(float v) {
  v += __int_as_float(__builtin_amdgcn_update_dpp(0, __float_as_int(v), 0xB1, 0xF, 0xF, true));
  v += __int_as_float(__builtin_amdgcn_update_dpp(0, __float_as_int(v), 0x4E, 0xF, 0xF, true));
  v += __int_as_float(__builtin_amdgcn_update_dpp(0, __float_as_int(v), 0x141, 0xF, 0xF, true));
  v += __int_as_float(__builtin_amdgcn_update_dpp(0, __float_as_int(v), 0x140, 0xF, 0xF, true));
  return v;
}
__device__ __forceinline__ float sum_grp32(float v) {
  v = sum_grp16(v);
  auto a = __builtin_amdgcn_permlane16_swap(__float_as_int(v), __float_as_int(v), false, false);
  return __int_as_float(a[0]) + __int_as_float(a[1]);
}
__device__ __forceinline__ float wave_sum(float v) {
  v = sum_grp32(v);
  auto b = __builtin_amdgcn_permlane32_swap(__float_as_int(v), __float_as_int(v), false, false);
  return __int_as_float(b[0]) + __int_as_float(b[1]);
}

struct WS {
  u16* xb;
  float* rs0;
  u16* WinT;
  u16* WoutT;
  u16* WqT;
  u16* keysb;
  u16* Wg;
  u16* Ub;
  u16* Vb;
  u16* xl;
  u16* gg;
  u16* glu;
  u16* y;
  float* ssq_lru;
  float* ssq_h1;
  unsigned* cand;
  u16* h1b;
  float* tmp_a;
  float* tmp_b;
  u16* sel_e;
  float* wgt;
  float* ssq_out;
  unsigned* bar;
  float* gate;
  float* rs2v;
  unsigned* part;
};

static WS make_ws(void* d_ws) {
  char* p = (char*)d_ws;
  WS w;
  size_t off = 0;
  auto take = [&](size_t bytes) { char* r = p + off; off += (bytes + 255) & ~(size_t)255; return r; };
  w.xb = (u16*)take((size_t)T_TOK * 1024 * 2);
  w.rs0 = (float*)take((size_t)T_TOK * 4);
  w.WinT = (u16*)take((size_t)2048 * 1024 * 2);
  w.WoutT = (u16*)take((size_t)1024 * 1024 * 2);
  w.WqT = (u16*)take((size_t)2048 * 1024 * 2);
  w.keysb = (u16*)take((size_t)16 * 128 * 128 * 2);
  w.Wg = (u16*)take((size_t)2 * 8 * 4 * 32 * 64 * 2);
  w.Ub = (u16*)take((size_t)16384 * 1024 * 2);
  w.Vb = (u16*)take((size_t)16384 * 1024 * 2);
  w.xl = (u16*)take((size_t)T_TOK * 512 * 2);
  w.gg = (u16*)take((size_t)T_TOK * 512 * 2);
  w.glu = (u16*)take((size_t)T_TOK * 512 * 2);
  w.y = (u16*)take((size_t)T_TOK * 1024 * 2);
  w.ssq_lru = (float*)take((size_t)T_TOK * 32 * 4);
  w.ssq_h1 = (float*)take((size_t)T_TOK * 16 * 4);
  w.sel_e = (u16*)take((size_t)T_TOK * 128 * 2);
  w.wgt = (float*)take((size_t)T_TOK * 128 * 4);
  w.ssq_out = (float*)take((size_t)T_TOK * 16 * 4);
  w.bar = (unsigned*)take(4096 * 4);
  w.gate = (float*)take((size_t)T_TOK * 128 * 4);
  w.rs2v = (float*)take((size_t)T_TOK * 4);
  w.part = (unsigned*)w.xl;
  w.cand = (unsigned*)w.xl;
  w.h1b = w.xb;
  w.tmp_a = (float*)w.Ub;
  w.tmp_b = (float*)w.Vb;
  return w;
}


__device__ __forceinline__ int win_orig_col(int np) {
  if (np < 1024) return np;
  int r = (np - 1024) >> 6, i = (np - 1024) & 63;
  return (i < 32) ? (1024 + 32 * r + i) : (1536 + 32 * r + (i - 32));
}


__device__ __forceinline__ void load_rows8(const u16* __restrict__ A, int t0, float* xs) {
  for (int i = threadIdx.x; i < 8 * 1024; i += 256) xs[i] = bf2f(A[(size_t)t0 * 1024 + i]);
  __syncthreads();
}
__device__ __forceinline__ void dot8(const u16* __restrict__ wrow, const float* xs, int kbeg, int kend, float acc[8]) {
  for (int k = kbeg; k < kend; k += 8) {
    uint4 wv = *(const uint4*)(wrow + k);
    float wf[8];
    wf[0] = __uint_as_float(wv.x << 16); wf[1] = __uint_as_float(wv.x & 0xffff0000u);
    wf[2] = __uint_as_float(wv.y << 16); wf[3] = __uint_as_float(wv.y & 0xffff0000u);
    wf[4] = __uint_as_float(wv.z << 16); wf[5] = __uint_as_float(wv.z & 0xffff0000u);
    wf[6] = __uint_as_float(wv.w << 16); wf[7] = __uint_as_float(wv.w & 0xffff0000u);
#pragma unroll
    for (int r = 0; r < 8; ++r) {
      const float* xr = xs + r * 1024 + k;
      float a = acc[r];
#pragma unroll
      for (int j = 0; j < 8; ++j) a += wf[j] * xr[j];
      acc[r] = a;
    }
  }
}


__device__ __forceinline__ float rs2_of(const float* ssq_h1, int t) {
  float s = 0.f;
  for (int j = 0; j < 16; ++j) s += ssq_h1[(size_t)t * 16 + j];
  return rsqrtf(s * (1.f / 1024.f) + EPS);
}


#define GEMM_BUF_BYTES 49152
#define GEMM_LDS_BYTES (2 * GEMM_BUF_BYTES)

__device__ __forceinline__ int swz_off(int row, int c) { return row * 128 + ((c ^ ((row >> 1) & 7)) << 4); }

typedef __attribute__((ext_vector_type(4))) unsigned int u32x4;
#define G_LOAD(P, k0) do { \
  P##a0 = *(const u32x4*)(Ap + (size_t)0 * 64 * 1024 + (k0)); P##a1 = *(const u32x4*)(Ap + (size_t)1 * 64 * 1024 + (k0)); \
  P##a2 = *(const u32x4*)(Ap + (size_t)2 * 64 * 1024 + (k0)); P##a3 = *(const u32x4*)(Ap + (size_t)3 * 64 * 1024 + (k0)); \
  P##b0 = *(const u32x4*)(Bp + (size_t)0 * 64 * 1024 + (k0)); P##b1 = *(const u32x4*)(Bp + (size_t)1 * 64 * 1024 + (k0)); } while (0)
#define G_STORE(P, As_) do { char* _As = (As_); char* _Bs = _As + 32768; \
  *(u32x4*)(_As + swz_off(srow + 0, sc)) = P##a0; *(u32x4*)(_As + swz_off(srow + 64, sc)) = P##a1; \
  *(u32x4*)(_As + swz_off(srow + 128, sc)) = P##a2; *(u32x4*)(_As + swz_off(srow + 192, sc)) = P##a3; \
  *(u32x4*)(_Bs + swz_off(srow + 0, sc)) = P##b0; *(u32x4*)(_Bs + swz_off(srow + 64, sc)) = P##b1; } while (0)
__device__ __forceinline__ void g_mma(const char* As, int wm, int wn, int lane, f32x16 (&acc)[2][2]) {
  const char* Bs = As + 32768;
#pragma unroll
  for (int ks = 0; ks < 4; ++ks) {
    const int c = ks * 2 + (lane >> 5);
    bf16x8 af[2], bfr[2];
#pragma unroll
    for (int mi = 0; mi < 2; ++mi) af[mi] = *(const bf16x8*)(As + swz_off(wm * 64 + mi * 32 + (lane & 31), c));
#pragma unroll
    for (int ni = 0; ni < 2; ++ni) bfr[ni] = *(const bf16x8*)(Bs + swz_off(wn * 64 + ni * 32 + (lane & 31), c));
#pragma unroll
    for (int mi = 0; mi < 2; ++mi)
#pragma unroll
      for (int ni = 0; ni < 2; ++ni)
        acc[mi][ni] = __builtin_amdgcn_mfma_f32_32x32x16_bf16(af[mi], bfr[ni], acc[mi][ni], 0, 0, 0);
  }
}

#define GEMM_STAGE_BYTES 49152
#define GEMM3_LDS_BYTES (3 * GEMM_STAGE_BYTES)
template <bool RESCALE, int NBT>
__device__ __forceinline__ void gemm_core(const u16* __restrict__ A, const u16* __restrict__ Bt, int m0, int n0,
                                          char* smem, f32x16 (&acc)[2][2], const float* rls, int koff = 0) {
  const int tid = tid_fresh(), lane = tid & 63, wid = tid >> 6;
  const int wm = wid >> 1, wn = wid & 1;
  const int srow = tid >> 3, pos = tid & 7;
  const int csrc = pos ^ ((srow >> 1) & 7);
  const u16* Ap = A + (size_t)(m0 + srow) * 64 + csrc * 8;
  const u16* Bp = Bt + (size_t)(n0 + srow) * 64 + csrc * 8;
  const size_t ksA = (size_t)T_TOK * 64, ksB = (size_t)NBT * 64;
  char* wbase = smem + wid * 1024;
  asm volatile("" : "+v"(acc[0][0]), "+v"(acc[0][1]), "+v"(acc[1][0]), "+v"(acc[1][1]));
  __builtin_amdgcn_sched_barrier(0);
#define G_DMA(stage, kt_) do { const int _kt = (((kt_) + koff) & 15); char* _sb = wbase + (stage) * GEMM_STAGE_BYTES; \
    const u16* _a = Ap + _kt * ksA; const u16* _b = Bp + _kt * ksB; \
    __builtin_amdgcn_global_load_lds((const unsigned*)(_a + 0 * 4096), (unsigned*)(_sb + 0 * 8192), 16, 0, 0); \
    __builtin_amdgcn_global_load_lds((const unsigned*)(_a + 1 * 4096), (unsigned*)(_sb + 1 * 8192), 16, 0, 0); \
    __builtin_amdgcn_global_load_lds((const unsigned*)(_a + 2 * 4096), (unsigned*)(_sb + 2 * 8192), 16, 0, 0); \
    __builtin_amdgcn_global_load_lds((const unsigned*)(_a + 3 * 4096), (unsigned*)(_sb + 3 * 8192), 16, 0, 0); \
    __builtin_amdgcn_global_load_lds((const unsigned*)(_b + 0 * 4096), (unsigned*)(_sb + 32768 + 0 * 8192), 16, 0, 0); \
    __builtin_amdgcn_global_load_lds((const unsigned*)(_b + 1 * 4096), (unsigned*)(_sb + 32768 + 1 * 8192), 16, 0, 0); } while (0)
  G_DMA(0, 0);
  G_DMA(1, 1);
  int st = 0;
#pragma unroll 1
  for (int kt = 0; kt < 16; ++kt) {
    if (kt < 15) asm volatile("s_waitcnt vmcnt(6)" ::: "memory");
    else asm volatile("s_waitcnt vmcnt(0)" ::: "memory");
    asm volatile("s_waitcnt lgkmcnt(0)" ::: "memory");
    __builtin_amdgcn_s_barrier();
    if (kt + 2 < 16) { const int st2 = (st >= 1) ? st - 1 : st + 2; G_DMA(st2, kt + 2); }
    if (RESCALE && kt == 8) {
#pragma unroll
      for (int mi = 0; mi < 2; ++mi)
#pragma unroll
        for (int r = 0; r < 16; ++r) {
          const float s = rls[wm * 64 + mi * 32 + (r & 3) + 8 * (r >> 2) + 4 * (lane >> 5)];
          acc[mi][0][r] *= s; acc[mi][1][r] *= s;
        }
    }
    g_mma(smem + st * GEMM_STAGE_BYTES, wm, wn, lane, acc);
    st = (st == 2) ? 0 : st + 1;
  }
#undef G_DMA
  __syncthreads();
}

#define G256_STAGE_BYTES 32768
#define G256_LDS_BYTES (4 * G256_STAGE_BYTES)
__device__ __forceinline__ int swz64(int row, int c) { return row * 64 + ((c ^ ((row >> 2) & 3)) << 4); }
template <bool RESCALE, int NBT>
__device__ __forceinline__ void gemm_core256(const u16* __restrict__ A, const u16* __restrict__ Bt, int m0, int n0,
                                             char* smem, f32x16 (&acc)[4][2], const float* rls) {
  const int tid = tid_fresh(), lane = tid & 63, wid = tid >> 6;
  const int wm = wid >> 2, wn = wid & 3;
  const int rowi = wid * 16 + (lane >> 2);
  const int csrc = (lane & 3) ^ ((lane >> 4) & 3);
  const u16* Ap = A + (size_t)(m0 + rowi) * 64 + csrc * 8;
  const u16* Bp = Bt + (size_t)(n0 + rowi) * 64 + csrc * 8;
  const size_t ksA = (size_t)T_TOK * 64, ksB = (size_t)NBT * 64;
  char* wbase = smem + wid * 1024;
  asm volatile("" : "+v"(acc[0][0]), "+v"(acc[0][1]), "+v"(acc[1][0]), "+v"(acc[1][1]), "+v"(acc[2][0]), "+v"(acc[2][1]), "+v"(acc[3][0]), "+v"(acc[3][1]));
  __builtin_amdgcn_sched_barrier(0);
#define G2_DMA(s_) do { const int _s = (s_); char* _sb = wbase + (_s & 3) * G256_STAGE_BYTES; \
    const u16* _a = Ap + (_s >> 1) * ksA + (_s & 1) * 32; const u16* _b = Bp + (_s >> 1) * ksB + (_s & 1) * 32; \
    __builtin_amdgcn_global_load_lds((const unsigned*)(_a), (unsigned*)(_sb), 16, 0, 0); \
    __builtin_amdgcn_global_load_lds((const unsigned*)(_a + 8192), (unsigned*)(_sb + 8192), 16, 0, 0); \
    __builtin_amdgcn_global_load_lds((const unsigned*)(_b), (unsigned*)(_sb + 16384), 16, 0, 0); \
    __builtin_amdgcn_global_load_lds((const unsigned*)(_b + 8192), (unsigned*)(_sb + 16384 + 8192), 16, 0, 0); } while (0)
  G2_DMA(0);
  G2_DMA(1);
  G2_DMA(2);
#pragma unroll 1
  for (int s = 0; s < 32; ++s) {
    if (s < 30) asm volatile("s_waitcnt vmcnt(8)" ::: "memory");
    else if (s == 30) asm volatile("s_waitcnt vmcnt(4)" ::: "memory");
    else asm volatile("s_waitcnt vmcnt(0)" ::: "memory");
    asm volatile("s_waitcnt lgkmcnt(0)" ::: "memory");
    __builtin_amdgcn_s_barrier();
    if (s + 3 < 32) G2_DMA(s + 3);
    if (RESCALE && s == 16) {
#pragma unroll
      for (int mi = 0; mi < 4; ++mi)
#pragma unroll
        for (int r = 0; r < 16; ++r) {
          const float sc = rls[wm * 128 + mi * 32 + (r & 3) + 8 * (r >> 2) + 4 * (lane >> 5)];
          acc[mi][0][r] *= sc; acc[mi][1][r] *= sc;
        }
    }
    const char* As = smem + (s & 3) * G256_STAGE_BYTES;
    const char* Bs = As + 16384;
#pragma unroll
    for (int ks = 0; ks < 2; ++ks) {
      const int c = ks * 2 + (lane >> 5);
      bf16x8 af[4], bfr[2];
#pragma unroll
      for (int mi = 0; mi < 4; ++mi) af[mi] = *(const bf16x8*)(As + swz64(wm * 128 + mi * 32 + (lane & 31), c));
#pragma unroll
      for (int ni = 0; ni < 2; ++ni) bfr[ni] = *(const bf16x8*)(Bs + swz64(wn * 64 + ni * 32 + (lane & 31), c));
#pragma unroll
      for (int mi = 0; mi < 4; ++mi)
#pragma unroll
        for (int ni = 0; ni < 2; ++ni)
          acc[mi][ni] = __builtin_amdgcn_mfma_f32_32x32x16_bf16(af[mi], bfr[ni], acc[mi][ni], 0, 0, 0);
    }
  }
#undef G2_DMA
  __syncthreads();
}

__device__ __forceinline__ void zero_acc(f32x16 (&acc)[2][2]) {
#pragma unroll
  for (int mi = 0; mi < 2; ++mi)
#pragma unroll
    for (int ni = 0; ni < 2; ++ni)
#pragma unroll
      for (int r = 0; r < 16; ++r) acc[mi][ni][r] = 0.f;
}

__device__ __forceinline__ void p1_tile(const WS& w, int tile, int nblk_g, char* smem) {
  const int it = tile >> 8, b = tile & 255, g = b & 7, j = b >> 3;
  const int mt = it * 32 + g * 4 + (j >> 3), nt = j & 7;
  const int m0 = mt * 256, n0 = nt * 256;
  f32x16 acc[4][2];
#pragma unroll
  for (int mi = 0; mi < 4; ++mi)
#pragma unroll
    for (int ni = 0; ni < 2; ++ni)
#pragma unroll
      for (int r = 0; r < 16; ++r) acc[mi][ni][r] = 0.f;
  gemm_core256<false, 2048>(w.xb, w.WinT, m0, n0, smem, acc, nullptr);
  const int tidf = tid_fresh(); const int lane = tidf & 63, wid = tidf >> 6, wm = wid >> 2, wn = wid & 3;
  const int nb = n0 + wn * 64;
  const int rowb = m0 + wm * 128 + 4 * (lane >> 5);
#pragma unroll
  for (int mi = 0; mi < 4; ++mi) {
    float rs[16];
#pragma unroll
    for (int r = 0; r < 16; ++r) rs[r] = w.rs0[rowb + mi * 32 + (r & 3) + 8 * (r >> 2)];
    if (nb < 512) {
#pragma unroll
      for (int r = 0; r < 16; ++r) {
        const int row = rowb + mi * 32 + (r & 3) + 8 * (r >> 2);
#pragma unroll
        for (int ni = 0; ni < 2; ++ni) w.xl[(size_t)row * 512 + nb + ni * 32 + (lane & 31)] = f2bf(rs[r] * acc[mi][ni][r]);
      }
    } else if (nb < 1024) {
#pragma unroll
      for (int r = 0; r < 16; ++r) {
        const int row = rowb + mi * 32 + (r & 3) + 8 * (r >> 2);
#pragma unroll
        for (int ni = 0; ni < 2; ++ni) w.gg[(size_t)row * 512 + (nb - 512) + ni * 32 + (lane & 31)] = f2bf(gelu_tanh(rs[r] * acc[mi][ni][r]));
      }
    } else {
      const int ch = ((nb - 1024) >> 6) * 32 + (lane & 31);
#pragma unroll
      for (int r = 0; r < 16; ++r) {
        const int row = rowb + mi * 32 + (r & 3) + 8 * (r >> 2);
        const float a = rs[r] * acc[mi][0][r], bb = rs[r] * acc[mi][1][r];
        w.glu[(size_t)row * 512 + ch] = f2bf(a * sigmoidf_(bb));
      }
    }
  }
}
__device__ __forceinline__ void p3_tile(const WS& w, const float* __restrict__ x, float* __restrict__ h1, int tile, char* smem) {
  const int b = tile & 255, g = b & 7, j = b >> 3;
  const int mt = (tile >> 8) * 64 + g * 8 + (j >> 2), nt = j & 3;
  const int m0 = mt * 256, n0 = nt * 256;
  const int tidf = tid_fresh(); const int lane = tidf & 63, wid = tidf >> 6, wm = wid >> 2, wn = wid & 3;
  float* rls = (float*)(smem + G256_LDS_BYTES);
  if (tidf < 256) {
    const float4* p = (const float4*)(w.ssq_lru + (size_t)(m0 + tidf) * 32);
    float s = 0.f;
#pragma unroll
    for (int i = 0; i < 8; ++i) { float4 v = p[i]; s += v.x + v.y + v.z + v.w; }
    rls[tidf] = rsqrtf(s * (1.f / 512.f) + EPS);
  }
  f32x16 acc[4][2];
#pragma unroll
  for (int mi = 0; mi < 4; ++mi)
#pragma unroll
    for (int ni = 0; ni < 2; ++ni)
#pragma unroll
      for (int r = 0; r < 16; ++r) acc[mi][ni][r] = 0.f;
  gemm_core256<true, 1024>(w.y, w.WoutT, m0, n0, smem, acc, rls);
  const size_t ob = (size_t)(m0 + wm * 128 + 4 * (lane >> 5)) * 1024 + n0 + wn * 64 + (lane & 31);
#pragma unroll
  for (int mi = 0; mi < 4; ++mi) {
    float xr[2][16];
#pragma unroll
    for (int r = 0; r < 16; ++r)
#pragma unroll
      for (int ni = 0; ni < 2; ++ni) xr[ni][r] = x[ob + (size_t)(mi * 32 + (r & 3) + 8 * (r >> 2)) * 1024 + ni * 32];
#pragma unroll
    for (int r = 0; r < 16; ++r) {
      const int row = m0 + wm * 128 + mi * 32 + (r & 3) + 8 * (r >> 2) + 4 * (lane >> 5);
      float ss = 0.f;
#pragma unroll
      for (int ni = 0; ni < 2; ++ni) {
        const int col = n0 + wn * 64 + ni * 32 + (lane & 31);
        const float hv = xr[ni][r] + acc[mi][ni][r];
        h1[(size_t)row * 1024 + col] = hv;
        w.h1b[AIDX(row, col)] = f2bf(hv);
        ss += hv * hv;
      }
      ss = sum_grp32(ss);
      if ((lane & 31) == 0) w.ssq_h1[(size_t)row * 16 + nt * 4 + wn] = ss;
    }
  }
  __syncthreads();
}

__device__ __forceinline__ int swz256(int row, int c) { return row * 256 + ((c ^ (row & 15)) << 4); }

__device__ __forceinline__ void cmpswap_desc(float& a, float& b) { float mx = fmaxf(a, b), mn = fminf(a, b); a = mx; b = mn; }

__device__ __forceinline__ void p4_tile(const WS& w, int tile, char* smem) {
  const int it = tile >> 8, b = tile & 255, g = b & 7, j = b >> 3;
  const int mt = it * 16 + g * 2 + (j >> 4), hp = j & 15;
  const int m0 = mt * 256, n0 = hp * 128;
  const int tid = tid_fresh(), lane = tid & 63, wid = tid >> 6, wm = wid >> 1, wn = wid & 1;
  float* rls = (float*)(smem + GEMM3_LDS_BYTES);
  if (tid < 256) {
    const float4* p = (const float4*)(w.ssq_h1 + (size_t)(m0 + tid) * 16);
    float s = 0.f;
#pragma unroll
    for (int i = 0; i < 4; ++i) { float4 v = p[i]; s += v.x + v.y + v.z + v.w; }
    rls[tid] = rsqrtf(s * (1.f / 1024.f) + EPS);
  }
  f32x16 acc[2][2];
  zero_acc(acc);
  gemm_core<false, 2048>(w.h1b, w.WqT, m0, n0, smem, acc, nullptr, hp);
  PROBE_MARK(PSM(smem), 13);
  char* qs = smem;
  char* ksm = smem + 65536;
  {
#pragma unroll
  for (int mi = 0; mi < 2; ++mi)
#pragma unroll
    for (int r = 0; r < 16; ++r) {
      const int row = wm * 64 + mi * 32 + (r & 3) + 8 * (r >> 2) + 4 * (lane >> 5);
      const float rs = rls[row];
#pragma unroll
      for (int ni = 0; ni < 2; ++ni) {
        const int col = wn * 64 + ni * 32 + (lane & 31);
        *(u16*)(qs + swz256(row, col >> 3) + (col & 7) * 2) = f2bf(rs * acc[mi][ni][r]);
      }
    }
  {
    const u16* kp = w.keysb + (size_t)hp * 128 * 128;
#pragma unroll
    for (int i = 0; i < 4; ++i) {
      const int q = tid + 512 * i, row = q >> 4, c = q & 15;
      *(uint4*)(ksm + swz256(row, c)) = *(const uint4*)(kp + row * 128 + c * 8);
    }
  }
  __syncthreads();
  }
  PROBE_MARK(PSM(smem), 14);
  f32x16 sacc[4];
  {
#pragma unroll
  for (int ni = 0; ni < 4; ++ni)
#pragma unroll
    for (int r = 0; r < 16; ++r) sacc[ni][r] = 0.f;
#pragma unroll
  for (int ks = 0; ks < 8; ++ks) {
    const int c = ks * 2 + (lane >> 5);
    bf16x8 af = *(const bf16x8*)(qs + swz256(wid * 32 + (lane & 31), c));
#pragma unroll
    for (int ni = 0; ni < 4; ++ni) {
      bf16x8 bfr = *(const bf16x8*)(ksm + swz256(ni * 32 + (lane & 31), c));
      sacc[ni] = __builtin_amdgcn_mfma_f32_32x32x16_bf16(af, bfr, sacc[ni], 0, 0, 0);
    }
  }
  }
  PROBE_MARK(PSM(smem), 15);
  {
    const int l31 = lane & 31;
    int v0[16], v1[16], v2[16], v3[16], res[16];
#pragma unroll
    for (int r = 0; r < 16; ++r) {
      int k0 = (int)((__float_as_uint(sacc[0][r]) & ~127u) | (unsigned)(l31));
      int k1 = (int)((__float_as_uint(sacc[1][r]) & ~127u) | (unsigned)(32 + l31));
      int k2 = (int)((__float_as_uint(sacc[2][r]) & ~127u) | (unsigned)(64 + l31));
      int k3 = (int)((__float_as_uint(sacc[3][r]) & ~127u) | (unsigned)(96 + l31));
      k0 ^= (k0 >> 31) & 0x7fffffff; k1 ^= (k1 >> 31) & 0x7fffffff;
      k2 ^= (k2 >> 31) & 0x7fffffff; k3 ^= (k3 >> 31) & 0x7fffffff;
      int t;
      t = max(k0, k1); k1 = min(k0, k1); k0 = t;
      t = max(k2, k3); k3 = min(k2, k3); k2 = t;
      t = max(k0, k2); k2 = min(k0, k2); k0 = t;
      t = max(k1, k3); k3 = min(k1, k3); k1 = t;
      t = max(k1, k2); k2 = min(k1, k2); k1 = t;
      v0[r] = k0; v1[r] = k1; v2[r] = k2; v3[r] = k3;
      res[r] = (int)0x80000000;
    }
#pragma unroll 1
    for (int jj = 0; jj < 16; ++jj) {
      const int jm = (l31 == jj) ? -1 : 0;
#pragma unroll
      for (int r = 0; r < 16; ++r) {
        int m = v0[r];
        m = max(m, __builtin_amdgcn_update_dpp(0, m, 0xB1, 0xF, 0xF, true));
        m = max(m, __builtin_amdgcn_update_dpp(0, m, 0x4E, 0xF, 0xF, true));
        m = max(m, __builtin_amdgcn_update_dpp(0, m, 0x141, 0xF, 0xF, true));
        m = max(m, __builtin_amdgcn_update_dpp(0, m, 0x140, 0xF, 0xF, true));
        auto sw = __builtin_amdgcn_permlane16_swap(m, m, false, false);
        m = max((int)sw[0], (int)sw[1]);
        const int hm = (v0[r] == m) ? -1 : 0;
        v0[r] ^= (v0[r] ^ v1[r]) & hm;
        v1[r] ^= (v1[r] ^ v2[r]) & hm;
        v2[r] ^= (v2[r] ^ v3[r]) & hm;
        v3[r] ^= (v3[r] ^ (int)0x80000000) & hm;
        res[r] ^= (res[r] ^ m) & jm;
      }
    }
#pragma unroll
    for (int r = 0; r < 16; ++r) {
      const int row = m0 + wid * 32 + (r & 3) + 8 * (r >> 2) + 4 * (lane >> 5);
      const int key = res[r];
      const unsigned pk = (unsigned)(key ^ ((key >> 31) & 0x7fffffff));
      if (l31 < 16) w.cand[((size_t)row * 16 + hp) * 16 + l31] = pk;
    }
  }
  __syncthreads();
  PROBE_MARK(PSM(smem), 16);
}


typedef __attribute__((ext_vector_type(2))) __bf16 bf16x2_t;
__device__ __forceinline__ float dot2bf(unsigned a, unsigned b, float c) {
  return __builtin_amdgcn_fdot2_f32_bf16(__builtin_bit_cast(bf16x2_t, a), __builtin_bit_cast(bf16x2_t, b), c, false);
}
__device__ __forceinline__ float dot8bf(uint4 a, uint4 b, float c) {
  c = dot2bf(a.x, b.x, c); c = dot2bf(a.y, b.y, c); c = dot2bf(a.z, b.z, c); c = dot2bf(a.w, b.w, c);
  return c;
}
__device__ __forceinline__ void axpy8(float (&acc)[8], float wgt, uint4 v) {
  acc[0] += wgt * __uint_as_float(v.x << 16); acc[1] += wgt * __uint_as_float(v.x & 0xffff0000u);
  acc[2] += wgt * __uint_as_float(v.y << 16); acc[3] += wgt * __uint_as_float(v.y & 0xffff0000u);
  acc[4] += wgt * __uint_as_float(v.z << 16); acc[5] += wgt * __uint_as_float(v.z & 0xffff0000u);
  acc[6] += wgt * __uint_as_float(v.w << 16); acc[7] += wgt * __uint_as_float(v.w & 0xffff0000u);
}

__device__ __forceinline__ void p5_route_load(const WS& w, int t, int ca, int cb, unsigned (&pa)[8], unsigned (&pb)[8], float& sq) {
  const int lane = threadIdx.x & 63;
  const unsigned* cp = w.cand + (size_t)t * 256;
#pragma unroll
  for (int h = 0; h < 8; ++h) {
    pa[h] = cp[(2 * h) * 16 + ca];
    pb[h] = cp[(2 * h + 1) * 16 + cb];
  }
  sq = (lane < 16) ? w.ssq_h1[(size_t)t * 16 + lane] : 0.f;
}
__device__ __forceinline__ void p5_route_compute(const WS& w, int t, const unsigned (&pa)[8], const unsigned (&pb)[8], float sq, float* keys  ) {
  const int lane = threadIdx.x & 63;
  float s[8]; int e[8];
#pragma unroll
  for (int h = 0; h < 8; ++h) {
    const float sv = __uint_as_float(pa[h]) + __uint_as_float(pb[h]);
    e[h] = (int)(pa[h] & 127u) * 128 + (int)(pb[h] & 127u);
    s[h] = (lane < 50) ? __uint_as_float((__float_as_uint(sv) & ~63u) | (unsigned)lane) : -3.0e38f;
    keys[h * 64 + lane] = s[h];
  }
  __builtin_amdgcn_fence(__ATOMIC_RELEASE, "wavefront");
  __builtin_amdgcn_wave_barrier();
  __builtin_amdgcn_fence(__ATOMIC_ACQUIRE, "wavefront");
#pragma unroll
  for (int h = 0; h < 8; ++h) {
    int rank = 0;
    const float4* kp = (const float4*)(keys + h * 64);
#pragma unroll
    for (int j4 = 0; j4 < 13; ++j4) {
      const float4 k4 = kp[j4];
      rank += (k4.x > s[h]) ? 1 : 0;
      rank += (k4.y > s[h]) ? 1 : 0;
      if (j4 * 4 + 2 < 50) rank += (k4.z > s[h]) ? 1 : 0;
      if (j4 * 4 + 3 < 50) rank += (k4.w > s[h]) ? 1 : 0;
    }
    const bool sel = (lane < 50) && (rank < 16);
    const unsigned long long top = __ballot(rank == 0 && lane < 50);
    const float mx = __int_as_float(__builtin_amdgcn_readlane(__float_as_int(s[h]), (int)__builtin_ctzll(top)));
    const float ex = sel ? __expf(s[h] - mx) : 0.f;
    const float sum = wave_sum(ex);
    if (sel) {
      w.sel_e[(size_t)t * 128 + ((h * 16 + rank) & 7) * 16 + ((h * 16 + rank) >> 3)] = (u16)e[h];
      w.gate[(size_t)t * 128 + h * 16 + rank] = ex * frcp(sum);
    }
  }
  const float sqs = wave_sum(sq);
  if (lane == 0) w.rs2v[t] = rsqrtf(sqs * (1.f / 1024.f) + EPS);
  __builtin_amdgcn_fence(__ATOMIC_RELEASE, "wavefront");
  __builtin_amdgcn_wave_barrier();
  __builtin_amdgcn_fence(__ATOMIC_ACQUIRE, "wavefront");
}

__device__ __forceinline__ f32x2 fp8lo(unsigned d) { return __builtin_amdgcn_cvt_pk_f32_fp8((int)d, false); }
__device__ __forceinline__ f32x2 fp8hi(unsigned d) { return __builtin_amdgcn_cvt_pk_f32_fp8((int)d, true); }
__device__ __forceinline__ f32x2 bfpair(unsigned d) { f32x2 r; r.x = __uint_as_float(d << 16); r.y = __uint_as_float(d & 0xffff0000u); return r; }

__device__ __forceinline__ unsigned eT_get(const u32x4& a, const u32x4& b, int i) {
  const unsigned wds[8] = {a.x, a.y, a.z, a.w, b.x, b.y, b.z, b.w};
  return (i & 1) ? (wds[i >> 1] >> 16) : (wds[i >> 1] & 0xffffu);
}
__device__ __forceinline__ void eT_load(const WS& w, int t, u32x4& a, u32x4& b) {
  const u32x4* p = (const u32x4*)(w.sel_e + (unsigned)(t * 128 + ((threadIdx.x & 63) >> 3) * 16));
  a = p[0]; b = p[1];
}
__device__ __forceinline__ void u_issue(const WS& w, int t, int s, const u32x4& ea, const u32x4& eb, u32x4 (&u)[16], u32x4& xa, u32x4& xb) {
  const int lane = threadIdx.x & 63;
  const char* ub = (const char*)w.Ub;
  const unsigned uoff = (unsigned)s * (16384u * 128u) + (unsigned)(lane & 7) * 16u;
#pragma unroll
  for (int i = 0; i < 16; ++i) u[i] = *(const u32x4*)(ub + (uoff + eT_get(ea, eb, i) * 128u));
  const u16* xp = w.h1b + AIDX(t, s * 128 + (lane & 7) * 16);
  xa = *(const u32x4*)xp; xb = *(const u32x4*)(xp + 8);
}
__device__ __forceinline__ void u_compute(const WS& w, int t, int s, const u32x4 (&u)[16], const u32x4& xa, const u32x4& xb, bool valid) {
  const int lane = threadIdx.x & 63;
  f32x2 x2[8];
  x2[0] = bfpair(xa.x); x2[1] = bfpair(xa.y); x2[2] = bfpair(xa.z); x2[3] = bfpair(xa.w);
  x2[4] = bfpair(xb.x); x2[5] = bfpair(xb.y); x2[6] = bfpair(xb.z); x2[7] = bfpair(xb.w);
  float p[16];
#pragma unroll
  for (int i = 0; i < 16; ++i) {
    f32x2 a = {0.f, 0.f};
    a = __builtin_elementwise_fma(fp8lo(u[i].x), x2[0], a); a = __builtin_elementwise_fma(fp8hi(u[i].x), x2[1], a);
    a = __builtin_elementwise_fma(fp8lo(u[i].y), x2[2], a); a = __builtin_elementwise_fma(fp8hi(u[i].y), x2[3], a);
    a = __builtin_elementwise_fma(fp8lo(u[i].z), x2[4], a); a = __builtin_elementwise_fma(fp8hi(u[i].z), x2[5], a);
    a = __builtin_elementwise_fma(fp8lo(u[i].w), x2[6], a); a = __builtin_elementwise_fma(fp8hi(u[i].w), x2[7], a);
    p[i] = a.x + a.y;
  }
#pragma unroll
  for (int c = 0; c < 8; ++c) {
    const bool up = (lane & 4) != 0;
    const float send = up ? p[c] : p[c + 8];
    const float keep = up ? p[c + 8] : p[c];
    p[c] = keep + __shfl_xor(send, 4, 64);
  }
#pragma unroll
  for (int c = 0; c < 4; ++c) {
    const bool up = (lane & 2) != 0;
    const float send = up ? p[c] : p[c + 4];
    const float keep = up ? p[c + 4] : p[c];
    p[c] = keep + __shfl_xor(send, 2, 64);
  }
#pragma unroll
  for (int c = 0; c < 2; ++c) {
    const bool up = (lane & 1) != 0;
    const float send = up ? p[c] : p[c + 2];
    const float keep = up ? p[c + 2] : p[c];
    p[c] = keep + __shfl_xor(send, 1, 64);
  }
  const _Float16 h0 = (_Float16)(p[0] * (1.f / PEER_SU)), h1v = (_Float16)(p[1] * (1.f / PEER_SU));
  const unsigned pk = (unsigned)__builtin_bit_cast(unsigned short, h0) | ((unsigned)__builtin_bit_cast(unsigned short, h1v) << 16);
  if (valid) w.part[((size_t)t * 8 + s) * 64 + lane] = pk;
}
__device__ __forceinline__ void u_sweep(const WS& w, int s, int t0, int stride) {
  const int n = (t0 < T_TOK) ? (T_TOK - t0 + stride - 1) / stride : 0;
  if (n <= 0) return;
  const int lane = threadIdx.x & 63;
#define TT(i) (t0 + min((i), n - 1) * stride)
  u32x4 uA[16], uB[16], xaA, xbA, xaB, xbB;
  u32x4 eA0, eA1, eB0, eB1;
  eT_load(w, TT(0), eA0, eA1);
  eT_load(w, TT(1), eB0, eB1);
  u_issue(w, TT(0), s, eA0, eA1, uA, xaA, xbA);
#pragma unroll 1
  for (int i = 0; i < n; i += 2) {
    eT_load(w, TT(i + 2), eA0, eA1);
    u_issue(w, TT(i + 1), s, eB0, eB1, uB, xaB, xbB);
    u_compute(w, TT(i), s, uA, xaA, xbA, i < n);
    eT_load(w, TT(i + 3), eB0, eB1);
    u_issue(w, TT(i + 2), s, eA0, eA1, uA, xaA, xbA);
    u_compute(w, TT(i + 1), s, uB, xaB, xbB, i + 1 < n);
  }
#undef TT
}
__device__ __forceinline__ void p5_token_slice(const WS& w, int t, int s) {
  const int lane = threadIdx.x & 63;
  u32x4 ea, eb; eT_load(w, t, ea, eb);
  u32x4 u[16], xa, xb;
  u_issue(w, t, s, ea, eb, u, xa, xb);
  u_compute(w, t, s, u, xa, xb, true);
}

__device__ __forceinline__ void p5_wphase(const WS& w, int t) {
  const int lane = threadIdx.x & 63;
  float d0 = 0.f, d1 = 0.f;
#pragma unroll
  for (int s = 0; s < 8; ++s) {
    const unsigned pk = w.part[((size_t)t * 8 + s) * 64 + lane];
    d0 += (float)__builtin_bit_cast(_Float16, (unsigned short)(pk & 0xffffu));
    d1 += (float)__builtin_bit_cast(_Float16, (unsigned short)(pk >> 16));
  }
  const float rs2 = w.rs2v[t];
  const int p0 = 16 * (lane & 7) + (lane >> 3), p1 = p0 + 8;
  u16* wq = (u16*)w.wgt;
  wq[(size_t)t * 128 + (p0 & 7) * 16 + (p0 >> 3)] = f2bf(w.gate[(size_t)t * 128 + p0] * gelu_tanh(rs2 * d0));
  wq[(size_t)t * 128 + (p1 & 7) * 16 + (p1 >> 3)] = f2bf(w.gate[(size_t)t * 128 + p1] * gelu_tanh(rs2 * d1));
}

__device__ __forceinline__ int v_col(int s, int lane) {
  return s * 128 + (lane & 7) * 16 + ((lane >> 5) & 1) * 8 + ((lane >> 4) & 1) * 4 + ((lane >> 3) & 1) * 2;
}
__device__ __forceinline__ void wT_load(const WS& w, int t, u32x4& a, u32x4& b) {
  const u32x4* p = (const u32x4*)((const u16*)w.wgt + (unsigned)(t * 128 + ((threadIdx.x & 63) >> 3) * 16));
  a = p[0]; b = p[1];
}
__device__ __forceinline__ void v_issue(const WS& w, int t, int s, const u32x4& ea, const u32x4& eb, u32x4 (&v)[16], float2& hin, const float* h1) {
  const int lane = threadIdx.x & 63;
  const char* vb = (const char*)w.Vb;
  const unsigned voff = (unsigned)s * (16384u * 128u) + (unsigned)(lane & 7) * 16u;
#pragma unroll
  for (int i = 0; i < 16; ++i) v[i] = *(const u32x4*)(vb + (voff + eT_get(ea, eb, i) * 128u));
  hin = *(const float2*)(h1 + (size_t)t * 1024 + v_col(s, lane));
}
__device__ __forceinline__ void v_compute(const WS& w, int t, int s, const u32x4 (&v)[16], const u32x4& wa, const u32x4& wb, float2 hin, float* out, bool valid) {
  const int lane = threadIdx.x & 63;
  float wi[16];
  {
    const unsigned wds[8] = {wa.x, wa.y, wa.z, wa.w, wb.x, wb.y, wb.z, wb.w};
#pragma unroll
    for (int i = 0; i < 16; ++i) wi[i] = __uint_as_float((i & 1) ? (wds[i >> 1] & 0xffff0000u) : (wds[i >> 1] << 16));
  }
  f32x2 a2[8];
#pragma unroll
  for (int c = 0; c < 8; ++c) { a2[c].x = 0.f; a2[c].y = 0.f; }
#pragma unroll
  for (int i = 0; i < 16; ++i) {
    f32x2 wv; wv.x = wi[i]; wv.y = wi[i];
    a2[0] = __builtin_elementwise_fma(fp8lo(v[i].x), wv, a2[0]); a2[1] = __builtin_elementwise_fma(fp8hi(v[i].x), wv, a2[1]);
    a2[2] = __builtin_elementwise_fma(fp8lo(v[i].y), wv, a2[2]); a2[3] = __builtin_elementwise_fma(fp8hi(v[i].y), wv, a2[3]);
    a2[4] = __builtin_elementwise_fma(fp8lo(v[i].z), wv, a2[4]); a2[5] = __builtin_elementwise_fma(fp8hi(v[i].z), wv, a2[5]);
    a2[6] = __builtin_elementwise_fma(fp8lo(v[i].w), wv, a2[6]); a2[7] = __builtin_elementwise_fma(fp8hi(v[i].w), wv, a2[7]);
  }
  float acc[16];
#pragma unroll
  for (int c = 0; c < 8; ++c) { acc[2 * c] = a2[c].x; acc[2 * c + 1] = a2[c].y; }
#pragma unroll
  for (int c = 0; c < 8; ++c) {
    const bool up = (lane & 32) != 0;
    const float send = up ? acc[c] : acc[c + 8];
    const float keep = up ? acc[c + 8] : acc[c];
    acc[c] = keep + __shfl_xor(send, 32, 64);
  }
#pragma unroll
  for (int c = 0; c < 4; ++c) {
    const bool up = (lane & 16) != 0;
    const float send = up ? acc[c] : acc[c + 4];
    const float keep = up ? acc[c + 4] : acc[c];
    acc[c] = keep + __shfl_xor(send, 16, 64);
  }
#pragma unroll
  for (int c = 0; c < 2; ++c) {
    const bool up = (lane & 8) != 0;
    const float send = up ? acc[c] : acc[c + 2];
    const float keep = up ? acc[c + 2] : acc[c];
    acc[c] = keep + __shfl_xor(send, 8, 64);
  }
  const size_t o = (size_t)t * 1024 + v_col(s, lane);
  const float hv0 = hin.x + acc[0] * (1.f / PEER_SV), hv1 = hin.y + acc[1] * (1.f / PEER_SV);
  const float ss = wave_sum(hv0 * hv0 + hv1 * hv1);
  if (valid) {
    *(float2*)(out + o) = make_float2(hv0, hv1);
    if (lane == 0) w.ssq_out[(size_t)t * 16 + s] = ss;
  }
}
__device__ __forceinline__ void v_sweep(const WS& w, int s, int t0, int stride, const float* h1, float* out, bool dry) {
  const int n = (t0 < T_TOK) ? (T_TOK - t0 + stride - 1) / stride : 0;
  if (n <= 0) return;
  const int lane = threadIdx.x & 63;
#define TT(i) (t0 + min((i), n - 1) * stride)
  u32x4 vA[16], vB[16];
  float2 hA, hB;
  u32x4 eA0, eA1, eB0, eB1, wA0, wA1, wB0, wB1;
  eT_load(w, TT(0), eA0, eA1);
  eT_load(w, TT(1), eB0, eB1);
  wT_load(w, TT(0), wA0, wA1);
  v_issue(w, TT(0), s, eA0, eA1, vA, hA, h1);
#pragma unroll 1
  for (int i = 0; i < n; i += 2) {
    eT_load(w, TT(i + 2), eA0, eA1);
    wT_load(w, TT(i + 1), wB0, wB1);
    v_issue(w, TT(i + 1), s, eB0, eB1, vB, hB, h1);
    v_compute(w, TT(i), s, vA, wA0, wA1, hA, out, !dry);
    eT_load(w, TT(i + 3), eB0, eB1);
    wT_load(w, TT(i + 2), wA0, wA1);
    v_issue(w, TT(i + 2), s, eA0, eA1, vA, hA, h1);
    v_compute(w, TT(i + 1), s, vB, wB0, wB1, hB, out, !dry && (i + 1 < n));
  }
#undef TT
}
__device__ __forceinline__ void p6_token_slice(const WS& w, int t, int s, const float* h1, float* out, bool dry = false) {
  const int lane = threadIdx.x & 63;
  u32x4 ea, eb, wa, wb; eT_load(w, t, ea, eb); wT_load(w, t, wa, wb);
  u32x4 v[16]; float2 hin;
  v_issue(w, t, s, ea, eb, v, hin, h1);
  v_compute(w, t, s, v, wa, wb, hin, out, !dry);
}

__device__ __forceinline__ void p7_row(const WS& w, int t, const float* __restrict__ gF, float* out, bool dry = false) {
  const int lane = threadIdx.x & 63;
  float s = (lane < 8) ? w.ssq_out[(size_t)t * 16 + lane] : 0.f;
  s = wave_sum(s);
  const float rn = rsqrtf(s * (1.f / 1024.f) + EPS);
  float4* orow = (float4*)(out + (size_t)t * 1024);
#pragma unroll
  for (int i = 0; i < 4; ++i) {
    float4 v = orow[i * 64 + lane];
    const float4 g = ((const float4*)gF)[i * 64 + lane];
    v.x *= rn * g.x; v.y *= rn * g.y; v.z *= rn * g.z; v.w *= rn * g.w;
    if (dry) { asm volatile("" :: "v"(v.x), "v"(v.y), "v"(v.z), "v"(v.w)); continue; }
    orow[i * 64 + lane] = v;
  }
}

__device__ __forceinline__ void staircase_ab(int lane, int& ca, int& cb) {
  ca = 0; cb = 0;
  int cnt = 0;
  for (int a = 0; a < 16; ++a) {
    const int nb = 16 / (a + 1);
    if (lane >= cnt && lane < cnt + nb) { ca = a; cb = lane - cnt; }
    cnt += nb;
  }
}


struct UvJob { const float* U; const float* V; const float* g2; u16* Ub; u16* Vb; size_t i0; size_t stride; };
#define UV_N4 ((size_t)16384 * 256)
__device__ __forceinline__ void uv_store(const UvJob& J, size_t i, const float4& u, const float4& v, const float4& g) {
  const int e = (int)(i >> 8), col = (int)(i & 255) * 4;
  const float cu = 448.f;
  const float ux = fminf(fmaxf(u.x * g.x * PEER_SU, -cu), cu), uy = fminf(fmaxf(u.y * g.y * PEER_SU, -cu), cu);
  const float uz = fminf(fmaxf(u.z * g.z * PEER_SU, -cu), cu), uw = fminf(fmaxf(u.w * g.w * PEER_SU, -cu), cu);
  const float vx = fminf(fmaxf(v.x * PEER_SV, -cu), cu), vy = fminf(fmaxf(v.y * PEER_SV, -cu), cu);
  const float vz = fminf(fmaxf(v.z * PEER_SV, -cu), cu), vw = fminf(fmaxf(v.w * PEER_SV, -cu), cu);
  int pu = __builtin_amdgcn_cvt_pk_fp8_f32(ux, uy, 0, false);
  pu = __builtin_amdgcn_cvt_pk_fp8_f32(uz, uw, pu, true);
  int pv = __builtin_amdgcn_cvt_pk_fp8_f32(vx, vy, 0, false);
  pv = __builtin_amdgcn_cvt_pk_fp8_f32(vz, vw, pv, true);
  const size_t so = ((size_t)(col >> 7) * 16384 + e) * 128 + (col & 127);
  *(int*)((char*)J.Ub + so) = pu;
  *(int*)((char*)J.Vb + so) = pv;
}

#define LRU_XCT 0
#define LRU_GX 32768
#define LRU_HF (32768 + 33792)
#define LRU_SUM (LRU_HF + 65536)
#define LRU_CARRY (LRU_SUM + 4096)
#define LRU_GGT (LRU_CARRY + 128)
#define LRU_LDS_BYTES (LRU_GGT + 8192)

struct LruParams {
  const float* cw; const float* cb; const float* b_rg; const float* b_ig; const float* lam;
};

template <int DIR>
__device__ __forceinline__ void lru_pass(const WS& w, const LruParams& P, int b, int hh, int qq, char* smem, const UvJob& J, int& uvk) {
  const int tid = tid_fresh(), lane = tid & 63, wid = tid >> 6;
  char* xct = smem + LRU_XCT;
  char* gx = smem + LRU_GX;
  float* Gt = (float*)(smem + LRU_GX);
  u16* hf = (u16*)(smem + LRU_HF);
  float* sumA = (float*)(smem + LRU_SUM);
  float* sumB = sumA + 512;
  float* carry = (float*)(smem + LRU_CARRY);
  bf16x8 bw[4];
  {
    const u16* wg = w.Wg + (((size_t)DIR * 8 + hh) * 4 + qq) * 32 * 64;
#pragma unroll
    for (int ks = 0; ks < 4; ++ks) bw[ks] = *(const bf16x8*)(wg + (lane & 31) * 64 + ks * 16 + 8 * (lane >> 5));
  }
  const int s_sub = tid >> 4, ch = tid & 15;
  const int cglob = hh * 64 + qq * 16 + ch;
  const float br = P.b_rg[DIR * 512 + cglob], bi = P.b_ig[DIR * 512 + cglob];
  const float Kc = 8.f * log_sigmoidf_(P.lam[DIR * 512 + cglob]);
  const int cp = tid & 31, rr = tid >> 5;
  float cw0[4], cw1[4];
#pragma unroll
  for (int k = 0; k < 4; ++k) { cw0[k] = P.cw[k * 512 + hh * 64 + 2 * cp]; cw1[k] = P.cw[k * 512 + hh * 64 + 2 * cp + 1]; }
  const float cb0 = P.cb[hh * 64 + 2 * cp], cb1 = P.cb[hh * 64 + 2 * cp + 1];
  if (tid < 16) carry[tid] = 0.f;
  u16* ggt = (u16*)(smem + LRU_GGT);
  u32x4 pf0, pf1, pf2, pf3, pf4, pgg;
  const u16* xlb = w.xl + (size_t)b * SEQ * 512 + hh * 64 + (tid & 7) * 8;
  const u16* ggb = w.gg + (size_t)b * SEQ * 512 + hh * 64 + qq * 16 + (tid & 1) * 8;
#define LRU_PF(c_) do { const int _s0 = (c_) * 256 - 2 + (tid >> 3); \
    pf0 = *(const u32x4*)(xlb + (size_t)min(max(_s0, 0), SEQ - 1) * 512); \
    pf1 = *(const u32x4*)(xlb + (size_t)min(max(_s0 + 64, 0), SEQ - 1) * 512); \
    pf2 = *(const u32x4*)(xlb + (size_t)min(max(_s0 + 128, 0), SEQ - 1) * 512); \
    pf3 = *(const u32x4*)(xlb + (size_t)min(max(_s0 + 192, 0), SEQ - 1) * 512); \
    pf4 = *(const u32x4*)(xlb + (size_t)min(max(_s0 + 256, 0), SEQ - 1) * 512); \
    if (DIR == 1) pgg = *(const u32x4*)(ggb + (size_t)((c_) * 256 + (tid >> 1)) * 512); } while (0)
  LRU_PF(DIR ? 7 : 0);

  for (int cs = 0; cs < 8; ++cs) {
    const int chunk = DIR ? (7 - cs) : cs;
    const int s0 = chunk * 256;
    {
      const u32x4 z = {0u, 0u, 0u, 0u};
      const int r0 = tid >> 3, c = tid & 7;
      const int sp0 = s0 - 2 + r0;
      *(u32x4*)(gx + (r0) * 128 + c * 16) = (sp0 >= 0 && sp0 < SEQ) ? pf0 : z;
      *(u32x4*)(gx + (r0 + 64) * 128 + c * 16) = (sp0 + 64 >= 0 && sp0 + 64 < SEQ) ? pf1 : z;
      *(u32x4*)(gx + (r0 + 128) * 128 + c * 16) = (sp0 + 128 >= 0 && sp0 + 128 < SEQ) ? pf2 : z;
      *(u32x4*)(gx + (r0 + 192) * 128 + c * 16) = (sp0 + 192 >= 0 && sp0 + 192 < SEQ) ? pf3 : z;
      if (r0 + 256 < 259) *(u32x4*)(gx + (r0 + 256) * 128 + c * 16) = (sp0 + 256 >= 0 && sp0 + 256 < SEQ) ? pf4 : z;
      if (DIR == 1) *(u32x4*)((char*)ggt + (tid >> 1) * 32 + (tid & 1) * 16) = pgg;
      const int cn = DIR ? max(6 - cs, 0) : min(cs + 1, 7);
      LRU_PF(cn);
    }
    const size_t ja = J.i0 + (size_t)uvk * J.stride, jb = ja + J.stride;
    const size_t jac = ja < UV_N4 ? ja : 0, jbc = jb < UV_N4 ? jb : 0;
    const float4 juA = ((const float4*)J.U)[jac], jvA = ((const float4*)J.V)[jac], jgA = ((const float4*)J.g2)[jac & 255];
    const float4 juB = ((const float4*)J.U)[jbc], jvB = ((const float4*)J.V)[jbc], jgB = ((const float4*)J.g2)[jbc & 255];
    __syncthreads();
    {
      const unsigned* gxi = (const unsigned*)gx;
      unsigned win[19];
#pragma unroll
      for (int i = 0; i < 19; ++i) win[i] = gxi[(rr * 16 + i) * 32 + cp];
#pragma unroll
      for (int i = 0; i < 16; ++i) {
        float o0 = cb0, o1 = cb1;
#pragma unroll
        for (int k = 0; k < 4; ++k) {
          o0 += cw0[k] * __uint_as_float(win[i + k] << 16);
          o1 += cw1[k] * __uint_as_float(win[i + k] & 0xffff0000u);
        }
        const int row = rr * 16 + i;
        const unsigned pk = (unsigned)f2bf(o0) | ((unsigned)f2bf(o1) << 16);
        *(unsigned*)(xct + swz_off(row, cp >> 2) + (cp & 3) * 4) = pk;
      }
    }
    __syncthreads();
    {
      f32x16 acc;
#pragma unroll
      for (int r = 0; r < 16; ++r) acc[r] = 0.f;
#pragma unroll
      for (int ks = 0; ks < 4; ++ks) {
        bf16x8 af = *(const bf16x8*)(xct + swz_off(wid * 32 + (lane & 31), ks * 2 + (lane >> 5)));
        acc = __builtin_amdgcn_mfma_f32_32x32x16_bf16(af, bw[ks], acc, 0, 0, 0);
      }
#pragma unroll
      for (int r = 0; r < 16; ++r) {
        const int row = wid * 32 + (r & 3) + 8 * (r >> 2) + 4 * (lane >> 5);
        Gt[row * 33 + (lane & 31)] = acc[r];
      }
    }
    __syncthreads();
    float av[8], uv[8];
    {
      float A = 1.f, B = 0.f;
#pragma unroll
      for (int i = 0; i < 8; ++i) {
        const int p = s_sub * 8 + i;
        const int tok = DIR ? (255 - p) : p;
        const float r = sigmoidf_(Gt[tok * 33 + ch] + br);
        const float ig = sigmoidf_(Gt[tok * 33 + 16 + ch] + bi);
        const int col = qq * 16 + ch;
        const float xcv = bf2f(*(const u16*)(xct + swz_off(tok, col >> 3) + (col & 7) * 2));
        const float a = __expf(Kc * r);
        const float u = __builtin_amdgcn_sqrtf(fmaxf(1.f - a * a, 0.f)) * ig * xcv;
        av[i] = a; uv[i] = u;
        B = a * B + u; A *= a;
      }
      sumA[s_sub * 16 + ch] = A; sumB[s_sub * 16 + ch] = B;
    }
    __syncthreads();
    {
      float h = carry[(cs & 1) * 16 + ch];
#pragma unroll 4
      for (int sp = 0; sp < 31; ++sp) {
        const float hn = sumA[sp * 16 + ch] * h + sumB[sp * 16 + ch];
        h = (sp < s_sub) ? hn : h;
      }
#pragma unroll
      for (int i = 0; i < 8; ++i) {
        const int p = s_sub * 8 + i;
        const int tok = DIR ? (255 - p) : p;
        h = av[i] * h + uv[i];
        const int sq = s0 + tok;
        if (DIR == 0) {
          hf[sq * 16 + ch] = f2bf(h);
        } else {
          const size_t t = (size_t)b * SEQ + sq;
          const float yv = (bf2f(hf[sq * 16 + ch]) + h) * bf2f(ggt[tok * 16 + ch]);
          w.y[AIDX(t, cglob)] = f2bf(yv);
          float ss = yv * yv;
          ss = sum_grp16(ss);
          if (ch == 0) w.ssq_lru[t * 32 + hh * 4 + qq] = ss;
        }
      }
      if (s_sub == 31) carry[((cs + 1) & 1) * 16 + ch] = h;
    }
    if (ja < UV_N4) uv_store(J, ja, juA, jvA, jgA);
    if (jb < UV_N4) uv_store(J, jb, juB, jvB, jgB);
    uvk += 2;
    __syncthreads();
  }
#undef LRU_PF
}

__device__ __forceinline__ void p2_lru_task(const WS& w, const LruParams& P, int task, char* smem, const UvJob& J, int& uvk) {
  const int b = task >> 5, hh = (task >> 2) & 7, qq = task & 3;
  lru_pass<0>(w, P, b, hh, qq, smem, J, uvk);
  lru_pass<1>(w, P, b, hh, qq, smem, J, uvk);
}


#define CONV_LDS_BYTES (62 * 1024 + 32 * 4 * 4)
struct ConvParams { const float* cw; const float* cb; const float* ng; const float* nb; };

__device__ __forceinline__ void p2_conv_tile(const WS& w, const ConvParams& P, int tile, char* smem) {
  int tid = threadIdx.x;
  asm volatile("" : "+v"(tid));
  const int lane = tid & 63, wid = tid >> 6;
  const int b = tile >> 6, s0 = (tile & 63) * 32;
  float* red = (float*)(smem + 62 * 1024);
  for (int q = tid; q < 62 * 64; q += 512) {
    const int row = q >> 6, c = q & 63;
    const int sp = s0 - 15 + row;
    uint4 v = make_uint4(0, 0, 0, 0);
    if (sp >= 0 && sp < SEQ) v = *(const uint4*)(w.glu + ((size_t)b * SEQ + sp) * 512 + c * 8);
    *(uint4*)(smem + row * 1024 + c * 16) = v;
  }
  const int cp = tid & 255, th = tid >> 8;
  float w0[31], w1[31];
#pragma unroll
  for (int k = 0; k < 31; ++k) {
    const float2 wv = *(const float2*)(P.cw + k * 512 + 2 * cp);
    w0[k] = wv.x; w1[k] = wv.y;
  }
  const float2 cbv = *(const float2*)(P.cb + 2 * cp);
  const float2 ngv = *(const float2*)(P.ng + 2 * cp);
  const float2 nbv = *(const float2*)(P.nb + 2 * cp);
  __syncthreads();
  const unsigned* gl = (const unsigned*)smem;
  float y0[16], y1[16];
#pragma unroll
  for (int tb = 0; tb < 2; ++tb) {
    float a0[8], a1[8];
#pragma unroll
    for (int i = 0; i < 8; ++i) { a0[i] = cbv.x; a1[i] = cbv.y; }
    const int rbase = th * 16 + tb * 8;
#pragma unroll
    for (int j = 0; j < 38; ++j) {
      const unsigned pk = gl[(rbase + j) * 256 + cp];
      const float xlo = __uint_as_float(pk << 16), xhi = __uint_as_float(pk & 0xffff0000u);
#pragma unroll
      for (int i = 0; i < 8; ++i) {
        const int k = j - i;
        if (k >= 0 && k < 31) { a0[i] += w0[k] * xlo; a1[i] += w1[k] * xhi; }
      }
      if ((j & 3) == 3) __builtin_amdgcn_sched_barrier(0);
    }
#pragma unroll
    for (int i = 0; i < 8; ++i) {
      float s = a0[i] + a1[i];
      s = sum_grp32(s);
      const float mu = s * (1.f / 64.f);
      const float d0 = a0[i] - mu, d1 = a1[i] - mu;
      float q = d0 * d0 + d1 * d1;
      q = sum_grp32(q);
      const float rstd = rsqrtf(q * (1.f / 64.f) + EPS);
      const float v0 = d0 * rstd * ngv.x + nbv.x, v1 = d1 * rstd * ngv.y + nbv.y;
      const float yy0 = v0 * sigmoidf_(v0), yy1 = v1 * sigmoidf_(v1);
      y0[tb * 8 + i] = yy0; y1[tb * 8 + i] = yy1;
      float sq = yy0 * yy0 + yy1 * yy1;
      sq = wave_sum(sq);
      if (lane == 0) red[(th * 16 + tb * 8 + i) * 4 + (wid & 3)] = sq;
    }
    __builtin_amdgcn_sched_barrier(0);
  }
  __syncthreads();
#pragma unroll
  for (int i = 0; i < 16; ++i) {
    const int tok = th * 16 + i;
    const float4 r4 = *(const float4*)(red + tok * 4);
    const float rc = rsqrtf((r4.x + r4.y + r4.z + r4.w) * (1.f / 512.f) + EPS);
    const size_t t = (size_t)b * SEQ + s0 + tok;
    const unsigned pk = (unsigned)f2bf(y0[i] * rc) | ((unsigned)f2bf(y1[i] * rc) << 16);
    *(unsigned*)(w.y + AIDX(t, 512 + 2 * cp)) = pk;
  }
  __syncthreads();
}


#define XB_TMO      128
#define XB_XCNT(j)  (256  + 64 * (j))
#define XB_XSUB(j)  (1280 + 64 * (j))
#define XB_XGEN(j)  (2304 + 64 * (j))
#define XB_TOP      3328
#define XB_TOPGEN   3392
#define XCD_BAR_WORDS 3456
#define XB_SPIN_CAP (1u << 22)
#define LAS __attribute__((address_space(3)))
__device__ __forceinline__ unsigned xb_ld(unsigned* p) { return __hip_atomic_load(p, __ATOMIC_RELAXED, __HIP_MEMORY_SCOPE_AGENT); }
__device__ __forceinline__ unsigned xb_add(unsigned* p, unsigned v) { return __hip_atomic_fetch_add(p, v, __ATOMIC_RELAXED, __HIP_MEMORY_SCOPE_AGENT); }
__device__ __forceinline__ unsigned xb_xcc_id() { return (unsigned)__builtin_amdgcn_s_getreg((3 << 11) | 20) & 0xFu; }
#define XB_SPIN(cond, bar) do { unsigned _sp = 0; while (cond) { __builtin_amdgcn_s_sleep(1); \
    if ((++_sp & 255u) == 0u) { if (xb_ld(&(bar)[XB_TMO])) break; if (_sp > XB_SPIN_CAP) { atomicAdd(&(bar)[XB_TMO], 1u); break; } } } } while (0)
struct XcdBarrier { unsigned* bar; unsigned x; volatile LAS unsigned* st; };
__device__ __forceinline__ XcdBarrier xcd_barrier_post(unsigned* bar, volatile LAS unsigned* st) {
  XcdBarrier b; b.bar = bar; b.x = xb_xcc_id(); b.st = st;
  if (threadIdx.x == 0) st[2] = xb_add(&bar[XB_XCNT(b.x)], 1u);
  return b;
}
__device__ __forceinline__ void xcd_barrier_complete(unsigned* bar, unsigned x, unsigned& nloc, unsigned& nx) {
  const unsigned G = gridDim.x * gridDim.y * gridDim.z;
  unsigned sum, cnt, mine, sp = 0u;
  for (;;) {
    sum = 0u; cnt = 0u; mine = 0u;
#pragma unroll
    for (unsigned j = 0; j < 16; ++j) { const unsigned c = xb_ld(&bar[XB_XCNT(j)]); sum += c; cnt += (c > 0u) ? 1u : 0u; mine = (j == x) ? c : mine; }
    if (sum == G) break;
    __builtin_amdgcn_s_sleep(1);
    if ((++sp & 255u) == 0u) { if (xb_ld(&bar[XB_TMO])) break; if (sp > XB_SPIN_CAP) { atomicAdd(&bar[XB_TMO], 1u); break; } }
  }
  nloc = mine > 0u ? mine : 1u; nx = cnt > 0u ? cnt : 1u;
}
__device__ __forceinline__ void xcd_barrier(const XcdBarrier& b) {
  asm volatile("s_waitcnt vmcnt(0)" ::: "memory");
  __syncthreads();
  if (threadIdx.x == 0) {
    unsigned* bar = b.bar;
    __builtin_amdgcn_s_waitcnt(0);
    unsigned nloc = b.st[0], nx = b.st[1];
    if (nloc == 0u) { xcd_barrier_complete(bar, b.x, nloc, nx); b.st[0] = nloc; b.st[1] = nx; }
    const unsigned old = xb_add(&bar[XB_XSUB(b.x)], 1u);
    const unsigned gen = old / nloc;
    if (old + 1u == (gen + 1u) * nloc) {
      __builtin_amdgcn_fence(__ATOMIC_RELEASE, "agent");
      asm volatile("s_waitcnt vmcnt(0)" ::: "memory");
      const unsigned og = xb_add(&bar[XB_TOP], 1u);
      const unsigned tg = og / nx;
      if (og + 1u == (tg + 1u) * nx) xb_add(&bar[XB_TOPGEN], 1u);
      else XB_SPIN(xb_ld(&bar[XB_TOPGEN]) == tg, bar);
      __builtin_amdgcn_fence(__ATOMIC_ACQUIRE, "agent");
      xb_add(&bar[XB_XGEN(b.x)], 1u);
      asm volatile("s_waitcnt vmcnt(0)" ::: "memory");
    } else {
      XB_SPIN(xb_ld(&bar[XB_XGEN(b.x)]) == gen, bar);
      __builtin_amdgcn_fence(__ATOMIC_ACQUIRE, "agent");
      asm volatile("s_waitcnt vmcnt(0)" ::: "memory");
    }
  }
  __syncthreads();
}

struct MK {
  WS w;
  const float* x; const float* mix_norm_g; const float* w_in; const float* lru_conv_w; const float* lru_conv_b;
  const float* lru_w_rg; const float* lru_b_rg; const float* lru_w_ig; const float* lru_b_ig; const float* lru_lambda;
  const float* conf_conv_w; const float* conf_conv_b; const float* conf_norm_g; const float* conf_norm_b;
  const float* beta_lru; const float* beta_conv; const float* w_out; const float* ffn_norm_g; const float* peer_w_q;
  const float* peer_sub_keys; const float* peer_u; const float* peer_v; const float* final_norm_g;
  float* out;
  unsigned* bar;
};

static_assert(MK_LDS_BYTES >= LRU_LDS_BYTES && MK_LDS_BYTES >= GEMM3_LDS_BYTES + 1024, "lds size");
#define MK_LDS_TOTAL (MK_LDS_BYTES + 16 + 256)

template <int MODE>
__device__ __forceinline__ void prep_wT_tile(const float* __restrict__ wsrc, const float* __restrict__ scale_a,
                                             const float* __restrict__ scale_b, u16* __restrict__ dst, int N, int tile,
                                             int htid, float* tl) {
  const int ntn = N >> 5;
  const int n0 = (tile % ntn) * 32, k0 = (tile / ntn) * 32;
  const int tx = htid & 31, ty = htid >> 5;
#pragma unroll
  for (int i = 0; i < 4; ++i) {
    const int kk = ty + 8 * i, k = k0 + kk, n = n0 + tx;
    const int col = (MODE == 1) ? win_orig_col(n) : n;
    float sc;
    if (MODE == 2) sc = (k < 512) ? scale_a[k] : scale_b[k - 512];
    else sc = scale_a[k];
    tl[kk * 33 + tx] = sc * wsrc[(size_t)k * N + col];
  }
  __syncthreads();
#pragma unroll
  for (int i = 0; i < 4; ++i) {
    const int nn = ty + 8 * i;
    dst[WIDX(n0 + nn, k0 + tx, N)] = f2bf(tl[tx * 33 + nn]);
  }
  __syncthreads();
}

__device__ __forceinline__ void phase0(const MK& p, char* smem) {
  int tid = threadIdx.x;
  asm volatile("" : "+v"(tid));
  const int lane = tid & 63, wid = tid >> 6;
  const int nb = gridDim.x, bid = blockIdx.x;
  {
    auto row_store = [&](int t, const float4 (&v)[4]) {
      float ss = 0.f;
#pragma unroll
      for (int i = 0; i < 4; ++i) ss += v[i].x * v[i].x + v[i].y * v[i].y + v[i].z * v[i].z + v[i].w * v[i].w;
      ss = wave_sum(ss);
#pragma unroll
      for (int i = 0; i < 4; ++i) {
        ushort4 o;
        o.x = f2bf(v[i].x); o.y = f2bf(v[i].y); o.z = f2bf(v[i].z); o.w = f2bf(v[i].w);
        *(ushort4*)(p.w.xb + AIDX(t, (i * 64 + lane) * 4)) = o;
      }
      if (lane == 0) p.w.rs0[t] = rsqrtf(ss * (1.f / 1024.f) + EPS);
    };
    const int st = nb * 8;
    int t = bid * 8 + wid;
    for (; t + st < T_TOK; t += 2 * st) {
      float4 va[4], vb[4];
#pragma unroll
      for (int i = 0; i < 4; ++i) va[i] = ((const float4*)(p.x + (size_t)t * 1024))[i * 64 + lane];
#pragma unroll
      for (int i = 0; i < 4; ++i) vb[i] = ((const float4*)(p.x + (size_t)(t + st) * 1024))[i * 64 + lane];
      row_store(t, va);
      row_store(t + st, vb);
    }
    for (; t < T_TOK; t += st) {
      float4 va[4];
#pragma unroll
      for (int i = 0; i < 4; ++i) va[i] = ((const float4*)(p.x + (size_t)t * 1024))[i * 64 + lane];
      row_store(t, va);
    }
  }
  {
    float* tl = (float*)smem + (tid >> 8) * (32 * 33);
    const int htid = tid & 255, hb = bid * 2 + (tid >> 8), nhb = nb * 2;
    for (int tile = hb; tile < 2048; tile += nhb) prep_wT_tile<1>(p.w_in, p.mix_norm_g, nullptr, p.w.WinT, 2048, tile, htid, tl);
    for (int tile = hb; tile < 1024; tile += nhb) prep_wT_tile<2>(p.w_out, p.beta_lru, p.beta_conv, p.w.WoutT, 1024, tile, htid, tl);
    for (int tile = hb; tile < 2048; tile += nhb) prep_wT_tile<0>(p.peer_w_q, p.ffn_norm_g, nullptr, p.w.WqT, 2048, tile, htid, tl);
  }
  for (int i = bid * 512 + tid; i < 16 * 128 * 128; i += nb * 512) {
    p.w.keysb[i] = f2bf(p.peer_sub_keys[i]);
    if (i < 2 * 8 * 4 * 32 * 64) {
      const int k = i & 63, j = (i >> 6) & 31, qq = (i >> 11) & 3, hh = (i >> 13) & 7, dir = (i >> 16) & 1;
      const int o = qq * 16 + (j & 15);
      const float* srcp = (j < 16) ? p.lru_w_rg : p.lru_w_ig;
      p.w.Wg[i] = f2bf(srcp[(((size_t)dir * 8 + hh) * 64 + k) * 64 + o]);
    }
  }
}

#define BAR_MARK() do { xcd_barrier(xb); PROBE_MARK(PSM(smem), 12); } while (0)
__global__ void __launch_bounds__(512) k_mega(MK p) {
  extern __shared__ __attribute__((aligned(16))) char smem[];
  const int nb = gridDim.x, bid = blockIdx.x;
  volatile LAS unsigned* xst = (volatile LAS unsigned*)(smem + MK_LDS_BYTES);
  if (threadIdx.x < 4) xst[threadIdx.x] = 0u;
#if PROBE
  PROBE_INIT(PSM(smem));
#endif
  __syncthreads();
  XcdBarrier xb = xcd_barrier_post(p.bar, xst);
  for (int rep = 0; rep < (DUP == 1 ? 2 : 1); ++rep) { phase0(p, smem); PROBE_MARK(PSM(smem), 1); BAR_MARK(); }
  for (int rep = 0; rep < (DUP == 2 ? 2 : 1); ++rep) {
    for (int tile = bid; tile < 512; tile += nb) p1_tile(p.w, tile, nb, smem);
    PROBE_MARK(PSM(smem), 2); BAR_MARK();
  }
  {
    LruParams LP{p.lru_conv_w, p.lru_conv_b, p.lru_b_rg, p.lru_b_ig, p.lru_lambda};
    UvJob UJ{p.peer_u, p.peer_v, p.ffn_norm_g, p.w.Ub, p.w.Vb, (size_t)bid * 512 + threadIdx.x, (size_t)nb * 512};
    int uvk = 0;
    for (int rep = 0; rep < (DUP == 3 ? 2 : 1); ++rep) {
      for (int task = bid; task < 256; task += nb) p2_lru_task(p.w, LP, task, smem, UJ, uvk);
      if (DUP == 3 && rep == 0) xcd_barrier(xb);
    }
    for (size_t i = UJ.i0 + (size_t)uvk * UJ.stride; i < UV_N4; i += UJ.stride)
      uv_store(UJ, i, ((const float4*)UJ.U)[i], ((const float4*)UJ.V)[i], ((const float4*)UJ.g2)[i & 255]);
    PROBE_MARK(PSM(smem), 3);
    ConvParams CP{p.conf_conv_w, p.conf_conv_b, p.conf_norm_g, p.conf_norm_b};
    for (int rep = 0; rep < (DUP == 4 ? 2 : 1); ++rep) {
      for (int tile = bid; tile < 512; tile += nb) p2_conv_tile(p.w, CP, tile, smem);
      if (DUP == 4 && rep == 0) xcd_barrier(xb);
    }
    PROBE_MARK(PSM(smem), 4);
  }
  BAR_MARK();
  for (int rep = 0; rep < (DUP == 5 ? 2 : 1); ++rep) {
    for (int tile = bid; tile < 256; tile += nb) p3_tile(p.w, p.x, p.out, tile, smem);
    PROBE_MARK(PSM(smem), 5); BAR_MARK();
  }
  for (int rep = 0; rep < (DUP == 6 ? 2 : 1); ++rep) {
    for (int tile = bid; tile < 1024; tile += nb) p4_tile(p.w, tile, smem);
    PROBE_MARK(PSM(smem), 6); BAR_MARK();
  }
  for (int rep = 0; rep < (DUP == 7 ? 2 : 1); ++rep) {
    const int wid = threadIdx.x >> 6, lane = threadIdx.x & 63;
    int ca, cb;
    staircase_ab(lane, ca, cb);
    {
      unsigned pa[8], pb[8], na[8], nb8[8]; float sq, nsq;
      int t = bid * 8 + wid;
      if (t < T_TOK) p5_route_load(p.w, t, ca, cb, pa, pb, sq);
      for (; t < T_TOK; t += nb * 8) {
        const int tn = t + nb * 8;
        if (tn < T_TOK) p5_route_load(p.w, tn, ca, cb, na, nb8, nsq);
        p5_route_compute(p.w, t, pa, pb, sq, (float*)smem + wid * 512);
#pragma unroll
        for (int h = 0; h < 8; ++h) { pa[h] = na[h]; pb[h] = nb8[h]; }
        sq = nsq;
      }
    }
    PROBE_MARK(PSM(smem), 7); BAR_MARK();
  }
  int gs_slice, gs_t0, gs_stride;
  {
    const unsigned nloc = xst[0], nx = xst[1], rank = xst[2];
    const int wid = threadIdx.x >> 6;
    bool all8 = (nx == 8u);
    if (all8) { for (int j = 0; j < 8; ++j) all8 = all8 && (xb_ld(&p.bar[XB_XCNT(j)]) > 0u); }
    if (all8 && xb.x < 8u) { gs_slice = (int)xb.x; gs_t0 = (int)rank * 8 + wid; gs_stride = (int)nloc * 8; }
    else if ((nb & 7) == 0) { gs_slice = bid & 7; gs_t0 = (bid >> 3) * 8 + wid; gs_stride = (nb >> 3) * 8; }
    else { gs_slice = -1; gs_t0 = bid * 8 + wid; gs_stride = nb * 8; }
  }
  for (int rep = 0; rep < (DUP == 11 ? 2 : 1); ++rep) {
    if (gs_slice >= 0) u_sweep(p.w, gs_slice, gs_t0, gs_stride);
    else for (int s = 0; s < 8; ++s) u_sweep(p.w, s, gs_t0, gs_stride);
    PROBE_MARK(PSM(smem), 8); BAR_MARK();
  }
  for (int rep = 0; rep < (DUP == 12 ? 2 : 1); ++rep) {
    const int wid = threadIdx.x >> 6;
    for (int t = bid * 8 + wid; t < T_TOK; t += nb * 8) p5_wphase(p.w, t);
    PROBE_MARK(PSM(smem), 9); BAR_MARK();
  }
  for (int rep = 0; rep < (DUP == 8 ? 2 : 1); ++rep) {
    const bool dry = (DUP == 8 && rep == 0);
    if (gs_slice >= 0) v_sweep(p.w, gs_slice, gs_t0, gs_stride, p.out, p.out, dry);
    else for (int s = 0; s < 8; ++s) v_sweep(p.w, s, gs_t0, gs_stride, p.out, p.out, dry);
    PROBE_MARK(PSM(smem), 10); BAR_MARK();
  }
  for (int rep = 0; rep < (DUP == 9 ? 2 : 1); ++rep) {
    const bool dry = (DUP == 9 && rep == 0);
    const int wid = threadIdx.x >> 6;
    for (int t = bid * 8 + wid; t < T_TOK; t += nb * 8) p7_row(p.w, t, p.final_norm_g, p.out, dry);
    if (DUP == 9 && rep == 0) xcd_barrier(xb);
  }
  PROBE_MARK(PSM(smem), 11);
#if DUP == 10
  for (int rep = 0; rep < 10; ++rep) xcd_barrier(xb);
#endif
#if PROBE
  if (bid == PBLK && threadIdx.x == 0) {
    const unsigned long long* pa = (const unsigned long long*)PSM(smem);
    const unsigned long long dur = pa[PROBE];
    const unsigned long long st = __builtin_amdgcn_s_memrealtime();
    while (__builtin_amdgcn_s_memrealtime() - st < dur) __builtin_amdgcn_s_sleep(8);
  }
#endif
}

extern "C" void kernel_launch(void* const* d_in, const int* in_sizes, int n_in, void* d_out, int out_size, void* d_ws,
                              size_t ws_size, hipStream_t stream) {
  const float* x = (const float*)d_in[0];
  const float* mix_norm_g = (const float*)d_in[1];
  const float* w_in = (const float*)d_in[2];
  const float* lru_conv_w = (const float*)d_in[3];
  const float* lru_conv_b = (const float*)d_in[4];
  const float* lru_w_rg = (const float*)d_in[5];
  const float* lru_b_rg = (const float*)d_in[6];
  const float* lru_w_ig = (const float*)d_in[7];
  const float* lru_b_ig = (const float*)d_in[8];
  const float* lru_lambda = (const float*)d_in[9];
  const float* conf_conv_w = (const float*)d_in[10];
  const float* conf_conv_b = (const float*)d_in[11];
  const float* conf_norm_g = (const float*)d_in[12];
  const float* conf_norm_b = (const float*)d_in[13];
  const float* beta_lru = (const float*)d_in[14];
  const float* beta_conv = (const float*)d_in[15];
  const float* w_out = (const float*)d_in[16];
  const float* ffn_norm_g = (const float*)d_in[17];
  const float* peer_w_q = (const float*)d_in[18];
  const float* peer_sub_keys = (const float*)d_in[19];
  const float* peer_u = (const float*)d_in[20];
  const float* peer_v = (const float*)d_in[21];
  const float* final_norm_g = (const float*)d_in[22];
  float* out = (float*)d_out;
  WS w = make_ws(d_ws);
  static int grid_blocks = 0;
  if (!grid_blocks) {
    (void)hipFuncSetAttribute((const void*)k_mega, hipFuncAttributeMaxDynamicSharedMemorySize, MK_LDS_TOTAL);
    int dev = 0, cus = 0, per_cu = 0;
    (void)hipGetDevice(&dev);
    (void)hipDeviceGetAttribute(&cus, hipDeviceAttributeMultiprocessorCount, dev);
    (void)hipOccupancyMaxActiveBlocksPerMultiprocessor(&per_cu, k_mega, 512, MK_LDS_TOTAL);
    if (per_cu > 1) per_cu = 1;
    grid_blocks = cus * per_cu;
    if (grid_blocks <= 0) grid_blocks = 1;
  }
  MK p{};
  p.w = w;
  p.x = x; p.mix_norm_g = mix_norm_g; p.w_in = w_in; p.lru_conv_w = lru_conv_w; p.lru_conv_b = lru_conv_b;
  p.lru_w_rg = lru_w_rg; p.lru_b_rg = lru_b_rg; p.lru_w_ig = lru_w_ig; p.lru_b_ig = lru_b_ig; p.lru_lambda = lru_lambda;
  p.conf_conv_w = conf_conv_w; p.conf_conv_b = conf_conv_b; p.conf_norm_g = conf_norm_g; p.conf_norm_b = conf_norm_b;
  p.beta_lru = beta_lru; p.beta_conv = beta_conv; p.w_out = w_out; p.ffn_norm_g = ffn_norm_g; p.peer_w_q = peer_w_q;
  p.peer_sub_keys = peer_sub_keys; p.peer_u = peer_u; p.peer_v = peer_v; p.final_norm_g = final_norm_g;
  p.out = out;
  p.bar = w.bar;
  (void)hipMemsetAsync(w.bar, 0, XCD_BAR_WORDS * 4, stream);
  hipLaunchKernelGGL(k_mega, dim3(grid_blocks), dim3(512), MK_LDS_TOTAL, stream, p);
}
```

```cpp
#include <hip/hip_runtime.h>
#include <hip/hip_bf16.h>
#include <hip/hip_cooperative_groups.h>
#include <cstdio>
namespace cg = cooperative_groups;
#include <stdint.h>

typedef unsigned short u16;
typedef __attribute__((ext_vector_type(8))) short bf16x8;
typedef __attribute__((ext_vector_type(4))) float f32x4;
typedef __attribute__((ext_vector_type(16))) float f32x16;

#ifndef DUP
#define DUP 0
#endif
#ifndef PROBE
#define PROBE 0
#endif
#define MK_LDS_BYTES 153728
#define PSM(sm) ((sm) + MK_LDS_BYTES + 16)
#ifndef PBLK
#define PBLK 0
#endif
#if PROBE
#define PROBE_INIT(sm) unsigned long long* _pacc = (unsigned long long*)(sm); const bool _pon = (blockIdx.x == PBLK && threadIdx.x == 0); \
   if (_pon) { for (int _i = 0; _i < 31; ++_i) _pacc[_i] = 0ull; _pacc[31] = __builtin_amdgcn_s_memrealtime(); }
#define PROBE_MARK(sm, i) do { unsigned long long* _pa = (unsigned long long*)(sm); if (blockIdx.x == PBLK && threadIdx.x == 0) { \
   const unsigned long long _n = __builtin_amdgcn_s_memrealtime(); _pa[i] += _n - _pa[31]; _pa[31] = _n; } } while (0)
#else
#define PROBE_MARK(sm, i) do {} while (0)
#endif
#define T_TOK 16384
#define SEQ 2048
#define NB 8
#define DM 1024
#define DL 512
#define EPS 1e-6f
#define AIDX(t, k) ((((size_t)((k) >> 6)) * T_TOK + (size_t)(t)) * 64 + ((k) & 63))
#define WIDX(n, k, N) ((((size_t)((k) >> 6)) * (N) + (size_t)(n)) * 64 + ((k) & 63))
#define PEER_SU 256.f
#define PEER_SV 16.f
#define PEER_SV4 6.f
#define PEER_WS8 64.f
#define PEER_SU4 64.f
typedef __attribute__((ext_vector_type(2))) float f32x2;

__device__ __forceinline__ float bf2f(u16 v) { return __uint_as_float(((unsigned)v) << 16); }
typedef __attribute__((ext_vector_type(2))) __bf16 bf2v;
__device__ __forceinline__ u16 f2bf(float f) { return __builtin_bit_cast(u16, (__bf16)f); }
__device__ __forceinline__ unsigned f2bf2(float lo, float hi) { f32x2 v; v.x = lo; v.y = hi; return __builtin_bit_cast(unsigned, __builtin_convertvector(v, bf2v)); }
__device__ __forceinline__ f32x2 bfpair(unsigned d) { f32x2 r; r.x = __uint_as_float(d << 16); r.y = __uint_as_float(d & 0xffff0000u); return r; }
__device__ __forceinline__ float frcp(float x) { return __builtin_amdgcn_rcpf(x); }
__device__ __forceinline__ float sigmoidf_(float x) { return frcp(1.f + __expf(-x)); }
__device__ __forceinline__ float gelu_tanh(float x) {
  float u = 0.7978845608028654f * (x + 0.044715f * x * x * x);
  float e = __expf(2.f * u);
  float th = 1.f - 2.f * frcp(e + 1.f);
  return 0.5f * x * (1.f + th);
}
__device__ __forceinline__ float log_sigmoidf_(float x) {
  return fminf(x, 0.f) - log1pf(__expf(-fabsf(x)));
}
__device__ __forceinline__ int tid_fresh() { int t = threadIdx.x; asm volatile("" : "+v"(t)); return t; }
__device__ __forceinline__ float sum_grp16(float v) {
  v += __int_as_float(__builtin_amdgcn_update_dpp(0, __float_as_int(v), 0xB1, 0xF, 0xF, true));
  v += __int_as_float(__builtin_amdgcn_update_dpp(0, __float_as_int(v), 0x4E, 0xF, 0xF, true));
  v += __int_as_float(__builtin_amdgcn_update_dpp(0, __float_as_int(v), 0x141, 0xF, 0xF, true));
  v += __int_as_float(__builtin_amdgcn_update_dpp(0, __float_as_int(v), 0x140, 0xF, 0xF, true));
  return v;
}
__device__ __forceinline__ float sum_grp32(float v) {
  v = sum_grp16(v);
  auto a = __builtin_amdgcn_permlane16_swap(__float_as_int(v), __float_as_int(v), false, false);
  return __int_as_float(a[0]) + __int_as_float(a[1]);
}
__device__ __forceinline__ float wave_sum(float v) {
  v = sum_grp32(v);
  auto b = __builtin_amdgcn_permlane32_swap(__float_as_int(v), __float_as_int(v), false, false);
  return __int_as_float(b[0]) + __int_as_float(b[1]);
}

struct WS {
  u16* xb;
  float* rs0;
  u16* WinT;
  u16* WoutT;
  u16* WqT;
  u16* keysb;
  u16* Wg;
  u16* Ub;
  u16* Vb;
  u16* xl;
  u16* gg;
  u16* glu;
  u16* y;
  float* ssq_lru;
  float* ssq_h1;
  unsigned* cand;
  u16* h1b;
  float* tmp_a;
  float* tmp_b;
  u16* sel_e;
  float* wgt;
  float* ssq_out;
  unsigned* bar;
  float* gate;
  float* rs2v;
  unsigned* part;
  unsigned* ffn;
  unsigned char* h1q;
};

static WS make_ws(void* d_ws) {
  char* p = (char*)d_ws;
  WS w;
  size_t off = 0;
  auto take = [&](size_t bytes) { char* r = p + off; off += (bytes + 255) & ~(size_t)255; return r; };
  w.xb = (u16*)take((size_t)T_TOK * 1024 * 2);
  w.rs0 = (float*)take((size_t)T_TOK * 4);
  w.WinT = (u16*)take((size_t)2048 * 1024 * 2);
  w.WoutT = (u16*)take((size_t)1024 * 1024 * 2);
  w.WqT = (u16*)take((size_t)2048 * 1024 * 2);
  w.keysb = (u16*)take((size_t)16 * 128 * 128 * 2);
  w.Wg = (u16*)take((size_t)2 * 8 * 4 * 32 * 64 * 2);
  w.Ub = (u16*)take((size_t)16384 * 1024 * 2);
  w.Vb = (u16*)take((size_t)16384 * 1024 * 2);
  w.xl = (u16*)take((size_t)T_TOK * 512 * 2);
  w.gg = (u16*)take((size_t)T_TOK * 512 * 2);
  w.glu = (u16*)take((size_t)T_TOK * 512 * 2);
  w.y = (u16*)take((size_t)T_TOK * 1024 * 2);
  w.ssq_lru = (float*)take((size_t)T_TOK * 32 * 4);
  w.ssq_h1 = (float*)take((size_t)T_TOK * 16 * 4);
  w.sel_e = (u16*)take((size_t)T_TOK * 128 * 2);
  w.wgt = (float*)take((size_t)T_TOK * 128 * 4);
  w.ssq_out = (float*)take((size_t)T_TOK * 16 * 4);
  w.bar = (unsigned*)take(4096 * 4);
  w.gate = (float*)take((size_t)T_TOK * 128 * 4);
  w.rs2v = (float*)take((size_t)T_TOK * 4);
  w.part = (unsigned*)w.xl;
  w.ffn = (unsigned*)w.y;
  w.h1q = (unsigned char*)w.Ub + ((size_t)16 << 20);
  w.cand = (unsigned*)w.xl;
  w.h1b = w.xb;
  w.tmp_a = (float*)w.Ub;
  w.tmp_b = (float*)w.Vb;
  return w;
}


__device__ __forceinline__ int win_orig_col(int np) {
  if (np < 1024) return np;
  int r = (np - 1024) >> 6, i = (np - 1024) & 63;
  return (i < 32) ? (1024 + 32 * r + i) : (1536 + 32 * r + (i - 32));
}


__device__ __forceinline__ void load_rows8(const u16* __restrict__ A, int t0, float* xs) {
  for (int i = threadIdx.x; i < 8 * 1024; i += 256) xs[i] = bf2f(A[(size_t)t0 * 1024 + i]);
  __syncthreads();
}
__device__ __forceinline__ void dot8(const u16* __restrict__ wrow, const float* xs, int kbeg, int kend, float acc[8]) {
  for (int k = kbeg; k < kend; k += 8) {
    uint4 wv = *(const uint4*)(wrow + k);
    float wf[8];
    wf[0] = __uint_as_float(wv.x << 16); wf[1] = __uint_as_float(wv.x & 0xffff0000u);
    wf[2] = __uint_as_float(wv.y << 16); wf[3] = __uint_as_float(wv.y & 0xffff0000u);
    wf[4] = __uint_as_float(wv.z << 16); wf[5] = __uint_as_float(wv.z & 0xffff0000u);
    wf[6] = __uint_as_float(wv.w << 16); wf[7] = __uint_as_float(wv.w & 0xffff0000u);
#pragma unroll
    for (int r = 0; r < 8; ++r) {
      const float* xr = xs + r * 1024 + k;
      float a = acc[r];
#pragma unroll
      for (int j = 0; j < 8; ++j) a += wf[j] * xr[j];
      acc[r] = a;
    }
  }
}


__device__ __forceinline__ float rs2_of(const float* ssq_h1, int t) {
  float s = 0.f;
  for (int j = 0; j < 16; ++j) s += ssq_h1[(size_t)t * 16 + j];
  return rsqrtf(s * (1.f / 1024.f) + EPS);
}


#define GEMM_BUF_BYTES 49152
#define GEMM_LDS_BYTES (2 * GEMM_BUF_BYTES)

__device__ __forceinline__ int swz_off(int row, int c) { return row * 128 + ((c ^ ((row >> 1) & 7)) << 4); }

typedef __attribute__((ext_vector_type(4))) unsigned int u32x4;
#define G_LOAD(P, k0) do { \
  P##a0 = *(const u32x4*)(Ap + (size_t)0 * 64 * 1024 + (k0)); P##a1 = *(const u32x4*)(Ap + (size_t)1 * 64 * 1024 + (k0)); \
  P##a2 = *(const u32x4*)(Ap + (size_t)2 * 64 * 1024 + (k0)); P##a3 = *(const u32x4*)(Ap + (size_t)3 * 64 * 1024 + (k0)); \
  P##b0 = *(const u32x4*)(Bp + (size_t)0 * 64 * 1024 + (k0)); P##b1 = *(const u32x4*)(Bp + (size_t)1 * 64 * 1024 + (k0)); } while (0)
#define G_STORE(P, As_) do { char* _As = (As_); char* _Bs = _As + 32768; \
  *(u32x4*)(_As + swz_off(srow + 0, sc)) = P##a0; *(u32x4*)(_As + swz_off(srow + 64, sc)) = P##a1; \
  *(u32x4*)(_As + swz_off(srow + 128, sc)) = P##a2; *(u32x4*)(_As + swz_off(srow + 192, sc)) = P##a3; \
  *(u32x4*)(_Bs + swz_off(srow + 0, sc)) = P##b0; *(u32x4*)(_Bs + swz_off(srow + 64, sc)) = P##b1; } while (0)
__device__ __forceinline__ void g_mma(const char* As, int wm, int wn, int lane, f32x16 (&acc)[2][2]) {
  const char* Bs = As + 32768;
#pragma unroll
  for (int ks = 0; ks < 4; ++ks) {
    const int c = ks * 2 + (lane >> 5);
    bf16x8 af[2], bfr[2];
#pragma unroll
    for (int mi = 0; mi < 2; ++mi) af[mi] = *(const bf16x8*)(As + swz_off(wm * 64 + mi * 32 + (lane & 31), c));
#pragma unroll
    for (int ni = 0; ni < 2; ++ni) bfr[ni] = *(const bf16x8*)(Bs + swz_off(wn * 64 + ni * 32 + (lane & 31), c));
#pragma unroll
    for (int mi = 0; mi < 2; ++mi)
#pragma unroll
      for (int ni = 0; ni < 2; ++ni)
        acc[mi][ni] = __builtin_amdgcn_mfma_f32_32x32x16_bf16(bfr[ni], af[mi], acc[mi][ni], 0, 0, 0);
  }
}

#define GEMM_STAGE_BYTES 49152
#define GEMM3_LDS_BYTES (3 * GEMM_STAGE_BYTES)
template <bool RESCALE, int NBT>
__device__ __forceinline__ void gemm_core(const u16* __restrict__ A, const u16* __restrict__ Bt, int m0, int n0,
                                          char* smem, f32x16 (&acc)[2][2], const float* rls, int koff = 0) {
  const int tid = tid_fresh(), lane = tid & 63, wid = tid >> 6;
  const int wm = wid >> 1, wn = wid & 1;
  const int srow = tid >> 3, pos = tid & 7;
  const int csrc = pos ^ ((srow >> 1) & 7);
  const u16* Ap = A + (size_t)(m0 + srow) * 64 + csrc * 8;
  const u16* Bp = Bt + (size_t)(n0 + srow) * 64 + csrc * 8;
  const size_t ksA = (size_t)T_TOK * 64, ksB = (size_t)NBT * 64;
  char* wbase = smem + wid * 1024;
  asm volatile("" : "+v"(acc[0][0]), "+v"(acc[0][1]), "+v"(acc[1][0]), "+v"(acc[1][1]));
  __builtin_amdgcn_sched_barrier(0);
#define G_DMA(stage, kt_) do { const int _kt = (((kt_) + koff) & 15); char* _sb = wbase + (stage) * GEMM_STAGE_BYTES; \
    const u16* _a = Ap + _kt * ksA; const u16* _b = Bp + _kt * ksB; \
    __builtin_amdgcn_global_load_lds((const unsigned*)(_a + 0 * 4096), (unsigned*)(_sb + 0 * 8192), 16, 0, 0); \
    __builtin_amdgcn_global_load_lds((const unsigned*)(_a + 1 * 4096), (unsigned*)(_sb + 1 * 8192), 16, 0, 0); \
    __builtin_amdgcn_global_load_lds((const unsigned*)(_a + 2 * 4096), (unsigned*)(_sb + 2 * 8192), 16, 0, 0); \
    __builtin_amdgcn_global_load_lds((const unsigned*)(_a + 3 * 4096), (unsigned*)(_sb + 3 * 8192), 16, 0, 0); \
    __builtin_amdgcn_global_load_lds((const unsigned*)(_b + 0 * 4096), (unsigned*)(_sb + 32768 + 0 * 8192), 16, 0, 0); \
    __builtin_amdgcn_global_load_lds((const unsigned*)(_b + 1 * 4096), (unsigned*)(_sb + 32768 + 1 * 8192), 16, 0, 0); } while (0)
  G_DMA(0, 0);
  G_DMA(1, 1);
  int st = 0;
#pragma unroll 1
  for (int kt = 0; kt < 16; ++kt) {
    if (kt < 15) asm volatile("s_waitcnt vmcnt(6)" ::: "memory");
    else asm volatile("s_waitcnt vmcnt(0)" ::: "memory");
    asm volatile("s_waitcnt lgkmcnt(0)" ::: "memory");
    __builtin_amdgcn_s_barrier();
    if (kt + 2 < 16) { const int st2 = (st >= 1) ? st - 1 : st + 2; G_DMA(st2, kt + 2); }
    if (RESCALE && kt == 8) {
#pragma unroll
      for (int mi = 0; mi < 2; ++mi)
#pragma unroll
        for (int r = 0; r < 16; ++r) {
          const float s = rls[wm * 64 + mi * 32 + (r & 3) + 8 * (r >> 2) + 4 * (lane >> 5)];
          acc[mi][0][r] *= s; acc[mi][1][r] *= s;
        }
    }
    g_mma(smem + st * GEMM_STAGE_BYTES, wm, wn, lane, acc);
    st = (st == 2) ? 0 : st + 1;
  }
#undef G_DMA
  __syncthreads();
}

#define G256_STAGE_BYTES 32768
#define G256_LDS_BYTES (4 * G256_STAGE_BYTES)
__device__ __forceinline__ int swz64(int row, int c) { return row * 64 + ((c ^ ((row >> 2) & 3)) << 4); }
template <bool RESCALE, int NBT, bool TR = false, bool SPLITN = false>
__device__ __forceinline__ void gemm_core256(const u16* __restrict__ A, const u16* __restrict__ Bt, int m0, int n0,
                                             char* smem, f32x16 (&acc)[4][2], const float* rls) {
  const int tid = tid_fresh(), lane = tid & 63, wid = tid >> 6;
  const int wm = wid >> 2, wn = wid & 3;
  const int rowi = wid * 16 + (lane >> 2);
  const int csrc = (lane & 3) ^ ((lane >> 4) & 3);
  const u16* Ap = A + (size_t)(m0 + rowi) * 64 + csrc * 8;
  const u16* Bp = Bt + (size_t)(n0 + rowi) * 64 + csrc * 8;
  const size_t ksA = (size_t)T_TOK * 64, ksB = (size_t)NBT * 64;
  char* wbase = smem + wid * 1024;
  asm volatile("" : "+v"(acc[0][0]), "+v"(acc[0][1]), "+v"(acc[1][0]), "+v"(acc[1][1]), "+v"(acc[2][0]), "+v"(acc[2][1]), "+v"(acc[3][0]), "+v"(acc[3][1]));
  __builtin_amdgcn_sched_barrier(0);
#define G2_DMA(s_) do { const int _s = (s_); char* _sb = wbase + (_s & 3) * G256_STAGE_BYTES; \
    const u16* _a = Ap + (_s >> 1) * ksA + (_s & 1) * 32; const u16* _b = Bp + (_s >> 1) * ksB + (_s & 1) * 32; \
    __builtin_amdgcn_global_load_lds((const unsigned*)(_a), (unsigned*)(_sb), 16, 0, 0); \
    __builtin_amdgcn_global_load_lds((const unsigned*)(_a + 8192), (unsigned*)(_sb + 8192), 16, 0, 0); \
    __builtin_amdgcn_global_load_lds((const unsigned*)(_b), (unsigned*)(_sb + 16384), 16, 0, 0); \
    __builtin_amdgcn_global_load_lds((const unsigned*)(_b + 8192), (unsigned*)(_sb + 16384 + 8192), 16, 0, 0); } while (0)
  G2_DMA(0);
  G2_DMA(1);
  G2_DMA(2);
  bf16x8 afA[4], bfA[2], afB[4], bfB[2];
#define G2_READ(AF, BF, As_, ks_) do { const int _c = (ks_) * 2 + (lane >> 5); const char* _A = (As_); const char* _B = _A + 16384; \
    _Pragma("unroll") for (int _ni = 0; _ni < 2; ++_ni) BF[_ni] = *(const bf16x8*)(_B + swz64((SPLITN ? _ni * 128 + wn * 32 : wn * 64 + _ni * 32) + (lane & 31), _c)); \
    _Pragma("unroll") for (int _mi = 0; _mi < 4; ++_mi) AF[_mi] = *(const bf16x8*)(_A + swz64(wm * 128 + _mi * 32 + (lane & 31), _c)); } while (0)
#define G2_MMA(AF, BF) do { \
    _Pragma("unroll") for (int _mi = 0; _mi < 4; ++_mi) _Pragma("unroll") for (int _ni = 0; _ni < 2; ++_ni) \
      acc[_mi][_ni] = TR ? __builtin_amdgcn_mfma_f32_32x32x16_bf16(BF[_ni], AF[_mi], acc[_mi][_ni], 0, 0, 0) \
                         : __builtin_amdgcn_mfma_f32_32x32x16_bf16(AF[_mi], BF[_ni], acc[_mi][_ni], 0, 0, 0); } while (0)
#pragma unroll 1
  for (int s = 0; s < 32; ++s) {
    if (s < 30) asm volatile("s_waitcnt vmcnt(8)" ::: "memory");
    else if (s == 30) asm volatile("s_waitcnt vmcnt(4)" ::: "memory");
    else asm volatile("s_waitcnt vmcnt(0)" ::: "memory");
    asm volatile("s_waitcnt lgkmcnt(0)" ::: "memory");
    __builtin_amdgcn_s_barrier();
    if (s + 3 < 32) G2_DMA(s + 3);
    const char* As = smem + (s & 3) * G256_STAGE_BYTES;
    G2_READ(afA, bfA, As, 0);
    __builtin_amdgcn_sched_barrier(0);
    if (s > 0) G2_MMA(afB, bfB);
    __builtin_amdgcn_sched_barrier(0);
    if (RESCALE && s == 16) {
#pragma unroll
      for (int mi = 0; mi < 4; ++mi)
#pragma unroll
        for (int r = 0; r < 16; ++r) {
          const float sc = rls[wm * 128 + mi * 32 + (r & 3) + 8 * (r >> 2) + 4 * (lane >> 5)];
          acc[mi][0][r] *= sc; acc[mi][1][r] *= sc;
        }
    }
    G2_READ(afB, bfB, As, 1);
    __builtin_amdgcn_sched_barrier(0);
    G2_MMA(afA, bfA);
    __builtin_amdgcn_sched_barrier(0);
  }
  G2_MMA(afB, bfB);
#undef G2_READ
#undef G2_MMA
#undef G2_DMA
  __syncthreads();
}

__device__ __forceinline__ void zero_acc(f32x16 (&acc)[2][2]) {
#pragma unroll
  for (int mi = 0; mi < 2; ++mi)
#pragma unroll
    for (int ni = 0; ni < 2; ++ni)
#pragma unroll
      for (int r = 0; r < 16; ++r) acc[mi][ni][r] = 0.f;
}

__device__ __forceinline__ void p1_tile(const WS& w, int tile, int nblk_g, char* smem) {
  const int it = tile >> 8, b = tile & 255, g = b & 7, j = b >> 3;
  const int mt = it * 32 + g * 4 + (j >> 3), nt = j & 7;
  const int m0 = mt * 256, n0 = nt * 256;
  f32x16 acc[4][2];
#pragma unroll
  for (int mi = 0; mi < 4; ++mi)
#pragma unroll
    for (int ni = 0; ni < 2; ++ni)
#pragma unroll
      for (int r = 0; r < 16; ++r) acc[mi][ni][r] = 0.f;
  gemm_core256<false, 2048>(w.xb, w.WinT, m0, n0, smem, acc, nullptr);
  const int tidf = tid_fresh(); const int lane = tidf & 63, wid = tidf >> 6, wm = wid >> 2, wn = wid & 3;
  const int nb = n0 + wn * 64;
  const int rowb = m0 + wm * 128 + 4 * (lane >> 5);
#pragma unroll
  for (int mi = 0; mi < 4; ++mi) {
    float rs[16];
#pragma unroll
    for (int r = 0; r < 16; ++r) rs[r] = w.rs0[rowb + mi * 32 + (r & 3) + 8 * (r >> 2)];
    if (nb < 512) {
#pragma unroll
      for (int r = 0; r < 16; ++r) {
        const int row = rowb + mi * 32 + (r & 3) + 8 * (r >> 2);
#pragma unroll
        for (int ni = 0; ni < 2; ++ni) w.xl[(size_t)row * 512 + nb + ni * 32 + (lane & 31)] = f2bf(rs[r] * acc[mi][ni][r]);
      }
    } else if (nb < 1024) {
#pragma unroll
      for (int r = 0; r < 16; ++r) {
        const int row = rowb + mi * 32 + (r & 3) + 8 * (r >> 2);
#pragma unroll
        for (int ni = 0; ni < 2; ++ni) w.gg[(size_t)row * 512 + (nb - 512) + ni * 32 + (lane & 31)] = f2bf(gelu_tanh(rs[r] * acc[mi][ni][r]));
      }
    } else {
      const int ch = ((nb - 1024) >> 6) * 32 + (lane & 31);
#pragma unroll
      for (int r = 0; r < 16; ++r) {
        const int row = rowb + mi * 32 + (r & 3) + 8 * (r >> 2);
        const float a = rs[r] * acc[mi][0][r], bb = rs[r] * acc[mi][1][r];
        w.glu[(size_t)row * 512 + ch] = f2bf(a * sigmoidf_(bb));
      }
    }
  }
}
__device__ __forceinline__ void p3_tile(const WS& w, const float* __restrict__ x, float* __restrict__ h1, int tile, char* smem) {
  const int b = tile & 255, g = b & 7, j = b >> 3;
  const int mt = (tile >> 8) * 64 + g * 8 + (j >> 2), nt = j & 3;
  const int m0 = mt * 256, n0 = nt * 256;
  const int tidf = tid_fresh(); const int lane = tidf & 63, wid = tidf >> 6, wm = wid >> 2, wn = wid & 3;
  float* rls = (float*)(smem + G256_LDS_BYTES);
  if (tidf < 256) {
    const float4* p = (const float4*)(w.ssq_lru + (size_t)(m0 + tidf) * 32);
    float s = 0.f;
#pragma unroll
    for (int i = 0; i < 8; ++i) { float4 v = p[i]; s += v.x + v.y + v.z + v.w; }
    rls[tidf] = rsqrtf(s * (1.f / 512.f) + EPS);
  }
  f32x16 acc[4][2];
#pragma unroll
  for (int mi = 0; mi < 4; ++mi)
#pragma unroll
    for (int ni = 0; ni < 2; ++ni)
#pragma unroll
      for (int r = 0; r < 16; ++r) acc[mi][ni][r] = 0.f;
  gemm_core256<true, 1024>(w.y, w.WoutT, m0, n0, smem, acc, rls);
  const size_t ob = (size_t)(m0 + wm * 128 + 4 * (lane >> 5)) * 1024 + n0 + wn * 64 + (lane & 31);
#pragma unroll
  for (int mi = 0; mi < 4; ++mi) {
    float xr[2][16];
#pragma unroll
    for (int r = 0; r < 16; ++r)
#pragma unroll
      for (int ni = 0; ni < 2; ++ni) xr[ni][r] = x[ob + (size_t)(mi * 32 + (r & 3) + 8 * (r >> 2)) * 1024 + ni * 32];
#pragma unroll
    for (int r = 0; r < 16; ++r) {
      const int row = m0 + wm * 128 + mi * 32 + (r & 3) + 8 * (r >> 2) + 4 * (lane >> 5);
      float ss = 0.f;
#pragma unroll
      for (int ni = 0; ni < 2; ++ni) {
        const int col = n0 + wn * 64 + ni * 32 + (lane & 31);
        const float hv = xr[ni][r] + acc[mi][ni][r];
        w.h1b[AIDX(row, col)] = f2bf(hv);
        ss += hv * hv;
      }
      ss = sum_grp32(ss);
      if ((lane & 31) == 0) w.ssq_h1[(size_t)row * 16 + nt * 4 + wn] = ss;
    }
  }
  __syncthreads();
}

__device__ __forceinline__ int swz256(int row, int c) { return row * 256 + ((c ^ (row & 15)) << 4); }

__device__ __forceinline__ void cmpswap_desc(float& a, float& b) { float mx = fmaxf(a, b), mn = fminf(a, b); a = mx; b = mn; }

#define CE_D(a, b) { const int hi_ = max(a, b), lo_ = min(a, b); a = hi_; b = lo_; }
__device__ __forceinline__ void sort16_desc(int (&v)[16]) {
  CE_D(v[0], v[13]) CE_D(v[1], v[12]) CE_D(v[2], v[15]) CE_D(v[3], v[14]) CE_D(v[4], v[8]) CE_D(v[5], v[6]) CE_D(v[7], v[11]) CE_D(v[9], v[10])
  CE_D(v[0], v[5]) CE_D(v[1], v[7]) CE_D(v[2], v[9]) CE_D(v[3], v[4]) CE_D(v[6], v[13]) CE_D(v[8], v[14]) CE_D(v[10], v[15]) CE_D(v[11], v[12])
  CE_D(v[0], v[1]) CE_D(v[2], v[3]) CE_D(v[4], v[5]) CE_D(v[6], v[8]) CE_D(v[7], v[9]) CE_D(v[10], v[11]) CE_D(v[12], v[13]) CE_D(v[14], v[15])
  CE_D(v[0], v[2]) CE_D(v[1], v[3]) CE_D(v[4], v[10]) CE_D(v[5], v[11]) CE_D(v[6], v[7]) CE_D(v[8], v[9]) CE_D(v[12], v[14]) CE_D(v[13], v[15])
  CE_D(v[1], v[2]) CE_D(v[3], v[12]) CE_D(v[4], v[6]) CE_D(v[5], v[7]) CE_D(v[8], v[10]) CE_D(v[9], v[11]) CE_D(v[13], v[14])
  CE_D(v[1], v[4]) CE_D(v[2], v[6]) CE_D(v[5], v[8]) CE_D(v[7], v[10]) CE_D(v[9], v[13]) CE_D(v[11], v[14])
  CE_D(v[2], v[4]) CE_D(v[3], v[6]) CE_D(v[9], v[12]) CE_D(v[11], v[13])
  CE_D(v[3], v[5]) CE_D(v[6], v[8]) CE_D(v[7], v[9]) CE_D(v[10], v[12])
  CE_D(v[3], v[4]) CE_D(v[5], v[6]) CE_D(v[7], v[8]) CE_D(v[9], v[10]) CE_D(v[11], v[12])
  CE_D(v[6], v[7]) CE_D(v[8], v[9])
}
__device__ __forceinline__ void bitonic16_desc(int (&v)[16]) {
#pragma unroll
  for (int d = 8; d >= 1; d >>= 1)
#pragma unroll
    for (int i = 0; i < 16; ++i)
      if ((i & d) == 0) CE_D(v[i], v[i + d])
}
__device__ __forceinline__ void p4_topk_store(const f32x16 (&sacc)[4], int lane, unsigned* dstp) {
  const int half = lane >> 5;
  int L[16];
#pragma unroll
  for (int g = 0; g < 4; ++g) {
    int G[16];
#pragma unroll
    for (int r = 0; r < 16; ++r) {
      int k = (int)((__float_as_uint(sacc[g][r]) & ~127u) | (unsigned)(g * 32 + 8 * (r >> 2) + (r & 3))) | (half << 2);
      k ^= (k >> 31) & 0x7fffffff;
      G[r] = k;
    }
    sort16_desc(G);
    if (g == 0) {
#pragma unroll
      for (int k = 0; k < 16; ++k) L[k] = G[k];
    } else {
#pragma unroll
      for (int k = 0; k < 16; ++k) L[k] = max(L[k], G[15 - k]);
      bitonic16_desc(L);
    }
  }
  int M[16];
#pragma unroll
  for (int k = 0; k < 16; ++k) {
    auto sw = __builtin_amdgcn_permlane32_swap(L[15 - k], L[15 - k], false, false);
    M[k] = max(L[k], half ? (int)sw[0] : (int)sw[1]);
  }
  bitonic16_desc(M);
  if (half == 0) {
    uint4* dst = (uint4*)dstp;
#pragma unroll
    for (int q = 0; q < 4; ++q) {
      uint4 o;
      o.x = (unsigned)(M[4 * q + 0] ^ ((M[4 * q + 0] >> 31) & 0x7fffffff));
      o.y = (unsigned)(M[4 * q + 1] ^ ((M[4 * q + 1] >> 31) & 0x7fffffff));
      o.z = (unsigned)(M[4 * q + 2] ^ ((M[4 * q + 2] >> 31) & 0x7fffffff));
      o.w = (unsigned)(M[4 * q + 3] ^ ((M[4 * q + 3] >> 31) & 0x7fffffff));
      dst[q] = o;
    }
  }
}

__device__ __forceinline__ void p4_tile(const WS& w, int tile, char* smem) {
  const int it = tile >> 8, b = tile & 255, g = b & 7, j = b >> 3;
  const int mt = it * 32 + g * 4 + (j >> 3), hpp = j & 7;
  const int m0 = mt * 256, n0 = hpp * 256;
  const int tid = tid_fresh(), lane = tid & 63, wid = tid >> 6, wm = wid >> 2, wn = wid & 3;
  const int l31 = lane & 31, half = lane >> 5;
  float* rls = (float*)(smem + G256_LDS_BYTES);
  if (tid < 256) {
    const float4* p = (const float4*)(w.ssq_h1 + (size_t)(m0 + tid) * 16);
    float s = 0.f;
#pragma unroll
    for (int i = 0; i < 4; ++i) { float4 v = p[i]; s += v.x + v.y + v.z + v.w; }
    rls[tid] = rsqrtf(s * (1.f / 1024.f) + EPS);
  }
  f32x16 acc[4][2];
#pragma unroll
  for (int mi = 0; mi < 4; ++mi)
#pragma unroll
    for (int ni = 0; ni < 2; ++ni)
#pragma unroll
      for (int r = 0; r < 16; ++r) acc[mi][ni][r] = 0.f;
  gemm_core256<false, 2048, true, true>(w.h1b, w.WqT, m0, n0, smem, acc, nullptr);
  PROBE_MARK(PSM(smem), 13);
  char* qs = smem;
  char* ksm = smem + 65536;
  const u16* kp = w.keysb + (size_t)(2 * hpp) * 128 * 128 + (tid >> 4) * 128 + (tid & 15) * 8;
  u32x4 kr0, kr1, kr2, kr3;
#define KR_LOAD(kp_) do { kr0 = *(const u32x4*)(kp_); kr1 = *(const u32x4*)((kp_) + 32 * 128); \
    kr2 = *(const u32x4*)((kp_) + 64 * 128); kr3 = *(const u32x4*)((kp_) + 96 * 128); } while (0)
  KR_LOAD(kp);
  unsigned* cdst = w.cand + ((size_t)(m0 + wid * 32 + l31) * 16 + 2 * hpp) * 16;
#pragma unroll
  for (int hl = 0; hl < 2; ++hl) {
#pragma unroll
    for (int mi = 0; mi < 4; ++mi) {
      const int row = wm * 128 + mi * 32 + l31;
      const float rs = rls[row];
#pragma unroll
      for (int gq = 0; gq < 4; ++gq) {
        uint2 pk;
        pk.x = f2bf2(rs * acc[mi][hl][4 * gq + 0], rs * acc[mi][hl][4 * gq + 1]);
        pk.y = f2bf2(rs * acc[mi][hl][4 * gq + 2], rs * acc[mi][hl][4 * gq + 3]);
        *(uint2*)(qs + swz256(row, wn * 4 + gq) + 8 * half) = pk;
      }
    }
    *(u32x4*)(ksm + swz256((tid >> 4), tid & 15)) = kr0;
    *(u32x4*)(ksm + swz256((tid >> 4) + 32, tid & 15)) = kr1;
    *(u32x4*)(ksm + swz256((tid >> 4) + 64, tid & 15)) = kr2;
    *(u32x4*)(ksm + swz256((tid >> 4) + 96, tid & 15)) = kr3;
    __syncthreads();
    if (hl == 0) { KR_LOAD(kp + 128 * 128); PROBE_MARK(PSM(smem), 14); }
    f32x16 sacc[4];
#pragma unroll
    for (int ni = 0; ni < 4; ++ni)
#pragma unroll
      for (int r = 0; r < 16; ++r) sacc[ni][r] = 0.f;
#pragma unroll
    for (int ks = 0; ks < 8; ++ks) {
      const int c = ks * 2 + half;
      const bf16x8 af = *(const bf16x8*)(qs + swz256(wid * 32 + l31, c));
#pragma unroll
      for (int ni = 0; ni < 4; ++ni) {
        const bf16x8 bfr = *(const bf16x8*)(ksm + swz256(ni * 32 + l31, c));
        sacc[ni] = __builtin_amdgcn_mfma_f32_32x32x16_bf16(bfr, af, sacc[ni], 0, 0, 0);
      }
    }
    if (hl == 0) PROBE_MARK(PSM(smem), 15);
    p4_topk_store(sacc, lane, cdst + hl * 16);
    __syncthreads();
  }
#undef KR_LOAD
  PROBE_MARK(PSM(smem), 16);
}

typedef __attribute__((ext_vector_type(2))) __bf16 bf16x2_t;
__device__ __forceinline__ float dot2bf(unsigned a, unsigned b, float c) {
  return __builtin_amdgcn_fdot2_f32_bf16(__builtin_bit_cast(bf16x2_t, a), __builtin_bit_cast(bf16x2_t, b), c, false);
}
__device__ __forceinline__ float dot8bf(uint4 a, uint4 b, float c) {
  c = dot2bf(a.x, b.x, c); c = dot2bf(a.y, b.y, c); c = dot2bf(a.z, b.z, c); c = dot2bf(a.w, b.w, c);
  return c;
}
__device__ __forceinline__ void axpy8(float (&acc)[8], float wgt, uint4 v) {
  acc[0] += wgt * __uint_as_float(v.x << 16); acc[1] += wgt * __uint_as_float(v.x & 0xffff0000u);
  acc[2] += wgt * __uint_as_float(v.y << 16); acc[3] += wgt * __uint_as_float(v.y & 0xffff0000u);
  acc[4] += wgt * __uint_as_float(v.z << 16); acc[5] += wgt * __uint_as_float(v.z & 0xffff0000u);
  acc[6] += wgt * __uint_as_float(v.w << 16); acc[7] += wgt * __uint_as_float(v.w & 0xffff0000u);
}

__device__ __forceinline__ void p5_route_load(const WS& w, int t, int ca, int cb, unsigned (&pa)[8], unsigned (&pb)[8], float& sq) {
  const int lane = threadIdx.x & 63;
  const unsigned* cp = w.cand + (size_t)t * 256;
#pragma unroll
  for (int h = 0; h < 8; ++h) {
    pa[h] = cp[(2 * h) * 16 + ca];
    pb[h] = cp[(2 * h + 1) * 16 + cb];
  }
  sq = (lane < 16) ? w.ssq_h1[(size_t)t * 16 + lane] : 0.f;
}
__device__ __forceinline__ void p5_route_compute(const WS& w, int t, const unsigned (&pa)[8], const unsigned (&pb)[8], float sq, float* keys  ) {
  const int lane = threadIdx.x & 63;
  float s[8]; int e[8];
#pragma unroll
  for (int h = 0; h < 8; ++h) {
    const float sv = __uint_as_float(pa[h]) + __uint_as_float(pb[h]);
    e[h] = (int)(pa[h] & 127u) * 128 + (int)(pb[h] & 127u);
    s[h] = (lane < 50) ? __uint_as_float((__float_as_uint(sv) & ~63u) | (unsigned)lane) : -3.0e38f;
    keys[h * 64 + lane] = s[h];
  }
  __builtin_amdgcn_fence(__ATOMIC_RELEASE, "wavefront");
  __builtin_amdgcn_wave_barrier();
  __builtin_amdgcn_fence(__ATOMIC_ACQUIRE, "wavefront");
#pragma unroll
  for (int h = 0; h < 8; ++h) {
    int rank = 0;
    const float4* kp = (const float4*)(keys + h * 64);
#pragma unroll
    for (int j4 = 0; j4 < 13; ++j4) {
      const float4 k4 = kp[j4];
      rank += (k4.x > s[h]) ? 1 : 0;
      rank += (k4.y > s[h]) ? 1 : 0;
      if (j4 * 4 + 2 < 50) rank += (k4.z > s[h]) ? 1 : 0;
      if (j4 * 4 + 3 < 50) rank += (k4.w > s[h]) ? 1 : 0;
    }
    const bool sel = (lane < 50) && (rank < 16);
    const unsigned long long top = __ballot(rank == 0 && lane < 50);
    const float mx = __int_as_float(__builtin_amdgcn_readlane(__float_as_int(s[h]), (int)__builtin_ctzll(top)));
    const float ex = sel ? __expf(s[h] - mx) : 0.f;
    const float sum = wave_sum(ex);
    if (sel) {
      w.sel_e[(size_t)t * 128 + ((h * 16 + rank) & 7) * 16 + ((h * 16 + rank) >> 3)] = (u16)e[h];
      w.gate[(size_t)t * 128 + h * 16 + rank] = ex * frcp(sum);
    }
  }
  const float sqs = wave_sum(sq);
  if (lane == 0) w.rs2v[t] = rsqrtf(sqs * (1.f / 1024.f) + EPS);
  __builtin_amdgcn_fence(__ATOMIC_RELEASE, "wavefront");
  __builtin_amdgcn_wave_barrier();
  __builtin_amdgcn_fence(__ATOMIC_ACQUIRE, "wavefront");
}

__device__ __forceinline__ void p5_route8(const WS& w, int tbase, unsigned* lds) {
  const int lane = threadIdx.x & 63, tk = lane >> 3, h = lane & 7;
  const int t = tbase + tk;
  const bool tv = t < T_TOK;
  const int tc = tv ? t : (T_TOK - 1);
  const uint4* cp = (const uint4*)(w.cand + ((size_t)tc * 16 + 2 * h) * 16);
  unsigned A[16], B[16];
#pragma unroll
  for (int q = 0; q < 4; ++q) { const uint4 v = cp[q]; A[4 * q] = v.x; A[4 * q + 1] = v.y; A[4 * q + 2] = v.z; A[4 * q + 3] = v.w; }
#pragma unroll
  for (int q = 0; q < 4; ++q) { const uint4 v = cp[4 + q]; B[4 * q] = v.x; B[4 * q + 1] = v.y; B[4 * q + 2] = v.z; B[4 * q + 3] = v.w; }
  {
    const float2 sq2 = *(const float2*)(w.ssq_h1 + (size_t)tc * 16 + 2 * h);
    float sq = sq2.x + sq2.y;
    sq += __int_as_float(__builtin_amdgcn_update_dpp(0, __float_as_int(sq), 0xB1, 0xF, 0xF, true));
    sq += __int_as_float(__builtin_amdgcn_update_dpp(0, __float_as_int(sq), 0x4E, 0xF, 0xF, true));
    sq += __int_as_float(__builtin_amdgcn_update_dpp(0, __float_as_int(sq), 0x141, 0xF, 0xF, true));
    if (h == 0 && tv) w.rs2v[t] = rsqrtf(sq * (1.f / 1024.f) + EPS);
  }
  unsigned* ml = lds + lane * 33;
#pragma unroll
  for (int j = 0; j < 16; ++j) { ml[j] = A[j] & 127u; ml[16 + j] = B[j] & 127u; }
  int X[64];
  {
    int n = 0;
#pragma unroll
    for (int a = 0; a < 16; ++a)
#pragma unroll
      for (int b = 0; b < 16; ++b)
        if ((a + 1) * (b + 1) <= 16) {
          const float s = __uint_as_float(A[a]) + __uint_as_float(B[b]);
          int x = (int)((__float_as_uint(s) & ~255u) | (unsigned)(a * 16 + b));
          x ^= (x >> 31) & 0x7fffffff;
          X[n++] = x;
        }
#pragma unroll
    for (int k = 50; k < 64; ++k) X[k] = (int)0x80000000;
  }
  int L[16];
#pragma unroll
  for (int k = 0; k < 16; ++k) L[k] = X[k];
  sort16_desc(L);
#pragma unroll
  for (int g = 1; g < 4; ++g) {
    int G[16];
#pragma unroll
    for (int k = 0; k < 16; ++k) G[k] = X[g * 16 + k];
    sort16_desc(G);
#pragma unroll
    for (int k = 0; k < 16; ++k) L[k] = max(L[k], G[15 - k]);
    bitonic16_desc(L);
  }
  __builtin_amdgcn_fence(__ATOMIC_RELEASE, "wavefront");
  __builtin_amdgcn_wave_barrier();
  __builtin_amdgcn_fence(__ATOMIC_ACQUIRE, "wavefront");
  float sv[16]; unsigned ab[16];
#pragma unroll
  for (int k = 0; k < 16; ++k) {
    const int kk = L[k] ^ ((L[k] >> 31) & 0x7fffffff);
    ab[k] = (unsigned)kk & 255u;
    sv[k] = __int_as_float(kk);
  }
  float sum = 0.f;
  const float smax = sv[0];
#pragma unroll
  for (int k = 0; k < 16; ++k) { sv[k] = __expf(sv[k] - smax); sum += sv[k]; }
  const float inv = frcp(sum);
  if (tv) {
#pragma unroll
    for (int k = 0; k < 16; ++k) {
      const unsigned e = ml[ab[k] >> 4] * 128u + ml[16 + (ab[k] & 15u)];
      const int p = h * 16 + k;
      w.sel_e[(size_t)t * 128 + (p & 7) * 16 + (p >> 3)] = (u16)e;
      w.gate[(size_t)t * 128 + p] = sv[k] * inv;
    }
  }
  __builtin_amdgcn_fence(__ATOMIC_RELEASE, "wavefront");
  __builtin_amdgcn_wave_barrier();
  __builtin_amdgcn_fence(__ATOMIC_ACQUIRE, "wavefront");
}

__device__ __forceinline__ f32x2 fp8lo(unsigned d) { return __builtin_amdgcn_cvt_pk_f32_fp8((int)d, false); }
__device__ __forceinline__ f32x2 fp8hi(unsigned d) { return __builtin_amdgcn_cvt_pk_f32_fp8((int)d, true); }
__device__ __forceinline__ bf2v fp8lo_b(unsigned d) { return __builtin_amdgcn_cvt_scalef32_pk_bf16_fp8((int)d, 1.0f, false); }
__device__ __forceinline__ bf2v fp8hi_b(unsigned d) { return __builtin_amdgcn_cvt_scalef32_pk_bf16_fp8((int)d, 1.0f, true); }
typedef __attribute__((ext_vector_type(2))) _Float16 h2v;
__device__ __forceinline__ h2v fp8lo_h(unsigned d) { return __builtin_amdgcn_cvt_scalef32_pk_f16_fp8((int)d, 1.0f, false); }
__device__ __forceinline__ h2v fp8hi_h(unsigned d) { return __builtin_amdgcn_cvt_scalef32_pk_f16_fp8((int)d, 1.0f, true); }
#define BFX(d) __builtin_bit_cast(bf2v, (unsigned)(d))

__device__ __forceinline__ unsigned eT_get(const u32x4& a, const u32x4& b, int i) {
  const unsigned wds[8] = {a.x, a.y, a.z, a.w, b.x, b.y, b.z, b.w};
  return (i & 1) ? (wds[i >> 1] >> 16) : (wds[i >> 1] & 0xffffu);
}
__device__ __forceinline__ void eT_load(const WS& w, int t, u32x4& a, u32x4& b) {
  const u32x4* p = (const u32x4*)(w.sel_e + (unsigned)(t * 128 + ((threadIdx.x & 63) >> 3) * 16));
  a = p[0]; b = p[1];
}
__device__ __forceinline__ void u_issue(const WS& w, int t, int s, const u32x4& ea, const u32x4& eb, u32x4 (&u)[16], u32x4& xa, u32x4& xb) {
  const int lane = threadIdx.x & 63;
  const char* ub = (const char*)w.Ub;
  const unsigned uoff = (unsigned)s * (16384u * 128u) + (unsigned)(lane & 7) * 16u;
#pragma unroll
  for (int i = 0; i < 16; ++i) u[i] = *(const u32x4*)(ub + (uoff + eT_get(ea, eb, i) * 128u));
  const u16* xp = w.h1b + AIDX(t, s * 128 + (lane & 7) * 16);
  xa = *(const u32x4*)xp; xb = *(const u32x4*)(xp + 8);
}
__device__ __forceinline__ void u_compute(const WS& w, int t, int s, const u32x4 (&u)[16], const u32x4& xa, const u32x4& xb, bool valid) {
  const int lane = threadIdx.x & 63;
  float p[16];
#pragma unroll
  for (int i = 0; i < 16; ++i) {
    float a = 0.f;
    a = __builtin_amdgcn_fdot2_f32_bf16(fp8lo_b(u[i].x), BFX(xa.x), a, false); a = __builtin_amdgcn_fdot2_f32_bf16(fp8hi_b(u[i].x), BFX(xa.y), a, false);
    a = __builtin_amdgcn_fdot2_f32_bf16(fp8lo_b(u[i].y), BFX(xa.z), a, false); a = __builtin_amdgcn_fdot2_f32_bf16(fp8hi_b(u[i].y), BFX(xa.w), a, false);
    a = __builtin_amdgcn_fdot2_f32_bf16(fp8lo_b(u[i].z), BFX(xb.x), a, false); a = __builtin_amdgcn_fdot2_f32_bf16(fp8hi_b(u[i].z), BFX(xb.y), a, false);
    a = __builtin_amdgcn_fdot2_f32_bf16(fp8lo_b(u[i].w), BFX(xb.z), a, false); a = __builtin_amdgcn_fdot2_f32_bf16(fp8hi_b(u[i].w), BFX(xb.w), a, false);
    p[i] = a;
  }
  {
    const unsigned m4 = (unsigned)(-(int)((lane >> 2) & 1)), m2 = (unsigned)(-(int)((lane >> 1) & 1)), m1 = (unsigned)(-(int)(lane & 1));
#pragma unroll
    for (int c = 0; c < 8; ++c) {
      const unsigned x0 = __float_as_uint(p[c]), x1 = __float_as_uint(p[c + 8]);
      const unsigned send = (x0 & m4) | (x1 & ~m4), keep = (x1 & m4) | (x0 & ~m4);
      p[c] = __uint_as_float(keep) + __int_as_float(__builtin_amdgcn_update_dpp(0, (int)send, 0x141, 0xf, 0xf, true));
    }
#pragma unroll
    for (int c = 0; c < 4; ++c) {
      const unsigned x0 = __float_as_uint(p[c]), x1 = __float_as_uint(p[c + 4]);
      const unsigned send = (x0 & m2) | (x1 & ~m2), keep = (x1 & m2) | (x0 & ~m2);
      p[c] = __uint_as_float(keep) + __int_as_float(__builtin_amdgcn_update_dpp(0, (int)send, 0x4E, 0xf, 0xf, true));
    }
#pragma unroll
    for (int c = 0; c < 2; ++c) {
      const unsigned x0 = __float_as_uint(p[c]), x1 = __float_as_uint(p[c + 2]);
      const unsigned send = (x0 & m1) | (x1 & ~m1), keep = (x1 & m1) | (x0 & ~m1);
      p[c] = __uint_as_float(keep) + __int_as_float(__builtin_amdgcn_update_dpp(0, (int)send, 0xB1, 0xf, 0xf, true));
    }
  }
  const _Float16 h0 = (_Float16)(p[0] * (1.f / PEER_SU)), h1v = (_Float16)(p[1] * (1.f / PEER_SU));
  const unsigned pk = (unsigned)__builtin_bit_cast(unsigned short, h0) | ((unsigned)__builtin_bit_cast(unsigned short, h1v) << 16);
  if (valid) w.part[((size_t)t * 8 + s) * 64 + lane] = pk;
}
__device__ __forceinline__ void u_sweep(const WS& w, int s, int t0, int stride) {
  const int n = (t0 < T_TOK) ? (T_TOK - t0 + stride - 1) / stride : 0;
  if (n <= 0) return;
  const int lane = threadIdx.x & 63;
#define TT(i) (t0 + min((i), n - 1) * stride)
  u32x4 uA[16], uB[16], xaA, xbA, xaB, xbB;
  u32x4 eA0, eA1, eB0, eB1;
  eT_load(w, TT(0), eA0, eA1);
  eT_load(w, TT(1), eB0, eB1);
  u_issue(w, TT(0), s, eA0, eA1, uA, xaA, xbA);
#pragma unroll 1
  for (int i = 0; i < n; i += 2) {
    eT_load(w, TT(i + 2), eA0, eA1);
    u_issue(w, TT(i + 1), s, eB0, eB1, uB, xaB, xbB);
    u_compute(w, TT(i), s, uA, xaA, xbA, i < n);
    eT_load(w, TT(i + 3), eB0, eB1);
    u_issue(w, TT(i + 2), s, eA0, eA1, uA, xaA, xbA);
    u_compute(w, TT(i + 1), s, uB, xaB, xbB, i + 1 < n);
  }
#undef TT
}
typedef __attribute__((ext_vector_type(8))) int i32x8;
__device__ __forceinline__ void um_issue(const WS& w, int t, int s, const u32x4& ea, const u32x4& eb, u32x4 (&u)[16], u32x4 (&xr)[4]) {
  const int lane = threadIdx.x & 63, g = lane >> 4;
  const u32x4* xp = (const u32x4*)(w.h1q + (size_t)t * 1024 + s * 256 + g * 16);
  xr[0] = xp[0]; xr[1] = xp[4]; xr[2] = xp[8]; xr[3] = xp[12];
  const char* ub = (const char*)w.Ub;
  const unsigned uoff = (unsigned)s * (16384u * 128u) + (unsigned)(lane & 7) * 16u;
#pragma unroll
  for (int i = 0; i < 16; ++i) u[i] = *(const u32x4*)(ub + (uoff + eT_get(ea, eb, i) * 128u));
}
__device__ __forceinline__ int fp8x4(unsigned a, unsigned b) {
  const f32x2 p = bfpair(a), q = bfpair(b);
  int v = __builtin_amdgcn_cvt_pk_fp8_f32(p.x, p.y, 0, false);
  return __builtin_amdgcn_cvt_pk_fp8_f32(q.x, q.y, v, true);
}
__device__ __forceinline__ void um_compute(const WS& w, int t, int s, const u32x4 (&u)[16], const u32x4 (&xr)[4], char* lbuf) {
  const int lane = threadIdx.x & 63, n = lane & 15, g = lane >> 4;
  {
    const int q = lane >> 3, c = lane & 7;
    char* wb = lbuf + q * 128 + ((c ^ q) << 4);
#pragma unroll
    for (int i = 0; i < 16; ++i) *(u32x4*)(wb + i * 1024) = u[i];
  }
  i32x8 b0, b1;
  b0[0] = (int)xr[0].x; b0[1] = (int)xr[0].y; b0[2] = (int)xr[0].z; b0[3] = (int)xr[0].w;
  b0[4] = (int)xr[1].x; b0[5] = (int)xr[1].y; b0[6] = (int)xr[1].z; b0[7] = (int)xr[1].w;
  b1[0] = (int)xr[2].x; b1[1] = (int)xr[2].y; b1[2] = (int)xr[2].z; b1[3] = (int)xr[2].w;
  b1[4] = (int)xr[3].x; b1[5] = (int)xr[3].y; b1[6] = (int)xr[3].z; b1[7] = (int)xr[3].w;
  const char* rb0 = lbuf + n * 128 + ((g ^ (n & 7)) << 4);
  const char* rb1 = lbuf + n * 128 + (((4 + g) ^ (n & 7)) << 4);
  float o[8];
#pragma unroll
  for (int m = 0; m < 8; ++m) {
    const u32x4 a0 = *(const u32x4*)(rb0 + m * 2048), a1 = *(const u32x4*)(rb1 + m * 2048);
    i32x8 av0, av1;
    av0[0] = (int)a0.x; av0[1] = (int)a0.y; av0[2] = (int)a0.z; av0[3] = (int)a0.w; av0[4] = 0; av0[5] = 0; av0[6] = 0; av0[7] = 0;
    av1[0] = (int)a1.x; av1[1] = (int)a1.y; av1[2] = (int)a1.z; av1[3] = (int)a1.w; av1[4] = 0; av1[5] = 0; av1[6] = 0; av1[7] = 0;
    f32x4 c = {0.f, 0.f, 0.f, 0.f};
    c = __builtin_amdgcn_mfma_scale_f32_16x16x128_f8f6f4(av0, b0, c, 4, 0, 0, 0x7F7F7F7F, 0, 0x7F7F7F7F);
    c = __builtin_amdgcn_mfma_scale_f32_16x16x128_f8f6f4(av1, b1, c, 4, 0, 0, 0x7F7F7F7F, 0, 0x7F7F7F7F);
    const float lo = (n & 1) ? c[1] : c[0], hi = (n & 1) ? c[3] : c[2];
    o[m] = (n & 2) ? hi : lo;
  }
  const float a0 = (n & 4) ? o[2] : o[0], a1 = (n & 4) ? o[3] : o[1];
  const float c0 = (n & 4) ? o[6] : o[4], c1 = (n & 4) ? o[7] : o[5];
  const float v0 = ((n & 8) ? c0 : a0) * (1.f / PEER_SU4), v1 = ((n & 8) ? c1 : a1) * (1.f / PEER_SU4);
  w.part[((size_t)t * 4 + s) * 64 + 16 * g + 4 * (n & 3) + (n >> 2)] = __builtin_bit_cast(unsigned, __builtin_amdgcn_cvt_pkrtz(v0, v1));
}
__device__ __forceinline__ void um_sweep(const WS& w, int s, int t0, int stride, char* lbuf) {
  const int n = (t0 < T_TOK) ? (T_TOK - t0 + stride - 1) / stride : 0;
  if (n <= 0) return;
#define TT(i) (t0 + min((i), n - 1) * stride)
  u32x4 uA[16], uB[16], xA[4], xB[4], eA0, eA1, eB0, eB1;
  eT_load(w, TT(0), eA0, eA1);
  eT_load(w, TT(1), eB0, eB1);
  um_issue(w, TT(0), s, eA0, eA1, uA, xA);
#pragma unroll 1
  for (int i = 0; i < n; i += 2) {
    eT_load(w, TT(i + 2), eA0, eA1);
    um_issue(w, TT(i + 1), s, eB0, eB1, uB, xB);
    __builtin_amdgcn_sched_barrier(0);
    um_compute(w, TT(i), s, uA, xA, lbuf);
    __builtin_amdgcn_sched_barrier(0);
    eT_load(w, TT(i + 3), eB0, eB1);
    um_issue(w, TT(i + 2), s, eA0, eA1, uA, xA);
    __builtin_amdgcn_sched_barrier(0);
    um_compute(w, TT(i + 1), s, uB, xB, lbuf);
    __builtin_amdgcn_sched_barrier(0);
  }
#undef TT
}
__device__ __forceinline__ void p5_token_slice(const WS& w, int t, int s) {
  const int lane = threadIdx.x & 63;
  u32x4 ea, eb; eT_load(w, t, ea, eb);
  u32x4 u[16], xa, xb;
  u_issue(w, t, s, ea, eb, u, xa, xb);
  u_compute(w, t, s, u, xa, xb, true);
}

__device__ __forceinline__ void p5_wphase(const WS& w, int t) {
  const int lane = threadIdx.x & 63;
  float d0 = 0.f, d1 = 0.f;
#pragma unroll
  for (int s = 0; s < 4; ++s) {
    const unsigned pk = w.part[((size_t)t * 4 + s) * 64 + lane];
    d0 += (float)__builtin_bit_cast(_Float16, (unsigned short)(pk & 0xffffu));
    d1 += (float)__builtin_bit_cast(_Float16, (unsigned short)(pk >> 16));
  }
  const float rs2 = w.rs2v[t];
  const int r = 4 * (lane >> 4) + ((lane >> 2) & 3), mp = lane & 3;
  const int pos0 = 16 * (r & 7) + (r >> 3) + 4 * mp, pos1 = pos0 + 2;
  const int p0 = (pos0 & 15) * 8 + (pos0 >> 4), p1 = (pos1 & 15) * 8 + (pos1 >> 4);
  const float w0 = w.gate[(size_t)t * 128 + p0] * gelu_tanh(rs2 * d0) * PEER_WS8, w1 = w.gate[(size_t)t * 128 + p1] * gelu_tanh(rs2 * d1) * PEER_WS8;
  const int pk = __builtin_amdgcn_cvt_pk_fp8_f32(w0, w1, 0, false);
  unsigned char* wq8 = (unsigned char*)w.wgt + (size_t)t * 128 + 32 * mp + r;
  wq8[0] = (unsigned char)(pk & 0xff);
  wq8[16] = (unsigned char)((pk >> 8) & 0xff);
}

template <int NT>
__device__ __forceinline__ void p5_wphase4(const WS& w, int t, int st) {
  const int lane = threadIdx.x & 63;
  const int r = 4 * (lane >> 4) + ((lane >> 2) & 3), mp = lane & 3;
  const int pos0 = 16 * (r & 7) + (r >> 3) + 4 * mp, pos1 = pos0 + 2;
  const int p0 = (pos0 & 15) * 8 + (pos0 >> 4), p1 = (pos1 & 15) * 8 + (pos1 >> 4);
  unsigned pk[NT][4]; float g0[NT], g1[NT], rs[NT];
#pragma unroll
  for (int k = 0; k < NT; ++k) {
    const size_t tk = (size_t)(t + k * st);
#pragma unroll
    for (int s = 0; s < 4; ++s) pk[k][s] = w.part[(tk * 4 + s) * 64 + lane];
    g0[k] = w.gate[tk * 128 + p0]; g1[k] = w.gate[tk * 128 + p1]; rs[k] = w.rs2v[tk];
  }
#pragma unroll
  for (int k = 0; k < NT; ++k) {
    float d0 = 0.f, d1 = 0.f;
#pragma unroll
    for (int s = 0; s < 4; ++s) {
      d0 += (float)__builtin_bit_cast(_Float16, (unsigned short)(pk[k][s] & 0xffffu));
      d1 += (float)__builtin_bit_cast(_Float16, (unsigned short)(pk[k][s] >> 16));
    }
    const float w0 = g0[k] * gelu_tanh(rs[k] * d0) * PEER_WS8, w1 = g1[k] * gelu_tanh(rs[k] * d1) * PEER_WS8;
    const int q = __builtin_amdgcn_cvt_pk_fp8_f32(w0, w1, 0, false);
    unsigned char* wq8 = (unsigned char*)w.wgt + (size_t)(t + k * st) * 128 + 32 * mp + r;
    wq8[0] = (unsigned char)(q & 0xff);
    wq8[16] = (unsigned char)((q >> 8) & 0xff);
  }
}

__device__ __forceinline__ int v_col(int s, int lane) {
  return s * 128 + (lane & 7) * 16 + ((lane >> 5) & 1) * 8 + ((lane >> 4) & 1) * 4 + ((lane >> 3) & 1) * 2;
}
__device__ __forceinline__ void wT_load(const WS& w, int t, u32x4& a, u32x4& b) {
  const u32x4* p = (const u32x4*)((const u16*)w.wgt + (unsigned)(t * 128 + ((threadIdx.x & 63) >> 3) * 16));
  a = p[0]; b = p[1];
}
__device__ __forceinline__ void v_issue(const WS& w, int t, int s, const u32x4& ea, const u32x4& eb, u32x4 (&v)[16], float2& hin, const float* h1) {
  const int lane = threadIdx.x & 63;
  const char* vb = (const char*)w.Vb;
  const unsigned voff = (unsigned)s * (16384u * 128u) + (unsigned)(lane & 7) * 16u;
#pragma unroll
  for (int i = 0; i < 16; ++i) v[i] = *(const u32x4*)(vb + (voff + eT_get(ea, eb, i) * 128u));
  (void)hin; (void)h1;
}
__device__ __forceinline__ void v_compute(const WS& w, int t, int s, const u32x4 (&v)[16], const u32x4& wa, const u32x4& wb, float2 hin, float* out, bool valid) {
  const int lane = threadIdx.x & 63;
  const unsigned wds[8] = {wa.x, wa.y, wa.z, wa.w, wb.x, wb.y, wb.z, wb.w};
  h2v a2[8];
#pragma unroll
  for (int c = 0; c < 8; ++c) { a2[c].x = (_Float16)0.f; a2[c].y = (_Float16)0.f; }
#pragma unroll
  for (int i = 0; i < 16; ++i) {
    const h2v wp = __builtin_bit_cast(h2v, wds[i >> 1]);
    const _Float16 ws = (i & 1) ? wp.y : wp.x;
    h2v wv; wv.x = ws; wv.y = ws;
    a2[0] = __builtin_elementwise_fma(fp8lo_h(v[i].x), wv, a2[0]); a2[1] = __builtin_elementwise_fma(fp8hi_h(v[i].x), wv, a2[1]);
    a2[2] = __builtin_elementwise_fma(fp8lo_h(v[i].y), wv, a2[2]); a2[3] = __builtin_elementwise_fma(fp8hi_h(v[i].y), wv, a2[3]);
    a2[4] = __builtin_elementwise_fma(fp8lo_h(v[i].z), wv, a2[4]); a2[5] = __builtin_elementwise_fma(fp8hi_h(v[i].z), wv, a2[5]);
    a2[6] = __builtin_elementwise_fma(fp8lo_h(v[i].w), wv, a2[6]); a2[7] = __builtin_elementwise_fma(fp8hi_h(v[i].w), wv, a2[7]);
  }
#pragma unroll
  for (int c = 0; c < 4; ++c) {
    auto r = __builtin_amdgcn_permlane32_swap(__builtin_bit_cast(unsigned, a2[c]), __builtin_bit_cast(unsigned, a2[c + 4]), false, false);
    a2[c] = __builtin_bit_cast(h2v, (unsigned)r[0]) + __builtin_bit_cast(h2v, (unsigned)r[1]);
  }
#pragma unroll
  for (int c = 0; c < 2; ++c) {
    auto r = __builtin_amdgcn_permlane16_swap(__builtin_bit_cast(unsigned, a2[c]), __builtin_bit_cast(unsigned, a2[c + 2]), false, false);
    a2[c] = __builtin_bit_cast(h2v, (unsigned)r[0]) + __builtin_bit_cast(h2v, (unsigned)r[1]);
  }
  {
    const unsigned m = (unsigned)(-(int)((lane >> 3) & 1));
    const unsigned x0 = __builtin_bit_cast(unsigned, a2[0]), x1 = __builtin_bit_cast(unsigned, a2[1]);
    const unsigned send = (x0 & m) | (x1 & ~m);
    const unsigned keep = (x1 & m) | (x0 & ~m);
    const unsigned got = (unsigned)__builtin_amdgcn_update_dpp(0, (int)send, 0x128, 0xf, 0xf, true);
    a2[0] = __builtin_bit_cast(h2v, keep) + __builtin_bit_cast(h2v, got);
  }
  if (valid) w.ffn[(size_t)t * 512 + (v_col(s, lane) >> 1)] = __builtin_bit_cast(unsigned, a2[0]);
}
__device__ __forceinline__ void v_sweep(const WS& w, int s, int t0, int stride, const float* h1, float* out, bool dry) {
  const int n = (t0 < T_TOK) ? (T_TOK - t0 + stride - 1) / stride : 0;
  if (n <= 0) return;
  const int lane = threadIdx.x & 63;
#define TT(i) (t0 + min((i), n - 1) * stride)
  u32x4 vA[16], vB[16];
  float2 hA, hB;
  u32x4 eA0, eA1, eB0, eB1, wA0, wA1, wB0, wB1;
  eT_load(w, TT(0), eA0, eA1);
  eT_load(w, TT(1), eB0, eB1);
  wT_load(w, TT(0), wA0, wA1);
  v_issue(w, TT(0), s, eA0, eA1, vA, hA, h1);
#pragma unroll 1
  for (int i = 0; i < n; i += 2) {
    eT_load(w, TT(i + 2), eA0, eA1);
    wT_load(w, TT(i + 1), wB0, wB1);
    v_issue(w, TT(i + 1), s, eB0, eB1, vB, hB, h1);
    v_compute(w, TT(i), s, vA, wA0, wA1, hA, out, !dry);
    eT_load(w, TT(i + 3), eB0, eB1);
    wT_load(w, TT(i + 2), wA0, wA1);
    v_issue(w, TT(i + 2), s, eA0, eA1, vA, hA, h1);
    v_compute(w, TT(i + 1), s, vB, wB0, wB1, hB, out, !dry && (i + 1 < n));
  }
#undef TT
}
__device__ __forceinline__ void p6_token_slice(const WS& w, int t, int s, const float* h1, float* out, bool dry = false) {
  const int lane = threadIdx.x & 63;
  u32x4 ea, eb, wa, wb; eT_load(w, t, ea, eb); wT_load(w, t, wa, wb);
  u32x4 v[16]; float2 hin;
  v_issue(w, t, s, ea, eb, v, hin, h1);
  v_compute(w, t, s, v, wa, wb, hin, out, !dry);
}

typedef __attribute__((ext_vector_type(2))) int i32x2v;
typedef __attribute__((address_space(3))) i32x2v lds_i32x2v;
__device__ __forceinline__ void vm_issue(const WS& w, int t, int s, const u32x4& ea, const u32x4& eb, u32x4 (&u)[16], u32x4 (&wr)[2]) {
  const int lane = threadIdx.x & 63, g = lane >> 4;
  const u32x4* wp = (const u32x4*)((const char*)w.wgt + (size_t)t * 128 + g * 32);
  wr[0] = wp[0]; wr[1] = wp[1];
  const char* vb = (const char*)w.Vb;
  const unsigned voff = (unsigned)s * (16384u * 128u) + (unsigned)(lane & 7) * 16u;
#pragma unroll
  for (int i = 0; i < 16; ++i) u[i] = *(const u32x4*)(vb + (voff + eT_get(ea, eb, i) * 128u));
}
__device__ __forceinline__ void vm_compute(const WS& w, int t, int s, const u32x4 (&u)[16], const u32x4 (&wr)[2], char* lbuf) {
  const int lane = threadIdx.x & 63, n = lane & 15, g = lane >> 4;
  {
    const int q = lane >> 3, c = lane & 7;
    char* wb = lbuf + q * 128 + ((c ^ q) << 4);
#pragma unroll
    for (int i = 0; i < 16; ++i) *(u32x4*)(wb + i * 1024) = u[i];
  }
  i32x8 b;
  b[0] = (int)wr[0].x; b[1] = (int)wr[0].y; b[2] = (int)wr[0].z; b[3] = (int)wr[0].w;
  b[4] = (int)wr[1].x; b[5] = (int)wr[1].y; b[6] = (int)wr[1].z; b[7] = (int)wr[1].w;
  const int K0 = 64 * (g & 1) + 16 * (g >> 1);
  const char* rb = lbuf + (K0 + n) * 128;
  const int sw = n & 7;
  f32x4 sel[4];
#pragma unroll
  for (int G = 0; G < 4; ++G) {
    f32x4 c[4];
#pragma unroll
    for (int jj = 0; jj < 4; ++jj) {
      const int J = 4 * G + jj;
      const char* ap = rb + (((J >> 1) ^ sw) << 4) + (J & 1) * 8;
      const i32x2v t1 = __builtin_amdgcn_ds_read_tr4_b64_v2i32((lds_i32x2v*)ap);
      const i32x2v t2 = __builtin_amdgcn_ds_read_tr4_b64_v2i32((lds_i32x2v*)(ap + 32 * 128));
      i32x8 a;
      a[0] = t1.x; a[1] = t1.y; a[2] = t2.x; a[3] = t2.y; a[4] = 0; a[5] = 0; a[6] = 0; a[7] = 0;
      f32x4 z = {0.f, 0.f, 0.f, 0.f};
      c[jj] = __builtin_amdgcn_mfma_scale_f32_16x16x128_f8f6f4(a, b, z, 4, 0, 0, 0x7F7F7F7F, 0, 0x7F7F7F7F);
    }
#pragma unroll
    for (int r = 0; r < 4; ++r) {
      const float lo = (n & 1) ? c[1][r] : c[0][r], hi = (n & 1) ? c[3][r] : c[2][r];
      sel[G][r] = (n & 2) ? hi : lo;
    }
  }
  const float kk = PEER_SV / (PEER_SV4 * PEER_WS8);
  float o[4];
#pragma unroll
  for (int r = 0; r < 4; ++r) {
    const float lo = (n & 4) ? sel[1][r] : sel[0][r], hi = (n & 4) ? sel[3][r] : sel[2][r];
    o[r] = ((n & 8) ? hi : lo) * kk;
  }
  uint2 pk;
  pk.x = __builtin_bit_cast(unsigned, __builtin_amdgcn_cvt_pkrtz(o[0], o[1]));
  pk.y = __builtin_bit_cast(unsigned, __builtin_amdgcn_cvt_pkrtz(o[2], o[3]));
  *(uint2*)(w.ffn + (size_t)t * 512 + ((s * 256 + 16 * n + 4 * g) >> 1)) = pk;
}
__device__ __forceinline__ void vm_sweep(const WS& w, int s, int t0, int stride, char* lbuf) {
  const int n = (t0 < T_TOK) ? (T_TOK - t0 + stride - 1) / stride : 0;
  if (n <= 0) return;
#define TT(i) (t0 + min((i), n - 1) * stride)
  u32x4 uA[16], uB[16], wA[2], wB[2], eA0, eA1, eB0, eB1;
  eT_load(w, TT(0), eA0, eA1);
  eT_load(w, TT(1), eB0, eB1);
  vm_issue(w, TT(0), s, eA0, eA1, uA, wA);
#pragma unroll 1
  for (int i = 0; i < n; i += 2) {
    eT_load(w, TT(i + 2), eA0, eA1);
    vm_issue(w, TT(i + 1), s, eB0, eB1, uB, wB);
    __builtin_amdgcn_sched_barrier(0);
    vm_compute(w, TT(i), s, uA, wA, lbuf);
    __builtin_amdgcn_sched_barrier(0);
    eT_load(w, TT(i + 3), eB0, eB1);
    vm_issue(w, TT(i + 2), s, eA0, eA1, uA, wA);
    __builtin_amdgcn_sched_barrier(0);
    vm_compute(w, TT(i + 1), s, uB, wB, lbuf);
    __builtin_amdgcn_sched_barrier(0);
  }
#undef TT
}

__device__ __forceinline__ void p7_row(const WS& w, int t, const float* __restrict__ gF, float* out, bool dry = false) {
  const int lane = threadIdx.x & 63;
  float4* orow = (float4*)(out + (size_t)t * 1024);
  const uint2* frow = (const uint2*)(w.ffn + (size_t)t * 512);
  float4 v[4]; uint2 f[4], hb[4];
#pragma unroll
  for (int i = 0; i < 4; ++i) { hb[i] = *(const uint2*)(w.h1b + AIDX(t, (i * 64 + lane) * 4)); f[i] = frow[i * 64 + lane]; }
#pragma unroll
  for (int i = 0; i < 4; ++i) {
    const f32x2 lo = bfpair(hb[i].x), hi = bfpair(hb[i].y);
    v[i].x = lo.x; v[i].y = lo.y; v[i].z = hi.x; v[i].w = hi.y;
  }
  float ss = 0.f;
#pragma unroll
  for (int i = 0; i < 4; ++i) {
    const h2v f0 = __builtin_bit_cast(h2v, f[i].x), f1 = __builtin_bit_cast(h2v, f[i].y);
    v[i].x += (float)f0.x * (1.f / PEER_SV); v[i].y += (float)f0.y * (1.f / PEER_SV);
    v[i].z += (float)f1.x * (1.f / PEER_SV); v[i].w += (float)f1.y * (1.f / PEER_SV);
    ss += v[i].x * v[i].x + v[i].y * v[i].y + v[i].z * v[i].z + v[i].w * v[i].w;
  }
  ss = wave_sum(ss);
  const float rn = rsqrtf(ss * (1.f / 1024.f) + EPS);
#pragma unroll
  for (int i = 0; i < 4; ++i) {
    const float4 g = ((const float4*)gF)[i * 64 + lane];
    float4 o = v[i];
    o.x *= rn * g.x; o.y *= rn * g.y; o.z *= rn * g.z; o.w *= rn * g.w;
    if (dry) { asm volatile("" :: "v"(o.x), "v"(o.y), "v"(o.z), "v"(o.w)); continue; }
    orow[i * 64 + lane] = o;
  }
}

__device__ __forceinline__ void staircase_ab(int lane, int& ca, int& cb) {
  ca = 0; cb = 0;
  int cnt = 0;
  for (int a = 0; a < 16; ++a) {
    const int nb = 16 / (a + 1);
    if (lane >= cnt && lane < cnt + nb) { ca = a; cb = lane - cnt; }
    cnt += nb;
  }
}


struct UvJob { const float* U; const float* V; const float* g2; u16* Ub; u16* Vb; size_t i0; size_t stride; };
#define UV_N4 ((size_t)16384 * 256)
__device__ __forceinline__ unsigned enc4(float x) {
  const float a = fminf(fabsf(x), 6.f);
  const float c = (a < 2.f) ? __builtin_rintf(a * 2.f) : ((a < 4.f) ? 4.f + __builtin_rintf(a - 2.f) : 6.f + __builtin_rintf((a - 4.f) * 0.5f));
  return (unsigned)fminf(c, 7.f) | ((x < 0.f) ? 8u : 0u);
}
__device__ __forceinline__ void uv_store(const UvJob& J, size_t i, const float4& u, const float4& v, const float4& g) {
  const int e = (int)(i >> 8), col = (int)(i & 255) * 4;
  const float ux = u.x * g.x * PEER_SU4, uy = u.y * g.y * PEER_SU4, uz = u.z * g.z * PEER_SU4, uw = u.w * g.w * PEER_SU4;
  unsigned pu = 0u;
  pu = __builtin_amdgcn_cvt_scalef32_pk_fp4_f32(pu, ux, uy, 1.0f, 0);
  pu = __builtin_amdgcn_cvt_scalef32_pk_fp4_f32(pu, uz, uw, 1.0f, 1);
  unsigned pv = 0u;
  pv = __builtin_amdgcn_cvt_scalef32_pk_fp4_f32(pv, v.x * PEER_SV4, v.y * PEER_SV4, 1.0f, 0);
  pv = __builtin_amdgcn_cvt_scalef32_pk_fp4_f32(pv, v.z * PEER_SV4, v.w * PEER_SV4, 1.0f, 1);
  const size_t so = ((size_t)(col >> 8) * 16384 + e) * 128 + ((col & 255) >> 1);
  *(u16*)((char*)J.Ub + so) = (u16)pu;
  *(u16*)((char*)J.Vb + so) = (u16)pv;
}

#define LRU_XCT 0
#define LRU_GX 32768
#define LRU_HF (32768 + 33792)
#define LRU_SUM (LRU_HF + 65536)
#define LRU_CARRY (LRU_SUM + 4096)
#define LRU_GGT (LRU_CARRY + 128)
#define LRU_WV (LRU_GGT + 16384)
#define LRU_LDS_BYTES (LRU_WV + 1024)

struct LruParams {
  const float* cw; const float* cb; const float* b_rg; const float* b_ig; const float* lam;
};

template <int DIR>
__device__ __forceinline__ void lru_pass(const WS& w, const LruParams& P, int b, int hh, int qq, char* smem, const UvJob& J, int& uvk) {
  const int tid = tid_fresh(), lane = tid & 63, wid = tid >> 6;
  char* xct = smem + LRU_XCT;
  char* gx = smem + LRU_GX;
  float* Gt = (float*)(smem + LRU_GX);
  u16* hf = (u16*)(smem + LRU_HF);
  float* sumA = (float*)(smem + LRU_SUM);
  float* sumB = sumA + 512;
  float* carry = (float*)(smem + LRU_CARRY);
  float* wvA = (float*)(smem + LRU_WV);
  float* wvB = wvA + 128;
  bf16x8 bw[4];
  {
    const u16* wg = w.Wg + (((size_t)DIR * 8 + hh) * 4 + qq) * 32 * 64;
#pragma unroll
    for (int ks = 0; ks < 4; ++ks) bw[ks] = *(const bf16x8*)(wg + (lane & 31) * 64 + ks * 16 + 8 * (lane >> 5));
  }
  const int s_sub = tid >> 4, ch = tid & 15;
  const int so = DIR ? (31 - s_sub) : s_sub;
  const int wv = __builtin_amdgcn_readfirstlane(DIR ? (7 - wid) : wid);
  const int jrow = so & 3;
  const int cglob = hh * 64 + qq * 16 + ch;
  const float br = P.b_rg[DIR * 512 + cglob], bi = P.b_ig[DIR * 512 + cglob];
  const float Kc = 8.f * log_sigmoidf_(P.lam[DIR * 512 + cglob]);
  const int cp = tid & 31, rr = tid >> 5;
  float cw0[4], cw1[4];
#pragma unroll
  for (int k = 0; k < 4; ++k) { cw0[k] = P.cw[k * 512 + hh * 64 + 2 * cp]; cw1[k] = P.cw[k * 512 + hh * 64 + 2 * cp + 1]; }
  const float cb0 = P.cb[hh * 64 + 2 * cp], cb1 = P.cb[hh * 64 + 2 * cp + 1];
  if (tid < 16) carry[tid] = 0.f;
  u16* ggt0 = (u16*)(smem + LRU_GGT);
  u32x4 pf0, pf1, pf2, pf3, pf4, pgg;
  const u16* xlb = w.xl + (size_t)b * SEQ * 512 + hh * 64 + (tid & 7) * 8;
  const u16* ggb = w.gg + (size_t)b * SEQ * 512 + hh * 64 + qq * 16 + (tid & 1) * 8;
#define LRU_PF(c_) do { const int _s0 = (c_) * 256 - 2 + (tid >> 3); \
    pf0 = *(const u32x4*)(xlb + (size_t)min(max(_s0, 0), SEQ - 1) * 512); \
    pf1 = *(const u32x4*)(xlb + (size_t)min(max(_s0 + 64, 0), SEQ - 1) * 512); \
    pf2 = *(const u32x4*)(xlb + (size_t)min(max(_s0 + 128, 0), SEQ - 1) * 512); \
    pf3 = *(const u32x4*)(xlb + (size_t)min(max(_s0 + 192, 0), SEQ - 1) * 512); \
    pf4 = *(const u32x4*)(xlb + (size_t)min(max(_s0 + 256, 0), SEQ - 1) * 512); \
    if (DIR == 1) pgg = *(const u32x4*)(ggb + (size_t)((c_) * 256 + (tid >> 1)) * 512); } while (0)
  LRU_PF(DIR ? 7 : 0);

  for (int cs = 0; cs < 8; ++cs) {
    const int chunk = DIR ? (7 - cs) : cs;
    const int s0 = chunk * 256;
    {
      const u32x4 z = {0u, 0u, 0u, 0u};
      const int r0 = tid >> 3, c = tid & 7;
      const int sp0 = s0 - 2 + r0;
      *(u32x4*)(gx + (r0) * 128 + c * 16) = (sp0 >= 0 && sp0 < SEQ) ? pf0 : z;
      *(u32x4*)(gx + (r0 + 64) * 128 + c * 16) = (sp0 + 64 >= 0 && sp0 + 64 < SEQ) ? pf1 : z;
      *(u32x4*)(gx + (r0 + 128) * 128 + c * 16) = (sp0 + 128 >= 0 && sp0 + 128 < SEQ) ? pf2 : z;
      *(u32x4*)(gx + (r0 + 192) * 128 + c * 16) = (sp0 + 192 >= 0 && sp0 + 192 < SEQ) ? pf3 : z;
      if (r0 + 256 < 259) *(u32x4*)(gx + (r0 + 256) * 128 + c * 16) = (sp0 + 256 >= 0 && sp0 + 256 < SEQ) ? pf4 : z;
      if (DIR == 1) *(u32x4*)((char*)ggt0 + (cs & 1) * 8192 + (tid >> 1) * 32 + (tid & 1) * 16) = pgg;
      const int cn = DIR ? max(6 - cs, 0) : min(cs + 1, 7);
      LRU_PF(cn);
    }
    const size_t ja = J.i0 + (size_t)uvk * J.stride, jb = ja + J.stride;
    const size_t jac = ja < UV_N4 ? ja : 0, jbc = jb < UV_N4 ? jb : 0;
    const float4 juA = ((const float4*)J.U)[jac], jvA = ((const float4*)J.V)[jac], jgA = ((const float4*)J.g2)[jac & 255];
    const float4 juB = ((const float4*)J.U)[jbc], jvB = ((const float4*)J.V)[jbc], jgB = ((const float4*)J.g2)[jbc & 255];
    __syncthreads();
    {
      const unsigned* gxi = (const unsigned*)gx;
      f32x2 win[19];
#pragma unroll
      for (int i = 0; i < 19; ++i) win[i] = bfpair(gxi[(rr * 16 + i) * 32 + cp]);
#pragma unroll
      for (int i = 0; i < 16; ++i) {
        f32x2 o; o.x = cb0; o.y = cb1;
#pragma unroll
        for (int k = 0; k < 4; ++k) { f32x2 cwk; cwk.x = cw0[k]; cwk.y = cw1[k]; o = __builtin_elementwise_fma(cwk, win[i + k], o); }
        const int row = rr * 16 + i;
        *(unsigned*)(xct + swz_off(row, cp >> 2) + (cp & 3) * 4) = f2bf2(o.x, o.y);
      }
    }
    __builtin_amdgcn_fence(__ATOMIC_RELEASE, "wavefront");
    __builtin_amdgcn_wave_barrier();
    __builtin_amdgcn_fence(__ATOMIC_ACQUIRE, "wavefront");
    {
      f32x16 acc;
#pragma unroll
      for (int r = 0; r < 16; ++r) acc[r] = 0.f;
#pragma unroll
      for (int ks = 0; ks < 4; ++ks) {
        bf16x8 af = *(const bf16x8*)(xct + swz_off(wid * 32 + (lane & 31), ks * 2 + (lane >> 5)));
        acc = __builtin_amdgcn_mfma_f32_32x32x16_bf16(af, bw[ks], acc, 0, 0, 0);
      }
#pragma unroll
      for (int r = 0; r < 16; ++r) {
        const int row = wid * 32 + (r & 3) + 8 * (r >> 2) + 4 * (lane >> 5);
        Gt[row * 33 + (lane & 31)] = acc[r];
      }
    }
    __builtin_amdgcn_fence(__ATOMIC_RELEASE, "wavefront");
    __builtin_amdgcn_wave_barrier();
    __builtin_amdgcn_fence(__ATOMIC_ACQUIRE, "wavefront");
    float av[8], uv[8];
    {
      float A = 1.f, B = 0.f;
#pragma unroll
      for (int i = 0; i < 8; ++i) {
        const int tok = DIR ? (s_sub * 8 + 7 - i) : (s_sub * 8 + i);
        const float r = sigmoidf_(Gt[tok * 33 + ch] + br);
        const float ig = sigmoidf_(Gt[tok * 33 + 16 + ch] + bi);
        const int col = qq * 16 + ch;
        const float xcv = bf2f(*(const u16*)(xct + swz_off(tok, col >> 3) + (col & 7) * 2));
        const float a = __expf(Kc * r);
        const float u = __builtin_amdgcn_sqrtf(fmaxf(1.f - a * a, 0.f)) * ig * xcv;
        av[i] = a; uv[i] = u;
        B = a * B + u; A *= a;
      }
      sumA[so * 16 + ch] = A; sumB[so * 16 + ch] = B;
    }
    __builtin_amdgcn_fence(__ATOMIC_RELEASE, "wavefront");
    __builtin_amdgcn_wave_barrier();
    __builtin_amdgcn_fence(__ATOMIC_ACQUIRE, "wavefront");
    {
      float At = 1.f, Bt = 0.f;
#pragma unroll
      for (int j2 = 0; j2 < 4; ++j2) {
        const float a = sumA[(wv * 4 + j2) * 16 + ch], bb = sumB[(wv * 4 + j2) * 16 + ch];
        Bt = a * Bt + bb; At *= a;
      }
      if (jrow == 0) { wvA[wv * 16 + ch] = At; wvB[wv * 16 + ch] = Bt; }
    }
    __syncthreads();
    {
      float h = carry[(cs & 1) * 16 + ch];
      for (int q = 0; q < wv; ++q) h = wvA[q * 16 + ch] * h + wvB[q * 16 + ch];
#pragma unroll
      for (int j2 = 0; j2 < 3; ++j2) {
        const float hn = sumA[(wv * 4 + j2) * 16 + ch] * h + sumB[(wv * 4 + j2) * 16 + ch];
        h = (j2 < jrow) ? hn : h;
      }
#pragma unroll
      for (int i = 0; i < 8; ++i) {
        const int tok = DIR ? (s_sub * 8 + 7 - i) : (s_sub * 8 + i);
        h = av[i] * h + uv[i];
        const int sq = s0 + tok;
        if (DIR == 0) {
          hf[sq * 16 + ch] = f2bf(h);
        } else {
          u16* gy = ggt0 + (cs & 1) * 4096 + tok * 16 + ch;
          *gy = f2bf((bf2f(hf[sq * 16 + ch]) + h) * bf2f(*gy));
        }
      }
      if (DIR == 1) {
        __builtin_amdgcn_fence(__ATOMIC_RELEASE, "wavefront");
        __builtin_amdgcn_wave_barrier();
        __builtin_amdgcn_fence(__ATOMIC_ACQUIRE, "wavefront");
        const int tl = 32 * wid + (lane >> 1);
        const u32x4 yy = *(const u32x4*)((const char*)ggt0 + (cs & 1) * 8192 + tl * 32 + (lane & 1) * 16);
        const size_t t = (size_t)b * SEQ + s0 + tl;
        *(u32x4*)(w.y + AIDX(t, hh * 64 + qq * 16 + (lane & 1) * 8)) = yy;
        const f32x2 q0 = bfpair(yy.x), q1 = bfpair(yy.y), q2 = bfpair(yy.z), q3 = bfpair(yy.w);
        float ss = q0.x * q0.x + q0.y * q0.y + q1.x * q1.x + q1.y * q1.y + q2.x * q2.x + q2.y * q2.y + q3.x * q3.x + q3.y * q3.y;
        ss += __int_as_float(__builtin_amdgcn_update_dpp(0, __float_as_int(ss), 0xB1, 0xF, 0xF, true));
        if ((lane & 1) == 0) w.ssq_lru[t * 32 + hh * 4 + qq] = ss;
      }
      if (so == 31) carry[((cs + 1) & 1) * 16 + ch] = h;
    }
    if (ja < UV_N4) uv_store(J, ja, juA, jvA, jgA);
    if (jb < UV_N4) uv_store(J, jb, juB, jvB, jgB);
    uvk += 2;
  }
  __syncthreads();
#undef LRU_PF
}

__device__ __forceinline__ void p2_lru_task(const WS& w, const LruParams& P, int task, char* smem, const UvJob& J, int& uvk) {
  const int b = task >> 5, hh = (task >> 2) & 7, qq = task & 3;
  lru_pass<0>(w, P, b, hh, qq, smem, J, uvk);
  lru_pass<1>(w, P, b, hh, qq, smem, J, uvk);
}


#define CONV_LDS_BYTES (62 * 1024 + 32 * 4 * 4)
struct ConvParams { const float* cw; const float* cb; const float* ng; const float* nb; };

__device__ __forceinline__ void p2_conv_tile(const WS& w, const ConvParams& P, int tile, char* smem) {
  int tid = threadIdx.x;
  asm volatile("" : "+v"(tid));
  const int lane = tid & 63, wid = tid >> 6;
  const int b = tile >> 6, s0 = (tile & 63) * 32;
  float* red = (float*)(smem + 62 * 1024);
  for (int q = tid; q < 62 * 64; q += 512) {
    const int row = q >> 6, c = q & 63;
    const int sp = s0 - 15 + row;
    uint4 v = make_uint4(0, 0, 0, 0);
    if (sp >= 0 && sp < SEQ) v = *(const uint4*)(w.glu + ((size_t)b * SEQ + sp) * 512 + c * 8);
    *(uint4*)(smem + row * 1024 + c * 16) = v;
  }
  const int cp = tid & 255, th = tid >> 8;
  float w0[31], w1[31];
#pragma unroll
  for (int k = 0; k < 31; ++k) {
    const float2 wv = *(const float2*)(P.cw + k * 512 + 2 * cp);
    w0[k] = wv.x; w1[k] = wv.y;
  }
  const float2 cbv = *(const float2*)(P.cb + 2 * cp);
  const float2 ngv = *(const float2*)(P.ng + 2 * cp);
  const float2 nbv = *(const float2*)(P.nb + 2 * cp);
  __syncthreads();
  const unsigned* gl = (const unsigned*)smem;
  float y0[16], y1[16];
#pragma unroll
  for (int tb = 0; tb < 2; ++tb) {
    float a0[8], a1[8];
#pragma unroll
    for (int i = 0; i < 8; ++i) { a0[i] = cbv.x; a1[i] = cbv.y; }
    const int rbase = th * 16 + tb * 8;
#pragma unroll
    for (int j = 0; j < 38; ++j) {
      const unsigned pk = gl[(rbase + j) * 256 + cp];
      const float xlo = __uint_as_float(pk << 16), xhi = __uint_as_float(pk & 0xffff0000u);
#pragma unroll
      for (int i = 0; i < 8; ++i) {
        const int k = j - i;
        if (k >= 0 && k < 31) { a0[i] += w0[k] * xlo; a1[i] += w1[k] * xhi; }
      }
      if ((j & 3) == 3) __builtin_amdgcn_sched_barrier(0);
    }
#pragma unroll
    for (int i = 0; i < 8; ++i) {
      float s = a0[i] + a1[i];
      s = sum_grp32(s);
      const float mu = s * (1.f / 64.f);
      const float d0 = a0[i] - mu, d1 = a1[i] - mu;
      float q = d0 * d0 + d1 * d1;
      q = sum_grp32(q);
      const float rstd = rsqrtf(q * (1.f / 64.f) + EPS);
      const float v0 = d0 * rstd * ngv.x + nbv.x, v1 = d1 * rstd * ngv.y + nbv.y;
      const float yy0 = v0 * sigmoidf_(v0), yy1 = v1 * sigmoidf_(v1);
      y0[tb * 8 + i] = yy0; y1[tb * 8 + i] = yy1;
      float sq = yy0 * yy0 + yy1 * yy1;
      sq = wave_sum(sq);
      if (lane == 0) red[(th * 16 + tb * 8 + i) * 4 + (wid & 3)] = sq;
    }
    __builtin_amdgcn_sched_barrier(0);
  }
  __syncthreads();
#pragma unroll
  for (int i = 0; i < 16; ++i) {
    const int tok = th * 16 + i;
    const float4 r4 = *(const float4*)(red + tok * 4);
    const float rc = rsqrtf((r4.x + r4.y + r4.z + r4.w) * (1.f / 512.f) + EPS);
    const size_t t = (size_t)b * SEQ + s0 + tok;
    const unsigned pk = f2bf2(y0[i] * rc, y1[i] * rc);
    *(unsigned*)(w.y + AIDX(t, 512 + 2 * cp)) = pk;
  }
  __syncthreads();
}


#define XB_TMO      128
#define XB_XCNT(j)  (256  + 64 * (j))
#define XB_XSUB(j)  (1280 + 64 * (j))
#define XB_XGEN(j)  (2304 + 64 * (j))
#define XB_TOP      3328
#define XB_TOPGEN   3392
#define XCD_BAR_WORDS 3456
#define XB_SPIN_CAP (1u << 22)
#define LAS __attribute__((address_space(3)))
__device__ __forceinline__ unsigned xb_ld(unsigned* p) { return __hip_atomic_load(p, __ATOMIC_RELAXED, __HIP_MEMORY_SCOPE_AGENT); }
__device__ __forceinline__ unsigned xb_add(unsigned* p, unsigned v) { return __hip_atomic_fetch_add(p, v, __ATOMIC_RELAXED, __HIP_MEMORY_SCOPE_AGENT); }
__device__ __forceinline__ unsigned xb_xcc_id() { return (unsigned)__builtin_amdgcn_s_getreg((3 << 11) | 20) & 0xFu; }
#define XB_SPIN(cond, bar) do { unsigned _sp = 0; while (cond) { __builtin_amdgcn_s_sleep(1); \
    if ((++_sp & 255u) == 0u) { if (xb_ld(&(bar)[XB_TMO])) break; if (_sp > XB_SPIN_CAP) { atomicAdd(&(bar)[XB_TMO], 1u); break; } } } } while (0)
struct XcdBarrier { unsigned* bar; unsigned x; volatile LAS unsigned* st; };
__device__ __forceinline__ XcdBarrier xcd_barrier_post(unsigned* bar, volatile LAS unsigned* st) {
  XcdBarrier b; b.bar = bar; b.x = xb_xcc_id(); b.st = st;
  if (threadIdx.x == 0) st[2] = xb_add(&bar[XB_XCNT(b.x)], 1u);
  return b;
}
__device__ __forceinline__ void xcd_barrier_complete(unsigned* bar, unsigned x, unsigned& nloc, unsigned& nx) {
  const unsigned G = gridDim.x * gridDim.y * gridDim.z;
  unsigned sum, cnt, mine, sp = 0u;
  for (;;) {
    sum = 0u; cnt = 0u; mine = 0u;
#pragma unroll
    for (unsigned j = 0; j < 16; ++j) { const unsigned c = xb_ld(&bar[XB_XCNT(j)]); sum += c; cnt += (c > 0u) ? 1u : 0u; mine = (j == x) ? c : mine; }
    if (sum == G) break;
    __builtin_amdgcn_s_sleep(1);
    if ((++sp & 255u) == 0u) { if (xb_ld(&bar[XB_TMO])) break; if (sp > XB_SPIN_CAP) { atomicAdd(&bar[XB_TMO], 1u); break; } }
  }
  nloc = mine > 0u ? mine : 1u; nx = cnt > 0u ? cnt : 1u;
}
__device__ __forceinline__ void xcd_barrier(const XcdBarrier& b) {
  asm volatile("s_waitcnt vmcnt(0)" ::: "memory");
  __syncthreads();
  if (threadIdx.x == 0) {
    unsigned* bar = b.bar;
    __builtin_amdgcn_s_waitcnt(0);
    unsigned nloc = b.st[0], nx = b.st[1];
    if (nloc == 0u) { xcd_barrier_complete(bar, b.x, nloc, nx); b.st[0] = nloc; b.st[1] = nx; }
    const unsigned old = xb_add(&bar[XB_XSUB(b.x)], 1u);
    const unsigned gen = old / nloc;
    if (old + 1u == (gen + 1u) * nloc) {
      __builtin_amdgcn_fence(__ATOMIC_RELEASE, "agent");
      asm volatile("s_waitcnt vmcnt(0)" ::: "memory");
      const unsigned og = xb_add(&bar[XB_TOP], 1u);
      const unsigned tg = og / nx;
      if (og + 1u == (tg + 1u) * nx) xb_add(&bar[XB_TOPGEN], 1u);
      else XB_SPIN(xb_ld(&bar[XB_TOPGEN]) == tg, bar);
      __builtin_amdgcn_fence(__ATOMIC_ACQUIRE, "agent");
      asm volatile("s_waitcnt vmcnt(0)" ::: "memory");
    } else {
      XB_SPIN(xb_ld(&bar[XB_TOPGEN]) == gen, bar);
      __builtin_amdgcn_fence(__ATOMIC_ACQUIRE, "agent");
      asm volatile("s_waitcnt vmcnt(0)" ::: "memory");
    }
  }
  __syncthreads();
}

struct MK {
  WS w;
  const float* x; const float* mix_norm_g; const float* w_in; const float* lru_conv_w; const float* lru_conv_b;
  const float* lru_w_rg; const float* lru_b_rg; const float* lru_w_ig; const float* lru_b_ig; const float* lru_lambda;
  const float* conf_conv_w; const float* conf_conv_b; const float* conf_norm_g; const float* conf_norm_b;
  const float* beta_lru; const float* beta_conv; const float* w_out; const float* ffn_norm_g; const float* peer_w_q;
  const float* peer_sub_keys; const float* peer_u; const float* peer_v; const float* final_norm_g;
  float* out;
  unsigned* bar;
};

static_assert(MK_LDS_BYTES >= LRU_LDS_BYTES && MK_LDS_BYTES >= GEMM3_LDS_BYTES + 1024, "lds size");
#define MK_LDS_TOTAL (MK_LDS_BYTES + 16 + 256)

template <int MODE>
__device__ __forceinline__ void prep_wT_tile(const float* __restrict__ wsrc, const float* __restrict__ scale_a,
                                             const float* __restrict__ scale_b, u16* __restrict__ dst, int N, int tile,
                                             int htid, float* tl) {
  const int ntn = N >> 5;
  const int n0 = (tile % ntn) * 32, k0 = (tile / ntn) * 32;
  const int tx = htid & 31, ty = htid >> 5;
#pragma unroll
  for (int i = 0; i < 4; ++i) {
    const int kk = ty + 8 * i, k = k0 + kk, n = n0 + tx;
    const int col = (MODE == 1) ? win_orig_col(n) : n;
    float sc;
    if (MODE == 2) sc = (k < 512) ? scale_a[k] : scale_b[k - 512];
    else sc = scale_a[k];
    tl[kk * 33 + tx] = sc * wsrc[(size_t)k * N + col];
  }
  __syncthreads();
#pragma unroll
  for (int i = 0; i < 4; ++i) {
    const int nn = ty + 8 * i;
    dst[WIDX(n0 + nn, k0 + tx, N)] = f2bf(tl[tx * 33 + nn]);
  }
  __syncthreads();
}

__device__ __forceinline__ void phase0(const MK& p, char* smem) {
  int tid = threadIdx.x;
  asm volatile("" : "+v"(tid));
  const int lane = tid & 63, wid = tid >> 6;
  const int nb = gridDim.x, bid = blockIdx.x;
  {
    auto row_store = [&](int t, const float4 (&v)[4]) {
      float ss = 0.f;
#pragma unroll
      for (int i = 0; i < 4; ++i) ss += v[i].x * v[i].x + v[i].y * v[i].y + v[i].z * v[i].z + v[i].w * v[i].w;
      ss = wave_sum(ss);
#pragma unroll
      for (int i = 0; i < 4; ++i) {
        *(uint2*)(p.w.xb + AIDX(t, (i * 64 + lane) * 4)) = make_uint2(f2bf2(v[i].x, v[i].y), f2bf2(v[i].z, v[i].w));
      }
      if (lane == 0) p.w.rs0[t] = rsqrtf(ss * (1.f / 1024.f) + EPS);
    };
    const int st = nb * 8;
    int t = bid * 8 + wid;
    for (; t + st < T_TOK; t += 2 * st) {
      float4 va[4], vb[4];
#pragma unroll
      for (int i = 0; i < 4; ++i) va[i] = ((const float4*)(p.x + (size_t)t * 1024))[i * 64 + lane];
#pragma unroll
      for (int i = 0; i < 4; ++i) vb[i] = ((const float4*)(p.x + (size_t)(t + st) * 1024))[i * 64 + lane];
      row_store(t, va);
      row_store(t + st, vb);
    }
    for (; t < T_TOK; t += st) {
      float4 va[4];
#pragma unroll
      for (int i = 0; i < 4; ++i) va[i] = ((const float4*)(p.x + (size_t)t * 1024))[i * 64 + lane];
      row_store(t, va);
    }
  }
  {
    float* tl = (float*)smem + (tid >> 8) * (32 * 33);
    const int htid = tid & 255, hb = bid * 2 + (tid >> 8), nhb = nb * 2;
    for (int tile = hb; tile < 2048; tile += nhb) prep_wT_tile<1>(p.w_in, p.mix_norm_g, nullptr, p.w.WinT, 2048, tile, htid, tl);
    for (int tile = hb; tile < 1024; tile += nhb) prep_wT_tile<2>(p.w_out, p.beta_lru, p.beta_conv, p.w.WoutT, 1024, tile, htid, tl);
    for (int tile = hb; tile < 2048; tile += nhb) prep_wT_tile<0>(p.peer_w_q, p.ffn_norm_g, nullptr, p.w.WqT, 2048, tile, htid, tl);
  }
  for (int i = bid * 512 + tid; i < 16 * 128 * 128; i += nb * 512) {
    p.w.keysb[i] = f2bf(p.peer_sub_keys[i]);
    if (i < 2 * 8 * 4 * 32 * 64) {
      const int k = i & 63, j = (i >> 6) & 31, qq = (i >> 11) & 3, hh = (i >> 13) & 7, dir = (i >> 16) & 1;
      const int o = qq * 16 + (j & 15);
      const float* srcp = (j < 16) ? p.lru_w_rg : p.lru_w_ig;
      p.w.Wg[i] = f2bf(srcp[(((size_t)dir * 8 + hh) * 64 + k) * 64 + o]);
    }
  }
}

#define BAR_MARK() do { xcd_barrier(xb); PROBE_MARK(PSM(smem), 12); } while (0)
__global__ void __launch_bounds__(512) k_mega(MK p) {
  extern __shared__ __attribute__((aligned(16))) char smem[];
  const int nb = gridDim.x, bid = blockIdx.x;
  volatile LAS unsigned* xst = (volatile LAS unsigned*)(smem + MK_LDS_BYTES);
  if (threadIdx.x < 4) xst[threadIdx.x] = 0u;
#if PROBE
  PROBE_INIT(PSM(smem));
#endif
  __syncthreads();
  XcdBarrier xb = xcd_barrier_post(p.bar, xst);
  for (int rep = 0; rep < (DUP == 1 ? 2 : 1); ++rep) { phase0(p, smem); PROBE_MARK(PSM(smem), 1); BAR_MARK(); }
  for (int rep = 0; rep < (DUP == 2 ? 2 : 1); ++rep) {
    for (int tile = bid; tile < 512; tile += nb) p1_tile(p.w, tile, nb, smem);
    PROBE_MARK(PSM(smem), 2); BAR_MARK();
  }
  {
    LruParams LP{p.lru_conv_w, p.lru_conv_b, p.lru_b_rg, p.lru_b_ig, p.lru_lambda};
    UvJob UJ{p.peer_u, p.peer_v, p.ffn_norm_g, p.w.Ub, p.w.Vb, (size_t)bid * 512 + threadIdx.x, (size_t)nb * 512};
    int uvk = 0;
    for (int rep = 0; rep < (DUP == 3 ? 2 : 1); ++rep) {
      for (int task = bid; task < 256; task += nb) p2_lru_task(p.w, LP, task, smem, UJ, uvk);
      if (DUP == 3 && rep == 0) xcd_barrier(xb);
    }
    for (size_t i = UJ.i0 + (size_t)uvk * UJ.stride; i < UV_N4; i += UJ.stride)
      uv_store(UJ, i, ((const float4*)UJ.U)[i], ((const float4*)UJ.V)[i], ((const float4*)UJ.g2)[i & 255]);
    PROBE_MARK(PSM(smem), 3);
    ConvParams CP{p.conf_conv_w, p.conf_conv_b, p.conf_norm_g, p.conf_norm_b};
    for (int rep = 0; rep < (DUP == 4 ? 2 : 1); ++rep) {
      for (int tile = bid; tile < 512; tile += nb) p2_conv_tile(p.w, CP, tile, smem);
      if (DUP == 4 && rep == 0) xcd_barrier(xb);
    }
    PROBE_MARK(PSM(smem), 4);
  }
  BAR_MARK();
  for (int rep = 0; rep < (DUP == 5 ? 2 : 1); ++rep) {
    for (int tile = bid; tile < 256; tile += nb) p3_tile(p.w, p.x, p.out, tile, smem);
    PROBE_MARK(PSM(smem), 5); BAR_MARK();
  }
  for (int rep = 0; rep < (DUP == 6 ? 2 : 1); ++rep) {
    for (int tile = bid; tile < 512; tile += nb) p4_tile(p.w, tile, smem);
    PROBE_MARK(PSM(smem), 6); BAR_MARK();
  }
  for (int rep = 0; rep < (DUP == 7 ? 2 : 1); ++rep) {
    const int wid = threadIdx.x >> 6;
    for (int tb = (bid * 8 + wid) * 8; tb < T_TOK; tb += nb * 64) {
      {
        const int lane = threadIdx.x & 63;
        u32x4 ha[8], hb[8];
#pragma unroll
        for (int k = 0; k < 8; ++k) {
          const u32x4* hp = (const u32x4*)(p.w.h1b + AIDX(min(tb + k, T_TOK - 1), lane * 16));
          ha[k] = hp[0]; hb[k] = hp[1];
        }
#pragma unroll
        for (int k = 0; k < 8; ++k) {
          u32x4 o;
          o.x = (unsigned)fp8x4(ha[k].x, ha[k].y); o.y = (unsigned)fp8x4(ha[k].z, ha[k].w);
          o.z = (unsigned)fp8x4(hb[k].x, hb[k].y); o.w = (unsigned)fp8x4(hb[k].z, hb[k].w);
          *(u32x4*)(p.w.h1q + (size_t)min(tb + k, T_TOK - 1) * 1024 + lane * 16) = o;
        }
      }
      p5_route8(p.w, tb, (unsigned*)smem + wid * (64 * 33));
    }
    PROBE_MARK(PSM(smem), 7); BAR_MARK();
  }
  int gs_slice, gs_t0, gs_stride, gu_t0, gu_stride;
  {
    const unsigned nloc = xst[0], nx = xst[1], rank = xst[2];
    const int wid = threadIdx.x >> 6;
    bool all8 = (nx == 8u);
    if (all8) { for (int j = 0; j < 8; ++j) all8 = all8 && (xb_ld(&p.bar[XB_XCNT(j)]) > 0u); }
    if (all8 && xb.x < 8u) { gs_slice = (int)xb.x; gs_t0 = (int)rank * 8 + wid; gs_stride = (int)nloc * 8; }
    else if ((nb & 7) == 0) { gs_slice = bid & 7; gs_t0 = (bid >> 3) * 8 + wid; gs_stride = (nb >> 3) * 8; }
    else { gs_slice = -1; gs_t0 = bid * 8 + wid; gs_stride = nb * 8; }
    if (all8 && xb.x < 8u) {
      const unsigned na = xb_ld(&p.bar[XB_XCNT(xb.x & ~1u)]), nbq = xb_ld(&p.bar[XB_XCNT(xb.x | 1u)]);
      gu_t0 = (int)(((xb.x & 1u) ? na : 0u) + rank) * 8 + wid; gu_stride = (int)(na + nbq) * 8;
    } else if ((nb & 7) == 0) { gu_t0 = ((bid & 1) * (nb >> 3) + (bid >> 3)) * 8 + wid; gu_stride = (nb >> 2) * 8; }
    else { gu_t0 = gs_t0; gu_stride = gs_stride; }
  }
  for (int rep = 0; rep < (DUP == 11 ? 2 : 1); ++rep) {
    char* ulds = smem + (threadIdx.x >> 6) * 16384;
    if (gs_slice >= 0) um_sweep(p.w, gs_slice >> 1, gu_t0, gu_stride, ulds);
    else for (int s = 0; s < 4; ++s) um_sweep(p.w, s, gs_t0, gs_stride, ulds);
    PROBE_MARK(PSM(smem), 8); BAR_MARK();
  }
  for (int rep = 0; rep < (DUP == 12 ? 2 : 1); ++rep) {
    const int wid = threadIdx.x >> 6;
    {
      const int wst = nb * 8;
      int t = bid * 8 + wid;
      for (; t + 7 * wst < T_TOK; t += 8 * wst) p5_wphase4<8>(p.w, t, wst);
      for (; t + 3 * wst < T_TOK; t += 4 * wst) p5_wphase4<4>(p.w, t, wst);
      for (; t < T_TOK; t += wst) p5_wphase(p.w, t);
    }
    PROBE_MARK(PSM(smem), 9); BAR_MARK();
  }
  for (int rep = 0; rep < (DUP == 8 ? 2 : 1); ++rep) {
    const bool dry = (DUP == 8 && rep == 0);
    (void)dry;
    char* vlds = smem + (threadIdx.x >> 6) * 16384;
    if (gs_slice >= 0) vm_sweep(p.w, gs_slice >> 1, gu_t0, gu_stride, vlds);
    else for (int s = 0; s < 4; ++s) vm_sweep(p.w, s, gs_t0, gs_stride, vlds);
    PROBE_MARK(PSM(smem), 10); BAR_MARK();
  }
  for (int rep = 0; rep < (DUP == 9 ? 2 : 1); ++rep) {
    const bool dry = (DUP == 9 && rep == 0);
    const int wid = threadIdx.x >> 6;
    for (int t = bid * 8 + wid; t < T_TOK; t += nb * 8) p7_row(p.w, t, p.final_norm_g, p.out, dry);
    if (DUP == 9 && rep == 0) xcd_barrier(xb);
  }
  PROBE_MARK(PSM(smem), 11);
#if DUP == 10
  for (int rep = 0; rep < 10; ++rep) xcd_barrier(xb);
#endif
#if PROBE
  if (bid == PBLK && threadIdx.x == 0) {
    const unsigned long long* pa = (const unsigned long long*)PSM(smem);
    const unsigned long long dur = pa[PROBE];
    const unsigned long long st = __builtin_amdgcn_s_memrealtime();
    while (__builtin_amdgcn_s_memrealtime() - st < dur) __builtin_amdgcn_s_sleep(8);
  }
#endif
}

extern "C" void kernel_launch(void* const* d_in, const int* in_sizes, int n_in, void* d_out, int out_size, void* d_ws,
                              size_t ws_size, hipStream_t stream) {
  const float* x = (const float*)d_in[0];
  const float* mix_norm_g = (const float*)d_in[1];
  const float* w_in = (const float*)d_in[2];
  const float* lru_conv_w = (const float*)d_in[3];
  const float* lru_conv_b = (const float*)d_in[4];
  const float* lru_w_rg = (const float*)d_in[5];
  const float* lru_b_rg = (const float*)d_in[6];
  const float* lru_w_ig = (const float*)d_in[7];
  const float* lru_b_ig = (const float*)d_in[8];
  const float* lru_lambda = (const float*)d_in[9];
  const float* conf_conv_w = (const float*)d_in[10];
  const float* conf_conv_b = (const float*)d_in[11];
  const float* conf_norm_g = (const float*)d_in[12];
  const float* conf_norm_b = (const float*)d_in[13];
  const float* beta_lru = (const float*)d_in[14];
  const float* beta_conv = (const float*)d_in[15];
  const float* w_out = (const float*)d_in[16];
  const float* ffn_norm_g = (const float*)d_in[17];
  const float* peer_w_q = (const float*)d_in[18];
  const float* peer_sub_keys = (const float*)d_in[19];
  const float* peer_u = (const float*)d_in[20];
  const float* peer_v = (const float*)d_in[21];
  const float* final_norm_g = (const float*)d_in[22];
  float* out = (float*)d_out;
  WS w = make_ws(d_ws);
  static int grid_blocks = 0;
  if (!grid_blocks) {
    (void)hipFuncSetAttribute((const void*)k_mega, hipFuncAttributeMaxDynamicSharedMemorySize, MK_LDS_TOTAL);
    int dev = 0, cus = 0, per_cu = 0;
    (void)hipGetDevice(&dev);
    (void)hipDeviceGetAttribute(&cus, hipDeviceAttributeMultiprocessorCount, dev);
    (void)hipOccupancyMaxActiveBlocksPerMultiprocessor(&per_cu, k_mega, 512, MK_LDS_TOTAL);
    if (per_cu > 1) per_cu = 1;
    grid_blocks = cus * per_cu;
    if (grid_blocks <= 0) grid_blocks = 1;
  }
  MK p{};
  p.w = w;
  p.x = x; p.mix_norm_g = mix_norm_g; p.w_in = w_in; p.lru_conv_w = lru_conv_w; p.lru_conv_b = lru_conv_b;
  p.lru_w_rg = lru_w_rg; p.lru_b_rg = lru_b_rg; p.lru_w_ig = lru_w_ig; p.lru_b_ig = lru_b_ig; p.lru_lambda = lru_lambda;
  p.conf_conv_w = conf_conv_w; p.conf_conv_b = conf_conv_b; p.conf_norm_g = conf_norm_g; p.conf_norm_b = conf_norm_b;
  p.beta_lru = beta_lru; p.beta_conv = beta_conv; p.w_out = w_out; p.ffn_norm_g = ffn_norm_g; p.peer_w_q = peer_w_q;
  p.peer_sub_keys = peer_sub_keys; p.peer_u = peer_u; p.peer_v = peer_v; p.final_norm_g = final_norm_g;
  p.out = out;
  p.bar = w.bar;
  (void)hipMemsetAsync(w.bar, 0, XCD_BAR_WORDS * 4, stream);
  hipLaunchKernelGGL(k_mega, dim3(grid_blocks), dim3(512), MK_LDS_TOTAL, stream, p);
}
```
